# Optimizing an MI355X kernel written in HIP

```python
import math
import jax
import jax.numpy as jnp
from jax import lax
import numpy as np

D_MODEL = 1024
BATCH = 16
SEQ = 4096
DEPTH = 2

GRID_W = 64
CTX_LEN = 256
EPS = 1e-6

SSD_HEADS = 6
SSD_HEAD_DIM = 64
SSD_INNER = SSD_HEADS * SSD_HEAD_DIM
SSD_GROUPS = 2
SSD_STATE = 128
SSD_CONV = 4
SSD_CHUNK = 128
XBC_DIM = SSD_INNER + 2 * SSD_GROUPS * SSD_STATE

MLA_HEADS = 6
Q_LORA = 256
KV_LORA = 256
QK_NOPE = 64
QK_ROPE = 32
V_HEAD = 64
QK_DIM = QK_NOPE + QK_ROPE
MLA_OUT = MLA_HEADS * V_HEAD
ROPE_THETA = 10000.0
ROPE_PAIRS = QK_ROPE // 4
Q_BLOCK = 128

POOL_WINDOWS = (2, 4, 8, 16)
POOL_GROUPS = len(POOL_WINDOWS)
POOL_GROUP_DIM = 64
POOL_DIM = POOL_GROUPS * POOL_GROUP_DIM

MIX_DIM = SSD_INNER + MLA_OUT + POOL_DIM
D_FF = 4 * D_MODEL

OFF_Z = 0
OFF_XBC = OFF_Z + SSD_INNER
OFF_DT = OFF_XBC + XBC_DIM
OFF_QA = OFF_DT + 2 * SSD_HEADS
OFF_KVA = OFF_QA + Q_LORA
OFF_KROPE = OFF_KVA + KV_LORA
OFF_POOL = OFF_KROPE + QK_ROPE
IN_COLS = OFF_POOL + POOL_DIM

kernel_name = "hybrid_ssd_mla_pool_diffusion_block"


def rmsnorm(u, w):
    uf = u.astype(jnp.float32)
    y = uf * lax.rsqrt(jnp.mean(uf * uf, axis=-1, keepdims=True) + EPS)
    return (y * w.astype(jnp.float32)).astype(u.dtype)


def adaln(cond, mod_w, mod_b):
    m = jax.nn.silu(cond) @ mod_w + mod_b
    return jnp.split(m[..., None, :], 6, axis=-1)


def modulate(h, shift, scale):
    return h * (1.0 + scale) + shift


def squared_relu_mlp(h, w1, w2):
    return jnp.square(jax.nn.relu(h @ w1)) @ w2


def axial_rope_tables(n):
    rows = n // GRID_W
    row = jnp.repeat(jnp.arange(rows, dtype=jnp.float32), GRID_W)
    col = jnp.tile(jnp.arange(GRID_W, dtype=jnp.float32), rows)
    inv_freq = ROPE_THETA ** (-jnp.arange(ROPE_PAIRS, dtype=jnp.float32) / ROPE_PAIRS)
    ang = jnp.stack([row[:, None] * inv_freq, col[:, None] * inv_freq], axis=1)
    return jnp.cos(ang), jnp.sin(ang)


def apply_axial_rope(u, cos, sin):
    shp = u.shape
    ur = u.astype(jnp.float32).reshape(shp[:-1] + (2, 2, ROPE_PAIRS))
    u1, u2 = ur[..., 0, :], ur[..., 1, :]
    bshape = (shp[1],) + (1,) * (u.ndim - 3) + (2, ROPE_PAIRS)
    cos = cos.reshape(bshape)
    sin = sin.reshape(bshape)
    out = jnp.stack([u1 * cos - u2 * sin, u2 * cos + u1 * sin], axis=-2)
    return out.reshape(shp).astype(u.dtype)


def depthwise_conv_centred(u, w, b):
    k = w.shape[0]
    out = lax.conv_general_dilated(u, w[:, None, :].astype(u.dtype), (1,), [((k - 1) // 2, k // 2)],
                                   dimension_numbers=('NWC', 'WIO', 'NWC'),
                                   feature_group_count=u.shape[-1])
    return out + b


def ssd_inputs(proj, conv_w, conv_b, dt_bias):
    bsz, n = proj.shape[:2]
    z = proj[..., OFF_Z:OFF_XBC]
    xbc = jax.nn.silu(depthwise_conv_centred(proj[..., OFF_XBC:OFF_DT], conv_w, conv_b))
    xs = xbc[..., :SSD_INNER].reshape(bsz, n, SSD_HEADS, SSD_HEAD_DIM)
    bm = xbc[..., SSD_INNER:SSD_INNER + SSD_GROUPS * SSD_STATE].reshape(bsz, n, SSD_GROUPS, SSD_STATE)
    cm = xbc[..., SSD_INNER + SSD_GROUPS * SSD_STATE:].reshape(bsz, n, SSD_GROUPS, SSD_STATE)
    dt_raw = proj[..., OFF_DT:OFF_QA].astype(jnp.float32).reshape(bsz, n, 2, SSD_HEADS)
    dt = jax.nn.softplus(dt_raw + dt_bias.astype(jnp.float32))
    return z, xs, bm, cm, dt


def segsum_exp(a):
    l = a.shape[-1]
    cs = jnp.cumsum(a, axis=-1)
    diff = cs[..., :, None] - cs[..., None, :]
    mask = jnp.tril(jnp.ones((l, l), dtype=bool))
    return jnp.exp(jnp.where(mask, diff, -jnp.inf))


def ssd_chunked_scan(xs, dt, a, b_mat, c_mat, h0):
    f32 = jnp.float32
    bsz, n = xs.shape[:2]
    nc = n // SSD_CHUNK
    r = SSD_HEADS // SSD_GROUPS
    dt = dt.astype(f32)
    x = (xs.astype(f32) * dt[..., None]).reshape(bsz, nc, SSD_CHUNK, SSD_GROUPS, r, SSD_HEAD_DIM)
    adt = jnp.moveaxis((dt * a.astype(f32)).reshape(bsz, nc, SSD_CHUNK, SSD_GROUPS, r), 2, -1)
    bm = b_mat.astype(f32).reshape(bsz, nc, SSD_CHUNK, SSD_GROUPS, SSD_STATE)
    cm = c_mat.astype(f32).reshape(bsz, nc, SSD_CHUNK, SSD_GROUPS, SSD_STATE)
    a_cs = jnp.cumsum(adt, axis=-1)
    l_mat = segsum_exp(adt)
    cb = jnp.einsum('bclgn,bcsgn->bcgls', cm, bm)
    y_diag = jnp.einsum('bcgrls,bcsgrp->bclgrp', cb[:, :, :, None] * l_mat, x)
    decay_to_end = jnp.exp(a_cs[..., -1:] - a_cs)
    chunk_states = jnp.einsum('bclgn,bcgrl,bclgrp->bcgrpn', bm, decay_to_end, x)
    chunk_decay = jnp.exp(a_cs[..., -1])

    def carry_step(h, inp):
        s_c, d_c = inp
        return h * d_c[..., None, None] + s_c, h

    h_init = h0.astype(f32).reshape(bsz, SSD_GROUPS, r, SSD_HEAD_DIM, SSD_STATE)
    h_last, h_in = lax.scan(carry_step, h_init,
                            (jnp.moveaxis(chunk_states, 1, 0), jnp.moveaxis(chunk_decay, 1, 0)))
    h_in = jnp.moveaxis(h_in, 0, 1)
    y_off = jnp.einsum('bclgn,bcgrpn,bcgrl->bclgrp', cm, h_in, jnp.exp(a_cs))
    y = (y_diag + y_off).reshape(bsz, n, SSD_HEADS, SSD_HEAD_DIM)
    return y, h_last.reshape(bsz, SSD_HEADS, SSD_HEAD_DIM, SSD_STATE)


def ssd_bidirectional(xs, bm, cm, dt, a, h0_fwd, h0_bwd):
    flip = lambda t: jnp.flip(t, axis=1)
    y_f, h_f = ssd_chunked_scan(xs, dt[:, :, 0], a[0], bm, cm, h0_fwd)
    y_b, h_b = ssd_chunked_scan(flip(xs), flip(dt[:, :, 1]), a[1], flip(bm), flip(cm), h0_bwd)
    return y_f + flip(y_b), h_f, h_b


def ssd_output(y, xs, z, d_skip, norm_w):
    bsz, n = y.shape[:2]
    y = y + xs.astype(jnp.float32) * d_skip.astype(jnp.float32)[:, None]
    g = (y.reshape(bsz, n, SSD_INNER) * jax.nn.silu(z.astype(jnp.float32)))
    g = g.reshape(bsz, n, SSD_GROUPS, SSD_INNER // SSD_GROUPS)
    g = g * lax.rsqrt(jnp.mean(g * g, axis=-1, keepdims=True) + EPS)
    return (g.reshape(bsz, n, SSD_INNER) * norm_w.astype(jnp.float32)).astype(z.dtype)


def mla_qkv(proj, q_a_norm_w, w_q_b, kv_a_norm_w, w_kv_b, rope):
    bsz, n = proj.shape[:2]
    cq = rmsnorm(proj[..., OFF_QA:OFF_KVA], q_a_norm_w)
    q = (cq @ w_q_b).reshape(bsz, n, MLA_HEADS, QK_DIM)
    ckv = rmsnorm(proj[..., OFF_KVA:OFF_KROPE], kv_a_norm_w)
    k_rope = proj[..., OFF_KROPE:OFF_POOL]
    kv = (ckv @ w_kv_b).reshape(bsz, n, MLA_HEADS, QK_NOPE + V_HEAD)
    k_nope, v = kv[..., :QK_NOPE], kv[..., QK_NOPE:]
    q_nope, q_rope = q[..., :QK_NOPE], q[..., QK_NOPE:]
    if rope is not None:
        cos, sin = rope
        q_rope = apply_axial_rope(q_rope, cos, sin)
        k_rope = apply_axial_rope(k_rope, cos, sin)
    q = jnp.concatenate([q_nope, q_rope], axis=-1)
    k = jnp.concatenate([k_nope, jnp.broadcast_to(k_rope[:, :, None, :], (bsz, n, MLA_HEADS, QK_ROPE))], axis=-1)
    return q, k, v


def attend(q, k, v):
    s = jnp.einsum('bqhd,bkhd->bhqk', q, k, preferred_element_type=jnp.float32) * (QK_DIM ** -0.5)
    p = jax.nn.softmax(s, axis=-1).astype(v.dtype)
    return jnp.einsum('bhqk,bkhd->bqhd', p, v)


def attend_blocked(q, k, v):
    bsz, n, h, dq = q.shape
    qb = jnp.moveaxis(q.reshape(bsz, n // Q_BLOCK, Q_BLOCK, h, dq), 1, 0)
    out = lax.map(lambda qi: attend(qi, k, v), qb)
    return jnp.moveaxis(out, 0, 1).reshape(bsz, n, h, v.shape[-1])


def multiscale_pool(u, pool_w, pool_scale):
    bsz, n, _ = u.shape
    uf = u.astype(jnp.float32)
    cs = jnp.pad(jnp.cumsum(uf, axis=1), ((0, 0), (1, 0), (0, 0)))
    t = jnp.arange(n)
    outs = []
    for gi, w in enumerate(POOL_WINDOWS):
        sl = slice(gi * POOL_GROUP_DIM, (gi + 1) * POOL_GROUP_DIM)
        lo = jnp.clip(t - w // 2, 0, n)
        hi = jnp.clip(t + w - w // 2, 0, n)
        csg = cs[..., sl]
        mean = (jnp.take(csg, hi, axis=1) - jnp.take(csg, lo, axis=1)) / (hi - lo).astype(jnp.float32)[:, None]
        outs.append(mean - uf[..., sl])
    d = jnp.stack(outs, axis=2)
    y = jnp.einsum('blgc,gcd->blgd', d, pool_w.astype(jnp.float32)).reshape(bsz, n, POOL_DIM)
    return (y * pool_scale.astype(jnp.float32)).astype(u.dtype)


def hybrid_layer(x, ctx, c, c_ctx, rope, mod_w, mod_b, norm1_w, norm2_w, w_in, conv_w, conv_b,
                 dt_bias, a_log, ssd_d, ssd_norm_w, q_a_norm_w, w_q_b, kv_a_norm_w, w_kv_b,
                 pool_w, pool_scale, w_out, w_mlp1, w_mlp2, update_ctx):
    bsz, n, _ = x.shape
    m = ctx.shape[1]
    sh1, sc1, g1, sh2, sc2, g2 = adaln(c, mod_w, mod_b)
    csh1, csc1, cg1, csh2, csc2, cg2 = adaln(c_ctx, mod_w, mod_b)
    px = modulate(rmsnorm(x, norm1_w), sh1, sc1) @ w_in
    pc = modulate(rmsnorm(ctx, norm1_w), csh1, csc1) @ w_in

    a = -jnp.exp(a_log.astype(jnp.float32))
    zc, xsc, bmc, cmc, dtc = ssd_inputs(pc, conv_w, conv_b, dt_bias)
    zx, xsx, bmx, cmx, dtx = ssd_inputs(px, conv_w, conv_b, dt_bias)
    h_zero = jnp.zeros((bsz, SSD_HEADS, SSD_HEAD_DIM, SSD_STATE), jnp.float32)
    yc, hf_ctx, hb_ctx = ssd_bidirectional(xsc, bmc, cmc, dtc, a, h_zero, h_zero)
    yx, _, _ = ssd_bidirectional(xsx, bmx, cmx, dtx, a, hf_ctx, hb_ctx)
    ssd_x = ssd_output(yx, xsx, zx, ssd_d, ssd_norm_w)

    qc, kc, vc = mla_qkv(pc, q_a_norm_w, w_q_b, kv_a_norm_w, w_kv_b, None)
    qx, kx, vx = mla_qkv(px, q_a_norm_w, w_q_b, kv_a_norm_w, w_kv_b, rope)
    attn_x = attend_blocked(qx, jnp.concatenate([kx, kc], axis=1), jnp.concatenate([vx, vc], axis=1))

    pool_x = multiscale_pool(px[..., OFF_POOL:], pool_w, pool_scale)

    mix_x = jnp.concatenate([ssd_x, attn_x.reshape(bsz, n, MLA_OUT), pool_x], axis=-1) @ w_out
    x = x + g1 * mix_x
    x = x + g2 * squared_relu_mlp(modulate(rmsnorm(x, norm2_w), sh2, sc2), w_mlp1, w_mlp2)

    if update_ctx:
        ssd_c = ssd_output(yc, xsc, zc, ssd_d, ssd_norm_w)
        attn_c = attend(qc, kc, vc).reshape(bsz, m, MLA_OUT)
        pool_c = multiscale_pool(pc[..., OFF_POOL:], pool_w, pool_scale)
        mix_c = jnp.concatenate([ssd_c, attn_c, pool_c], axis=-1) @ w_out
        ctx = ctx + cg1 * mix_c
        ctx = ctx + cg2 * squared_relu_mlp(modulate(rmsnorm(ctx, norm2_w), csh2, csc2), w_mlp1, w_mlp2)
    return x, ctx


def setup_inputs(seed: int = 0) -> dict:
    key = jax.random.key(seed)
    ks = jax.random.split(key, 32)
    f32 = jnp.float32

    def nrm(k, shape, scale):
        return jax.random.normal(k, shape, f32) * scale

    def gain(k, shape):
        return 1.0 + 0.02 * jax.random.normal(k, shape, f32)

    dt0 = jnp.exp(jax.random.uniform(ks[11], (DEPTH, 2, SSD_HEADS), f32, math.log(1e-3), math.log(1e-1)))
    return {
        "x": nrm(ks[0], (BATCH, SEQ, D_MODEL), 1.0),
        "c": nrm(ks[1], (BATCH, D_MODEL), 1.0),
        "ctx": nrm(ks[2], (BATCH, CTX_LEN, D_MODEL), 1.0),
        "c_ctx": nrm(ks[3], (D_MODEL,), 1.0),
        "mod_w": nrm(ks[4], (DEPTH, D_MODEL, 6 * D_MODEL), 0.5 * D_MODEL ** -0.5),
        "mod_b": nrm(ks[5], (DEPTH, 6 * D_MODEL), 0.01),
        "norm1_w": gain(ks[6], (DEPTH, D_MODEL)),
        "norm2_w": gain(ks[7], (DEPTH, D_MODEL)),
        "w_in": nrm(ks[8], (DEPTH, D_MODEL, IN_COLS), D_MODEL ** -0.5),
        "conv_w": nrm(ks[9], (DEPTH, SSD_CONV, XBC_DIM), SSD_CONV ** -0.5),
        "conv_b": nrm(ks[10], (DEPTH, XBC_DIM), 0.01),
        "dt_bias": dt0 + jnp.log(-jnp.expm1(-dt0)),
        "a_log": jnp.log(jax.random.uniform(ks[12], (DEPTH, 2, SSD_HEADS), f32, 1.0, 16.0)),
        "ssd_d": 1.0 + 0.1 * jax.random.normal(ks[13], (DEPTH, SSD_HEADS), f32),
        "ssd_norm_w": gain(ks[14], (DEPTH, SSD_INNER)),
        "q_a_norm_w": gain(ks[15], (DEPTH, Q_LORA)),
        "w_q_b": nrm(ks[16], (DEPTH, Q_LORA, MLA_HEADS * QK_DIM), Q_LORA ** -0.5),
        "kv_a_norm_w": gain(ks[17], (DEPTH, KV_LORA)),
        "w_kv_b": nrm(ks[18], (DEPTH, KV_LORA, MLA_HEADS * (QK_NOPE + V_HEAD)), KV_LORA ** -0.5),
        "pool_w": nrm(ks[19], (DEPTH, POOL_GROUPS, POOL_GROUP_DIM, POOL_GROUP_DIM), POOL_GROUP_DIM ** -0.5),
        "pool_scale": gain(ks[20], (DEPTH, POOL_DIM)),
        "w_out": nrm(ks[21], (DEPTH, MIX_DIM, D_MODEL), MIX_DIM ** -0.5),
        "w_mlp1": nrm(ks[22], (DEPTH, D_MODEL, D_FF), D_MODEL ** -0.5),
        "w_mlp2": nrm(ks[23], (DEPTH, D_FF, D_MODEL), D_FF ** -0.5),
        "final_norm_w": gain(ks[24], (D_MODEL,)),
    }


def reference(x, c, ctx, c_ctx, mod_w, mod_b, norm1_w, norm2_w, w_in, conv_w, conv_b, dt_bias, a_log,
              ssd_d, ssd_norm_w, q_a_norm_w, w_q_b, kv_a_norm_w, w_kv_b, pool_w, pool_scale, w_out,
              w_mlp1, w_mlp2, final_norm_w):
    rope = axial_rope_tables(x.shape[1])
    for i in range(DEPTH):
        x, ctx = hybrid_layer(x, ctx, c, c_ctx, rope, mod_w[i], mod_b[i], norm1_w[i], norm2_w[i], w_in[i],
                              conv_w[i], conv_b[i], dt_bias[i], a_log[i], ssd_d[i], ssd_norm_w[i],
                              q_a_norm_w[i], w_q_b[i], kv_a_norm_w[i], w_kv_b[i], pool_w[i], pool_scale[i],
                              w_out[i], w_mlp1[i], w_mlp2[i], update_ctx=(i < DEPTH - 1))
    return rmsnorm(x, final_norm_w)
```

```cpp
#include <hip/hip_runtime.h>
#include <hip/hip_cooperative_groups.h>
#include <cstdio>
#include <cstdint>
namespace cg = cooperative_groups;

#ifndef MULTI_LAUNCH
#define MULTI_LAUNCH 0
#endif
#ifndef ONLY
#define ONLY -1
#endif
#define EN(k) (ONLY < 0 || ONLY == (k))
#ifndef REPEAT_MASK
#define REPEAT_MASK 0
#endif

#define DI __device__ __forceinline__
typedef unsigned short bf16_t;
using bf16x8 = __attribute__((ext_vector_type(8))) short;
using f32x16 = __attribute__((ext_vector_type(16))) float;
typedef __bf16 bfv2 __attribute__((ext_vector_type(2)));
typedef float f32v2 __attribute__((ext_vector_type(2)));
#define MFMA(a, b, c) __builtin_amdgcn_mfma_f32_32x32x16_bf16((a), (b), (c), 0, 0, 0)

constexpr int NB = 16, LSEQ = 4096, CTXL = 256, TT = 4352;
constexpr int MT = NB * TT;
constexpr int DM = 1024, DFF = 4096;
constexpr int NP = 2176;
constexpr int C_Z = 0, C_XBC = 384, C_DT = 1280, C_QA = 1344, C_KVA = 1600, C_KR = 1856, C_POOL = 1888;
constexpr int IN_COLS = 2092;
constexpr int NPHASE = 20;
constexpr int MISC_OFF = 145408;
constexpr int SMEM_BYTES = MISC_OFF + 1024 + 256;
constexpr int NPW = 2304;
constexpr int NQ = 768;
constexpr int SSD_LDS_EL = 36352;

constexpr size_t al256(size_t x) { return (x + 255) & ~(size_t)255; }
constexpr size_t O_WT_IN = 0;
constexpr size_t O_WT_OUT = O_WT_IN + al256((size_t)2 * NPW * 1024 * 2);
constexpr size_t O_WT_M1 = O_WT_OUT + al256((size_t)2 * 1024 * 1024 * 2);
constexpr size_t O_WT_M2 = O_WT_M1 + al256((size_t)2 * 4096 * 1024 * 2);
constexpr size_t O_WT_QB = O_WT_M2 + al256((size_t)2 * 1024 * 4096 * 2);
constexpr size_t O_WT_KVB = O_WT_QB + al256((size_t)2 * NQ * 256 * 2);
constexpr size_t O_MODS = O_WT_KVB + al256((size_t)2 * 768 * 256 * 2);
constexpr size_t O_ROPE = O_MODS + al256((size_t)2 * 17 * 6144 * 4);
constexpr size_t O_CTR = O_ROPE + al256(64 * 8 * 2 * 4);
constexpr size_t O_BAR = O_CTR + 256;
constexpr size_t O_RSS = O_BAR + 16384;
constexpr size_t O_CTXRES = O_RSS + al256((size_t)2 * MT * 4);
constexpr size_t O_XN = O_CTXRES + al256((size_t)NB * CTXL * DM * 4);
constexpr size_t O_YSSD = O_XN + al256((size_t)MT * DM * 2);
constexpr size_t O_BIG = O_YSSD + al256((size_t)2 * MT * 384 * 2);
constexpr size_t O_PROJ = O_BIG;
constexpr size_t O_XBC = O_PROJ + al256((size_t)MT * NP * 2);
constexpr size_t O_Q = O_XBC + al256((size_t)MT * 896 * 2);
constexpr size_t O_K = O_Q + al256((size_t)NB * 6 * TT * 96 * 2);
constexpr size_t O_VT = O_K + al256((size_t)NB * 6 * TT * 96 * 2);
constexpr size_t O_END1 = O_VT + al256((size_t)NB * 6 * 64 * TT * 2);
constexpr size_t O_END2 = O_BIG + (size_t)MT * DFF * 2;
constexpr size_t WS_NEED = O_END1 > O_END2 ? O_END1 : O_END2;

struct Params {
  const float *x, *c, *ctx, *c_ctx, *mod_w, *mod_b, *norm1_w, *norm2_w, *w_in, *conv_w, *conv_b, *dt_bias, *a_log,
      *ssd_d, *ssd_norm_w, *q_a_norm_w, *w_q_b, *kv_a_norm_w, *w_kv_b, *pool_w, *pool_scale, *w_out, *w_mlp1, *w_mlp2,
      *final_norm_w;
  float* out;
  char* ws;
  DI bf16_t* wt_in() const { return (bf16_t*)(ws + O_WT_IN); }
  DI bf16_t* wt_out() const { return (bf16_t*)(ws + O_WT_OUT); }
  DI bf16_t* wt_m1() const { return (bf16_t*)(ws + O_WT_M1); }
  DI bf16_t* wt_m2() const { return (bf16_t*)(ws + O_WT_M2); }
  DI bf16_t* wt_qb() const { return (bf16_t*)(ws + O_WT_QB); }
  DI bf16_t* wt_kvb() const { return (bf16_t*)(ws + O_WT_KVB); }
  DI float* mods() const { return (float*)(ws + O_MODS); }
  DI float* rope() const { return (float*)(ws + O_ROPE); }
  DI int* ctr() const { return (int*)(ws + O_CTR); }
  DI unsigned* bar() const { return (unsigned*)(ws + O_BAR); }
  DI float* rss() const { return (float*)(ws + O_RSS); }
  DI float* ctxres() const { return (float*)(ws + O_CTXRES); }
  DI bf16_t* xn() const { return (bf16_t*)(ws + O_XN); }
  DI bf16_t* yssd() const { return (bf16_t*)(ws + O_YSSD); }
  DI bf16_t* proj() const { return (bf16_t*)(ws + O_PROJ); }
  DI bf16_t* xbc() const { return (bf16_t*)(ws + O_XBC); }
  DI bf16_t* Q() const { return (bf16_t*)(ws + O_Q); }
  DI bf16_t* Kc() const { return (bf16_t*)(ws + O_K); }
  DI bf16_t* Vt() const { return (bf16_t*)(ws + O_VT); }
  DI bf16_t* hidden() const { return (bf16_t*)(ws + O_BIG); }
};

DI unsigned pack2(float a, float b) {
  f32v2 v = {a, b};
  bfv2 r = __builtin_convertvector(v, bfv2);
  return __builtin_bit_cast(unsigned, r);
}
DI bf16_t f2bf(float a) { return (bf16_t)(pack2(a, 0.f) & 0xffffu); }
DI float bf2f(bf16_t v) { return __uint_as_float(((unsigned)v) << 16); }
DI float bflo(unsigned w) { return __uint_as_float(w << 16); }
DI float bfhi(unsigned w) { return __uint_as_float(w & 0xffff0000u); }
DI float silu(float x) { return x / (1.f + __expf(-x)); }
DI int crow(int reg, int h) { return (reg & 3) + 8 * (reg >> 2) + 4 * h; }
DI float wave_sum(float v) {
#pragma unroll
  for (int o = 32; o >= 1; o >>= 1) v += __shfl_xor(v, o);
  return v;
}
DI bf16x8 pack8(const f32x16& x, int s) {
  uint4 u;
  u.x = pack2(x[8 * s + 0], x[8 * s + 1]);
  u.y = pack2(x[8 * s + 2], x[8 * s + 3]);
  u.z = pack2(x[8 * s + 4], x[8 * s + 5]);
  u.w = pack2(x[8 * s + 6], x[8 * s + 7]);
  return __builtin_bit_cast(bf16x8, u);
}
DI bf16x8 join8(uint2 lo, uint2 hi) {
  uint4 u; u.x = lo.x; u.y = lo.y; u.z = hi.x; u.w = hi.y;
  return __builtin_bit_cast(bf16x8, u);
}
DI int ogrid() { return gridDim.x; }
DI int obid() { return blockIdx.x; }
DI int ogrid_op() { int g = gridDim.x; asm volatile("" : "+s"(g)); return g; }
DI int otid() { int t = threadIdx.x; asm volatile("" : "+v"(t)); return t; }
DI unsigned xb_ld(unsigned* p) { return __hip_atomic_load(p, __ATOMIC_RELAXED, __HIP_MEMORY_SCOPE_AGENT); }
DI unsigned xb_add(unsigned* p, unsigned v) { return __hip_atomic_fetch_add(p, v, __ATOMIC_RELAXED, __HIP_MEMORY_SCOPE_AGENT); }
DI unsigned xb_xcc_id() { return (unsigned)__builtin_amdgcn_s_getreg((3 << 11) | 20) & 0xFu; }
#define XB_TMO      128
#define XB_XCNT(j)  (256  + 64 * (j))
#define XB_XSUB(j)  (1280 + 64 * (j))
#define XB_XGEN(j)  (2304 + 64 * (j))
#define XB_TOP      3328
#define XB_TOPGEN   3392
#define XCD_BAR_WORDS 3456
#define XB_SPIN_CAP (1u << 18)
#define XB_SPIN(cond, bar) do { unsigned _sp = 0; while (cond) { __builtin_amdgcn_s_sleep(1); \
    if ((++_sp & 255u) == 0u) { if (xb_ld(&(bar)[XB_TMO])) break; if (_sp > XB_SPIN_CAP) { atomicAdd(&(bar)[XB_TMO], 1u); break; } } } } while (0)
DI f32x16 zero16() { f32x16 z; for (int i = 0; i < 16; ++i) z[i] = 0.f; return z; }

DI float* res_row(const Params& p, int b, int t) {
  return t < LSEQ ? p.out + ((size_t)b * LSEQ + t) * DM : p.ctxres() + ((size_t)b * CTXL + (t - LSEQ)) * DM;
}
DI const float* in_row(const Params& p, int b, int t) {
  return t < LSEQ ? p.x + ((size_t)b * LSEQ + t) * DM : p.ctx + ((size_t)b * CTXL + (t - LSEQ)) * DM;
}

using f32x4 = __attribute__((ext_vector_type(4))) float;
constexpr int GBK = 64, GHALF = 128, GHT = GHALF * GBK;
#define LAS __attribute__((address_space(3)))
DI int lds_byte(int r, int c) {
  const int st = (r >> 4) * 2 + (c >> 5), rr = r & 15, cc = c & 31, ob = rr * 64 + cc * 2;
  return st * 1024 + (ob ^ (((ob >> 9) & 1) << 5));
}
DI void stage_rc(int b, int& R, int& C) {
  const int st = b / 1024, sb = b % 1024, swz = sb ^ (((sb >> 9) & 1) << 5);
  R = (st >> 1) * 16 + swz / 64;
  C = (st & 1) * 32 + (swz % 64) / 2;
}
typedef f32x4 acc_t[2][2][4][2];

template <bool RMS, class Epi, class UnitFn>
DI void gemm256(const bf16_t* __restrict__ A, int lda, const bf16_t* __restrict__ Bt, int ldb, int K,
                bf16_t* shm, Epi& epi, UnitFn unit) {
  const int tid = otid();
  const int wid = tid >> 6, lane = tid & 63, wr = wid >> 2, wc = wid & 3, fr = lane & 15, fq = lane >> 4;
  float* rs = (float*)((char*)shm + MISC_OFF);
  const int ldst0 = tid * 16;
  const unsigned swave = (unsigned)__builtin_amdgcn_readfirstlane((int)((unsigned)(size_t)(LAS char*)shm + (unsigned)((tid & ~63) * 16)));
  unsigned la0, la1, lb0, lb1;
  {
    int r0_, c0_, r1_, c1_;
    stage_rc(ldst0, r0_, c0_);
    stage_rc(ldst0 + 8192, r1_, c1_);
    la0 = (unsigned)(r0_ * lda + c0_) * 2u; la1 = (unsigned)(r1_ * lda + c1_) * 2u;
    lb0 = (unsigned)(r0_ * ldb + c0_) * 2u; lb1 = (unsigned)(r1_ * ldb + c1_) * 2u;
  }
#define SA(b, h) (shm + ((b) * 2 + (h)) * GHT)
#define SB(b, h) (shm + (4 + (b) * 2 + (h)) * GHT)
#define GLDS(voff, sbase, m0v)                                                                           \
  asm volatile("s_mov_b32 m0, %2\n\ts_nop 0\n\tglobal_load_lds_dwordx4 %0, %1" ::"v"(voff), "s"(sbase), "s"(m0v) : "memory", "m0")
#define STAGE(PB, BASE, LD, br, kt, L0, L1)                                                               \
  do {                                                                                                    \
    const char* _ub = (const char*)((BASE) + (long)(br) * (LD) + (long)(kt) * GBK);                       \
    const unsigned _m = swave + (unsigned)(PB);                                                           \
    GLDS(L0, _ub, _m);                                                                                    \
    GLDS(L1, _ub, _m + 8192u);                                                                            \
  } while (0)
#define SAB(b, h) ((((b) * 2 + (h)) * GHT) * 2)
#define SBB(b, h) (((4 + (b) * 2 + (h)) * GHT) * 2)
#define STA(P, br, kt) STAGE(P, A, lda, br, kt, la0, la1)
#define STB(P, br, kt) STAGE(P, Bt, ldb, br, kt, lb0, lb1)
#define LDA(dst, b, h)                                                                                    \
  _Pragma("unroll") for (int m = 0; m < 4; ++m) _Pragma("unroll") for (int k = 0; k < 2; ++k)             \
      dst[m][k] = *reinterpret_cast<const bf16x8*>((const char*)SA(b, h) + lds_byte(wr * 64 + m * 16 + fr, k * 32 + fq * 8))
#define LDB(dst, b, h)                                                                                    \
  _Pragma("unroll") for (int n = 0; n < 2; ++n) _Pragma("unroll") for (int k = 0; k < 2; ++k)             \
      dst[n][k] = *reinterpret_cast<const bf16x8*>((const char*)SB(b, h) + lds_byte(wc * 32 + n * 16 + fr, k * 32 + fq * 8))
#define MMA(ai, bj, At_, Bt_)                                                                             \
  do {                                                                                                    \
    __builtin_amdgcn_s_setprio(1);                                                                        \
    _Pragma("unroll") for (int m = 0; m < 4; ++m) _Pragma("unroll") for (int n = 0; n < 2; ++n)           \
        _Pragma("unroll") for (int k = 0; k < 2; ++k) acc[ai][bj][m][n] =                                 \
            __builtin_amdgcn_mfma_f32_16x16x32_bf16(Bt_[n][k], At_[m][k], acc[ai][bj][m][n], 0, 0, 0);   \
    __builtin_amdgcn_s_setprio(0);                                                                        \
  } while (0)
#define WAIT_V(n) asm volatile("s_waitcnt vmcnt(" #n ")" ::: "memory")
#define WAIT_L(n) asm volatile("s_waitcnt lgkmcnt(" #n ")" ::: "memory")
#define BAR __builtin_amdgcn_s_barrier()
#define SCHED __builtin_amdgcn_sched_barrier(0)
#define PROLOGUE(br_, bc_)                                                                                 \
  do {                                                                                                    \
    STB(SBB(0, 0), (bc_), 0); STA(SAB(0, 0), (br_), 0);                                                   \
    STB(SBB(0, 1), (bc_) + GHALF, 0); STA(SAB(0, 1), (br_) + GHALF, 0);                                   \
    STB(SBB(1, 0), (bc_), 1); STA(SAB(1, 0), (br_), 1); STB(SBB(1, 1), (bc_) + GHALF, 1);                 \
  } while (0)
  int brow = 0, bcol = 0;
  if (!unit(0, brow, bcol)) return;
  if (!RMS) PROLOGUE(brow, bcol);
  for (int ui = 0;; ++ui) {
  int nbrow = 0, nbcol = 0;
  const bool more = unit(ui + 1, nbrow, nbcol);
  if (RMS) {
    const int row = tid >> 1, half = tid & 1;
    const bf16_t* ap = A + (size_t)(brow + row) * lda + half * 128;
    float ss = 0.f;
#pragma unroll 4
    for (int i = 0; i < 16; ++i) {
      uint4 v = *(const uint4*)(ap + i * 8);
      float f;
      f = bflo(v.x); ss += f * f; f = bfhi(v.x); ss += f * f;
      f = bflo(v.y); ss += f * f; f = bfhi(v.y); ss += f * f;
      f = bflo(v.z); ss += f * f; f = bfhi(v.z); ss += f * f;
      f = bflo(v.w); ss += f * f; f = bfhi(v.w); ss += f * f;
    }
    ss += __shfl_xor(ss, 1);
    if (half == 0) rs[row] = rsqrtf(ss * (1.f / 256.f) + 1e-6f);
    WAIT_V(0);
    PROLOGUE(brow, bcol);
  }
  acc_t acc;
#pragma unroll
  for (int i0 = 0; i0 < 2; ++i0)
#pragma unroll
    for (int i1 = 0; i1 < 2; ++i1)
#pragma unroll
      for (int i2 = 0; i2 < 4; ++i2)
#pragma unroll
        for (int i3 = 0; i3 < 2; ++i3) acc[i0][i1][i2][i3] = (f32x4){0.f, 0.f, 0.f, 0.f};
  bf16x8 At[4][2], B0[2][2], B1[2][2];
  const int nt = K / GBK;
  if (wr == 1) BAR;
  WAIT_V(10); BAR;
  WAIT_V(6); BAR;
  for (int t = 0; t < nt - 2; t += 2) {
    LDB(B0, 0, 0); SCHED; LDA(At, 0, 0); STA(SAB(1, 1), brow + GHALF, t + 1);
    WAIT_L(8); BAR; WAIT_L(0); MMA(0, 0, At, B0); BAR; SCHED;
    LDB(B1, 0, 1); STB(SBB(0, 0), bcol, t + 2);
    BAR; WAIT_L(0); MMA(0, 1, At, B1); BAR;
    LDA(At, 0, 1); STA(SAB(0, 0), brow, t + 2);
    BAR; WAIT_L(0); MMA(1, 0, At, B0); BAR; SCHED;
    STB(SBB(0, 1), bcol + GHALF, t + 2);
    WAIT_V(6); BAR; MMA(1, 1, At, B1); BAR;
    LDB(B0, 1, 0); SCHED; LDA(At, 1, 0); STA(SAB(0, 1), brow + GHALF, t + 2);
    WAIT_L(8); BAR; WAIT_L(0); MMA(0, 0, At, B0); BAR; SCHED;
    LDB(B1, 1, 1); STB(SBB(1, 0), bcol, t + 3);
    BAR; WAIT_L(0); MMA(0, 1, At, B1); BAR;
    LDA(At, 1, 1); STA(SAB(1, 0), brow, t + 3);
    BAR; WAIT_L(0); MMA(1, 0, At, B0); BAR; SCHED;
    STB(SBB(1, 1), bcol + GHALF, t + 3);
    WAIT_V(6); BAR; MMA(1, 1, At, B1); BAR;
  }
  {
    LDB(B0, 0, 0); LDA(At, 0, 0); STA(SAB(1, 1), brow + GHALF, nt - 1);
    BAR; WAIT_L(0); MMA(0, 0, At, B0); BAR;
    LDB(B1, 0, 1); BAR; WAIT_L(0); MMA(0, 1, At, B1); BAR;
    LDA(At, 0, 1); WAIT_V(4); BAR; WAIT_L(0); MMA(1, 0, At, B0); MMA(1, 1, At, B1); BAR;
  }
  {
    LDB(B0, 1, 0); LDA(At, 1, 0); WAIT_V(2); BAR; WAIT_L(0); MMA(0, 0, At, B0); BAR;
    LDB(B1, 1, 1); WAIT_V(0); BAR; WAIT_L(0); MMA(0, 1, At, B1); BAR;
    LDA(At, 1, 1); BAR; WAIT_L(0); MMA(1, 0, At, B0); MMA(1, 1, At, B1); BAR;
  }
  if (wr == 0) BAR;
  if (!RMS && more) { PROLOGUE(nbrow, nbcol); }
  epi(acc, brow, bcol, wr, wc, fr, fq, rs);
  if (RMS) __syncthreads();
  if (!more) break;
  brow = nbrow; bcol = nbcol;
  }
}

template <bool RMS, class Epi>
DI void gemm256_unit(const bf16_t* __restrict__ A, int lda, const bf16_t* __restrict__ Bt, int ldb, int K, int brow, int bcol,
                bf16_t* shm, Epi& epi) {
  const int tid = otid();
  const int wid = tid >> 6, lane = tid & 63, wr = wid >> 2, wc = wid & 3, fr = lane & 15, fq = lane >> 4;
  float* rs = (float*)((char*)shm + MISC_OFF);
  const int ldst0 = tid * 16;
  const unsigned swave = (unsigned)__builtin_amdgcn_readfirstlane((int)((unsigned)(size_t)(LAS char*)shm + (unsigned)((tid & ~63) * 16)));
  unsigned la0, la1, lb0, lb1;
  {
    int r0_, c0_, r1_, c1_;
    stage_rc(ldst0, r0_, c0_);
    stage_rc(ldst0 + 8192, r1_, c1_);
    la0 = (unsigned)(r0_ * lda + c0_) * 2u; la1 = (unsigned)(r1_ * lda + c1_) * 2u;
    lb0 = (unsigned)(r0_ * ldb + c0_) * 2u; lb1 = (unsigned)(r1_ * ldb + c1_) * 2u;
  }
  if (RMS) {
    const int row = tid >> 1, half = tid & 1;
    const bf16_t* ap = A + (size_t)(brow + row) * lda + half * 128;
    float ss = 0.f;
#pragma unroll 4
    for (int i = 0; i < 16; ++i) {
      uint4 v = *(const uint4*)(ap + i * 8);
      float f;
      f = bflo(v.x); ss += f * f; f = bfhi(v.x); ss += f * f;
      f = bflo(v.y); ss += f * f; f = bfhi(v.y); ss += f * f;
      f = bflo(v.z); ss += f * f; f = bfhi(v.z); ss += f * f;
      f = bflo(v.w); ss += f * f; f = bfhi(v.w); ss += f * f;
    }
    ss += __shfl_xor(ss, 1);
    if (half == 0) rs[row] = rsqrtf(ss * (1.f / 256.f) + 1e-6f);
    WAIT_V(0);
  }
  acc_t acc;
#pragma unroll
  for (int i0 = 0; i0 < 2; ++i0)
#pragma unroll
    for (int i1 = 0; i1 < 2; ++i1)
#pragma unroll
      for (int i2 = 0; i2 < 4; ++i2)
#pragma unroll
        for (int i3 = 0; i3 < 2; ++i3) acc[i0][i1][i2][i3] = (f32x4){0.f, 0.f, 0.f, 0.f};
  bf16x8 At[4][2], B0[2][2], B1[2][2];
  const int nt = K / GBK;
  STB(SBB(0, 0), bcol, 0); STA(SAB(0, 0), brow, 0);
  STB(SBB(0, 1), bcol + GHALF, 0); STA(SAB(0, 1), brow + GHALF, 0);
  if (wr == 1) BAR;
  WAIT_V(4); BAR;
  STB(SBB(1, 0), bcol, 1); STA(SAB(1, 0), brow, 1); STB(SBB(1, 1), bcol + GHALF, 1);
  WAIT_V(6); BAR;
  for (int t = 0; t < nt - 2; t += 2) {
    LDB(B0, 0, 0); SCHED; LDA(At, 0, 0); STA(SAB(1, 1), brow + GHALF, t + 1);
    WAIT_L(8); BAR; WAIT_L(0); MMA(0, 0, At, B0); BAR; SCHED;
    LDB(B1, 0, 1); STB(SBB(0, 0), bcol, t + 2);
    BAR; WAIT_L(0); MMA(0, 1, At, B1); BAR;
    LDA(At, 0, 1); STA(SAB(0, 0), brow, t + 2);
    BAR; WAIT_L(0); MMA(1, 0, At, B0); BAR; SCHED;
    STB(SBB(0, 1), bcol + GHALF, t + 2);
    WAIT_V(6); BAR; MMA(1, 1, At, B1); BAR;
    LDB(B0, 1, 0); SCHED; LDA(At, 1, 0); STA(SAB(0, 1), brow + GHALF, t + 2);
    WAIT_L(8); BAR; WAIT_L(0); MMA(0, 0, At, B0); BAR; SCHED;
    LDB(B1, 1, 1); STB(SBB(1, 0), bcol, t + 3);
    BAR; WAIT_L(0); MMA(0, 1, At, B1); BAR;
    LDA(At, 1, 1); STA(SAB(1, 0), brow, t + 3);
    BAR; WAIT_L(0); MMA(1, 0, At, B0); BAR; SCHED;
    STB(SBB(1, 1), bcol + GHALF, t + 3);
    WAIT_V(6); BAR; MMA(1, 1, At, B1); BAR;
  }
  {
    LDB(B0, 0, 0); LDA(At, 0, 0); STA(SAB(1, 1), brow + GHALF, nt - 1);
    BAR; WAIT_L(0); MMA(0, 0, At, B0); BAR;
    LDB(B1, 0, 1); BAR; WAIT_L(0); MMA(0, 1, At, B1); BAR;
    LDA(At, 0, 1); WAIT_V(4); BAR; WAIT_L(0); MMA(1, 0, At, B0); MMA(1, 1, At, B1); BAR;
  }
  {
    LDB(B0, 1, 0); LDA(At, 1, 0); WAIT_V(2); BAR; WAIT_L(0); MMA(0, 0, At, B0); BAR;
    LDB(B1, 1, 1); WAIT_V(0); BAR; WAIT_L(0); MMA(0, 1, At, B1); BAR;
    LDA(At, 1, 1); BAR; WAIT_L(0); MMA(1, 0, At, B0); MMA(1, 1, At, B1); BAR;
  }
  if (wr == 0) BAR;
  epi(acc, brow, bcol, wr, wc, fr, fq, rs);
  __syncthreads();
}


DI bool unit_next(int i, int nM, int nN, int& pm, int& pn) {
  const int nwg = nM * nN;
  const long L = (long)i * ogrid() + obid();
  if (L >= nwg) return false;
  int wgid = (int)L;
  {
    const int q = nwg / 8, r = nwg % 8, xcd = wgid % 8, off = wgid / 8;
    wgid = (xcd < r ? xcd * (q + 1) : r * (q + 1) + (xcd - r) * q) + off;
  }
  const int nig = 8 * nN, gid = wgid / nig, fm = gid * 8, gsz = (nM - fm) < 8 ? (nM - fm) : 8;
  pm = fm + ((wgid % nig) % gsz);
  pn = (wgid % nig) / gsz;
  return true;
}

#define EPI_LOOP                                                   \
  _Pragma("unroll") for (int ai = 0; ai < 2; ++ai)                 \
  _Pragma("unroll") for (int m = 0; m < 4; ++m)                    \
  _Pragma("unroll") for (int bj = 0; bj < 2; ++bj)                 \
  _Pragma("unroll") for (int n = 0; n < 2; ++n)
struct EpiProj {
  bf16_t* proj; float* rss;
  DI void operator()(const acc_t& acc, int brow, int bcol, int wr, int wc, int fr, int fq, const float* rs) const {
    EPI_LOOP {
      const int row = brow + ai * 128 + wr * 64 + m * 16 + fr, col = bcol + bj * 128 + wc * 32 + n * 16 + 4 * fq;
      if (col < NP) {
        const f32x4 v = acc[ai][bj][m][n];
        uint2 u; u.x = pack2(v[0], v[1]); u.y = pack2(v[2], v[3]);
        *(uint2*)(proj + (size_t)row * NP + col) = u;
      }
    }
    if (bcol + 256 > C_QA && bcol < C_KR) {
#pragma unroll
      for (int ai = 0; ai < 2; ++ai)
#pragma unroll
        for (int m = 0; m < 4; ++m) {
          float sq = 0.f, sk = 0.f;
#pragma unroll
          for (int bj = 0; bj < 2; ++bj)
#pragma unroll
            for (int n = 0; n < 2; ++n) {
              const int col = bcol + bj * 128 + wc * 32 + n * 16 + 4 * fq;
              const f32x4 v = acc[ai][bj][m][n];
              const float t = v[0] * v[0] + v[1] * v[1] + v[2] * v[2] + v[3] * v[3];
              sq += (col >= C_QA && col < C_KVA) ? t : 0.f;
              sk += (col >= C_KVA && col < C_KR) ? t : 0.f;
            }
          sq += __shfl_xor(sq, 16); sq += __shfl_xor(sq, 32);
          sk += __shfl_xor(sk, 16); sk += __shfl_xor(sk, 32);
          if (fq == 0) {
            const int row = brow + ai * 128 + wr * 64 + m * 16 + fr;
            if (sq != 0.f) unsafeAtomicAdd(rss + row, sq);
            if (sk != 0.f) unsafeAtomicAdd(rss + MT + row, sk);
          }
        }
    }
  }
};
struct EpiRelu2 {
  bf16_t* hid;
  DI void operator()(const acc_t& acc, int brow, int bcol, int wr, int wc, int fr, int fq, const float* rs) const {
    EPI_LOOP {
      const int row = brow + ai * 128 + wr * 64 + m * 16 + fr, col = bcol + bj * 128 + wc * 32 + n * 16 + 4 * fq;
      const f32x4 v = acc[ai][bj][m][n];
      const float a0 = fmaxf(v[0], 0.f), a1 = fmaxf(v[1], 0.f), a2 = fmaxf(v[2], 0.f), a3 = fmaxf(v[3], 0.f);
      uint2 u; u.x = pack2(a0 * a0, a1 * a1); u.y = pack2(a2 * a2, a3 * a3);
      *(uint2*)(hid + (size_t)row * DFF + col) = u;
    }
  }
};
struct EpiRes {
  const Params* p; int layer; int gate_off; bool from_input;
  DI void operator()(const acc_t& acc, int brow, int bcol, int wr, int wc, int fr, int fq, const float* rs) const {
    const int b = brow / TT, tb = brow - b * TT;
    const bool isctx = tb >= LSEQ;
    const float* gp = p->mods() + ((size_t)layer * 17 + (isctx ? 16 : b)) * 6144 + gate_off;
    EPI_LOOP {
      const int lr = ai * 128 + wr * 64 + m * 16 + fr, col = bcol + bj * 128 + wc * 32 + n * 16 + 4 * fq;
      const f32x4 v = acc[ai][bj][m][n];
      const float4 g = *(const float4*)(gp + col);
      float* dst = res_row(*p, b, tb + lr) + col;
      const float4 s = from_input ? *(const float4*)(in_row(*p, b, tb + lr) + col) : *(const float4*)dst;
      float4 o; o.x = s.x + g.x * v[0]; o.y = s.y + g.y * v[1]; o.z = s.z + g.z * v[2]; o.w = s.w + g.w * v[3];
      *(float4*)dst = o;
    }
  }
};
struct EpiQ {
  const Params* p;
  DI void operator()(const acc_t& acc, int brow, int bcol, int wr, int wc, int fr, int fq, const float* rs) const {
    float rq[8];
#pragma unroll
    for (int i = 0; i < 8; ++i) rq[i] = rsqrtf(p->rss()[0 + brow + (i >> 2) * 128 + wr * 64 + (i & 3) * 16 + fr] * (1.f / 256.f) + 1e-6f);
    const int b = brow / TT, tb = brow - b * TT;
    EPI_LOOP {
      const int lr = ai * 128 + wr * 64 + m * 16 + fr, col = bcol + bj * 128 + wc * 32 + n * 16 + 4 * fq;
      if (col < 576) {
        const int hh = col / 96, d = col - hh * 96;
        const f32x4 v = acc[ai][bj][m][n];
        const float sc = rq[ai * 4 + m];
        uint2 u; u.x = pack2(v[0] * sc, v[1] * sc); u.y = pack2(v[2] * sc, v[3] * sc);
        *(uint2*)(p->Q() + ((size_t)(b * 6 + hh) * TT + tb + lr) * 96 + d) = u;
      }
    }
  }
};
struct EpiKV {
  const Params* p;
  DI void operator()(const acc_t& acc, int brow, int bcol, int wr, int wc, int fr, int fq, const float* rs) const {
    float rq[8];
#pragma unroll
    for (int i = 0; i < 8; ++i) rq[i] = rsqrtf(p->rss()[MT + brow + (i >> 2) * 128 + wr * 64 + (i & 3) * 16 + fr] * (1.f / 256.f) + 1e-6f);
    const int b = brow / TT, tb = brow - b * TT;
    EPI_LOOP {
      const int lr = ai * 128 + wr * 64 + m * 16 + fr, col = bcol + bj * 128 + wc * 32 + n * 16 + 4 * fq;
      const int hh = col >> 7, j = col & 127;
      const f32x4 v = acc[ai][bj][m][n];
      const float sc = rq[ai * 4 + m];
      if (j < 64) {
        uint2 u; u.x = pack2(v[0] * sc, v[1] * sc); u.y = pack2(v[2] * sc, v[3] * sc);
        *(uint2*)(p->Kc() + ((size_t)(b * 6 + hh) * TT + tb + lr) * 96 + j) = u;
      } else {
        bf16_t* vp = p->Vt() + ((size_t)(b * 6 + hh) * 64 + (j - 64)) * TT + tb + lr;
        vp[0] = f2bf(v[0] * sc); vp[TT] = f2bf(v[1] * sc); vp[2 * TT] = f2bf(v[2] * sc); vp[3 * TT] = f2bf(v[3] * sc);
      }
    }
  }
};

DI void transpose_tile(const float* __restrict__ W, int N, int k0, int n0, bf16_t* __restrict__ dst, int ldd,
                       int shift_from, int shift_by, const float* rowscale, float gscale, float* tile) {
  const int tid = otid();
  const int lane = tid & 63, wave = tid >> 6;
  float4 v[8];
#pragma unroll
  for (int i = 0; i < 8; ++i) {
    const int k = k0 + wave + 8 * i, n = n0 + lane * 4;
    v[i] = make_float4(0.f, 0.f, 0.f, 0.f);
    if (n < N) {
      v[i] = *(const float4*)(W + (size_t)k * N + n);
      const float sc = (rowscale ? rowscale[k] : 1.f) * gscale;
      v[i].x *= sc; v[i].y *= sc; v[i].z *= sc; v[i].w *= sc;
    }
  }
#pragma unroll
  for (int i = 0; i < 8; ++i) {
    *(float4*)(tile + (wave + 8 * i) * 260 + lane * 4) = v[i];
  }
  __syncthreads();
  {
    const int nn = tid >> 1, kq = (tid & 1) * 32;
    const int n = n0 + nn;
    if (n < N) {
      const int drow = n >= shift_from ? n + shift_by : n;
      bf16_t* dp = dst + (size_t)drow * ldd + k0 + kq;
#pragma unroll
      for (int j = 0; j < 4; ++j) {
        const float* tp = tile + (kq + 8 * j) * 260 + nn;
        uint4 u;
        u.x = pack2(tp[0 * 260], tp[1 * 260]);
        u.y = pack2(tp[2 * 260], tp[3 * 260]);
        u.z = pack2(tp[4 * 260], tp[5 * 260]);
        u.w = pack2(tp[6 * 260], tp[7 * 260]);
        *(uint4*)(dp + 8 * j) = u;
      }
    }
  }
  __syncthreads();
}

DI void transpose_layer(const Params& p, int l, int first, int step, float* tile) {
  const float qscale = 0.10206207261596577f * 1.4426950408889634f;
  for (int v = first; v < 728; v += step) {
    if (v < 144) {
      const int kt = v / 9, nt = v - kt * 9;
      transpose_tile(p.w_in + (size_t)l * 1024 * IN_COLS, IN_COLS, kt * 64, nt * 256, p.wt_in() + (size_t)l * NPW * 1024, 1024, 1292, 52, nullptr, 1.f, tile);
    } else if (v < 192) {
      const int w = v - 144, kt = w >> 2, nt = w & 3;
      transpose_tile(p.w_out + (size_t)l * 1024 * 1024, 1024, kt * 64, nt * 256, p.wt_out() + (size_t)l * 1024 * 1024, 1024, 1 << 30, 0, nullptr, 1.f, tile);
    } else if (v < 448) {
      const int w = v - 192, kt = w >> 4, nt = w & 15;
      transpose_tile(p.w_mlp1 + (size_t)l * 1024 * 4096, 4096, kt * 64, nt * 256, p.wt_m1() + (size_t)l * 4096 * 1024, 1024, 1 << 30, 0, nullptr, 1.f, tile);
    } else if (v < 704) {
      const int w = v - 448, kt = w >> 2, nt = w & 3;
      transpose_tile(p.w_mlp2 + (size_t)l * 4096 * 1024, 1024, kt * 64, nt * 256, p.wt_m2() + (size_t)l * 1024 * 4096, 4096, 1 << 30, 0, nullptr, 1.f, tile);
    } else if (v < 716) {
      const int w = v - 704, kt = w / 3, nt = w - kt * 3;
      transpose_tile(p.w_q_b + (size_t)l * 256 * 576, 576, kt * 64, nt * 256, p.wt_qb() + (size_t)l * NQ * 256, 256, 1 << 30, 0, p.q_a_norm_w + l * 256, qscale, tile);
    } else {
      const int w = v - 716, kt = w / 3, nt = w - kt * 3;
      transpose_tile(p.w_kv_b + (size_t)l * 256 * 768, 768, kt * 64, nt * 256, p.wt_kvb() + (size_t)l * 768 * 256, 256, 1 << 30, 0, p.kv_a_norm_w + l * 256, 1.f, tile);
    }
  }
}

DI void phase_prep(const Params& p, bf16_t* smem) {
  float* tile = (float*)smem;
  const int tid = otid();
  const int gtid = obid() * 512 + tid, gsz = ogrid_op() * 512;
  if (gtid < 16) p.ctr()[gtid] = 0;
  if (gtid < 512) {
    const int pos = gtid >> 3, pair = gtid & 7;
    const float inv = powf(10000.f, -(float)pair / 8.f);
    const float ang = (float)pos * inv;
    p.rope()[gtid * 2] = cosf(ang);
    p.rope()[gtid * 2 + 1] = sinf(ang);
  }
  for (int i = gtid; i < 2 * 212 * 1024; i += gsz) {
    const int l = i / (212 * 1024), rem = i - l * 212 * 1024, rr = rem >> 10, k = rem & 1023;
    const int row = rr < 52 ? 1292 + rr : 2144 + (rr - 52);
    p.wt_in()[((size_t)l * NPW + row) * 1024 + k] = 0;
  }
  for (int i = gtid; i < 2 * 192 * 256; i += gsz) {
    const int l = i / (192 * 256), rem = i - l * 192 * 256;
    p.wt_qb()[(size_t)l * NQ * 256 + 576 * 256 + rem] = 0;
  }
  transpose_layer(p, 0, obid(), ogrid(), tile);
  {
    const int nn = tid & 63, c8 = __builtin_amdgcn_readfirstlane(tid >> 6);
    for (int it = obid(); it < 128; it += ogrid()) {
      const int l = it >> 6, g = (it >> 4) & 3, nblk = it & 15;
      const int n = nblk * 64 + nn;
      const float* wo = p.w_out + (size_t)l * 1024 * 1024 + (size_t)(768 + g * 64) * 1024 + n;
      const float* pw = p.pool_w + ((size_t)l * 4 + g) * 4096 + c8 * 8 * 64;
      const float* ps = p.pool_scale + l * 256 + g * 64;
      float o[8];
#pragma unroll
      for (int e = 0; e < 8; ++e) o[e] = 0.f;
#pragma unroll 8
      for (int d = 0; d < 64; ++d) {
        const float wv = wo[(size_t)d * 1024] * ps[d];
#pragma unroll
        for (int e = 0; e < 8; ++e) o[e] += pw[e * 64 + d] * wv;
      }
      uint4 u;
      u.x = pack2(o[0], o[1]); u.y = pack2(o[2], o[3]); u.z = pack2(o[4], o[5]); u.w = pack2(o[6], o[7]);
      *(uint4*)(p.wt_out() + (size_t)l * 1024 * 1024 + (size_t)n * 1024 + 768 + g * 64 + c8 * 8) = u;
    }
  }
  {
    float* sc = (float*)smem;
    const int lane = tid & 63, wave = tid >> 6;
    bool loaded = false;
    for (int it = ogrid() - 1 - obid(); it < 192; it += ogrid()) {
      const int l = it / 96, cb = it - l * 96;
      if (!loaded) {
        for (int i = tid; i < 17 * 1024; i += 512) {
          const int ci = i >> 10, k = i & 1023;
          const float v = ci < 16 ? p.c[ci * 1024 + k] : p.c_ctx[k];
          sc[i] = silu(v);
        }
        loaded = true;
        __syncthreads();
      }
      float acc[17];
#pragma unroll
      for (int i = 0; i < 17; ++i) acc[i] = 0.f;
      const float* mw = p.mod_w + (size_t)l * 1024 * 6144 + cb * 64 + lane;
      for (int k0 = wave * 128; k0 < wave * 128 + 128; k0 += 16) {
        float wv[16];
#pragma unroll
        for (int j = 0; j < 16; ++j) wv[j] = mw[(size_t)(k0 + j) * 6144];
#pragma unroll
        for (int j = 0; j < 16; ++j)
#pragma unroll
          for (int i = 0; i < 17; ++i) acc[i] += sc[i * 1024 + k0 + j] * wv[j];
      }
      float* sred = (float*)smem + 17 * 1024;
      for (int w = 0; w < 8; ++w) {
        if (wave == w) {
#pragma unroll
          for (int i = 0; i < 17; ++i) {
            if (w == 0) sred[i * 64 + lane] = acc[i];
            else sred[i * 64 + lane] += acc[i];
          }
        }
        __syncthreads();
      }
      for (int i = tid; i < 17 * 64; i += 512) {
        const int ci = i >> 6, cc = i & 63;
        p.mods()[((size_t)l * 17 + ci) * 6144 + cb * 64 + cc] = sred[i] + p.mod_b[l * 6144 + cb * 64 + cc];
      }
      __syncthreads();
    }
  }
}

DI void phase_norm(const Params& p, int layer, int which) {
  const int tid = otid(), lane = tid & 63, wave = tid >> 6;
  if (which == 1) { const int gs_ = ogrid_op() * 512; for (int i = obid() * 512 + tid; i < 2 * MT; i += gs_) p.rss()[i] = 0.f; }
  const float* nwt = (which == 1 ? p.norm1_w : p.norm2_w) + layer * 1024;
  const int chunk = (MT + ogrid() - 1) / ogrid();
  const int r_begin = obid() * chunk, r_end = min(MT, r_begin + chunk);
  float4 fw[4], fs[4];
  int cur_ci = -1;
  for (int r = r_begin + wave; r < r_end; r += 16) {
    const int r2 = r + 8;
    const bool has2 = r2 < r_end;
    const int b = r / TT, t = r - b * TT, b2 = r2 / TT, t2 = r2 - b2 * TT;
    const bool skip1 = t >= LSEQ && layer == 1 && which == 2;
    const bool skip2 = !has2 || (t2 >= LSEQ && layer == 1 && which == 2);
    const float* src1 = (layer == 0 && which == 1) ? in_row(p, b, t) : res_row(p, b, t);
    const float* src2 = (layer == 0 && which == 1) ? in_row(p, has2 ? b2 : b, has2 ? t2 : t) : res_row(p, has2 ? b2 : b, has2 ? t2 : t);
    float4 v1[4], v2[4];
#pragma unroll
    for (int i = 0; i < 4; ++i) {
      v1[i] = *(const float4*)(src1 + i * 256 + lane * 4);
      v2[i] = *(const float4*)(src2 + i * 256 + lane * 4);
    }
#pragma unroll
    for (int half = 0; half < 2; ++half) {
      const bool skip = half ? skip2 : skip1;
      if (skip) continue;
      const int rr = half ? r2 : r, bb = half ? b2 : b, tt = half ? t2 : t;
      const int ci = tt >= LSEQ ? 16 : bb;
      if (ci != cur_ci) {
        cur_ci = ci;
        const float* md = p.mods() + ((size_t)layer * 17 + ci) * 6144 + (which == 1 ? 0 : 3072);
#pragma unroll
        for (int i = 0; i < 4; ++i) {
          const int k = i * 256 + lane * 4;
          const float4 w = *(const float4*)(nwt + k);
          const float4 sc = *(const float4*)(md + 1024 + k);
          fs[i] = *(const float4*)(md + k);
          fw[i] = make_float4(w.x * (1.f + sc.x), w.y * (1.f + sc.y), w.z * (1.f + sc.z), w.w * (1.f + sc.w));
        }
      }
      float ss = 0.f;
#pragma unroll
      for (int i = 0; i < 4; ++i) {
        const float4 v = half ? v2[i] : v1[i];
        ss += v.x * v.x + v.y * v.y + v.z * v.z + v.w * v.w;
      }
      ss = wave_sum(ss);
      const float rstd = rsqrtf(ss * (1.f / 1024.f) + 1e-6f);
#pragma unroll
      for (int i = 0; i < 4; ++i) {
        const float4 v = half ? v2[i] : v1[i];
        uint2 u;
        u.x = pack2(v.x * rstd * fw[i].x + fs[i].x, v.y * rstd * fw[i].y + fs[i].y);
        u.y = pack2(v.z * rstd * fw[i].z + fs[i].z, v.w * rstd * fw[i].w + fs[i].w);
        *(uint2*)(p.xn() + (size_t)rr * DM + i * 256 + lane * 4) = u;
      }
    }
  }
}

DI void phase_final(const Params& p) {
  const int tid = otid(), lane = tid & 63, wave = tid >> 6;
  float4 fw[4];
#pragma unroll
  for (int i = 0; i < 4; ++i) fw[i] = *(const float4*)(p.final_norm_w + i * 256 + lane * 4);
  const int NR = NB * LSEQ;
  for (int r = obid() * 8 + wave; r < NR; r += ogrid() * 16) {
    const int r2 = r + ogrid() * 8;
    const bool has2 = r2 < NR;
    float* row1 = p.out + (size_t)r * DM;
    float* row2 = p.out + (size_t)(has2 ? r2 : r) * DM;
    float4 v1[4], v2[4];
#pragma unroll
    for (int i = 0; i < 4; ++i) {
      v1[i] = *(const float4*)(row1 + i * 256 + lane * 4);
      v2[i] = *(const float4*)(row2 + i * 256 + lane * 4);
    }
#pragma unroll
    for (int half = 0; half < 2; ++half) {
      if (half && !has2) continue;
      float* row = half ? row2 : row1;
      float ss = 0.f;
#pragma unroll
      for (int i = 0; i < 4; ++i) {
        const float4 v = half ? v2[i] : v1[i];
        ss += v.x * v.x + v.y * v.y + v.z * v.z + v.w * v.w;
      }
      ss = wave_sum(ss);
      const float rstd = rsqrtf(ss * (1.f / 1024.f) + 1e-6f);
#pragma unroll
      for (int i = 0; i < 4; ++i) {
        const float4 v = half ? v2[i] : v1[i];
        float4 o;
        o.x = v.x * rstd * fw[i].x; o.y = v.y * rstd * fw[i].y; o.z = v.z * rstd * fw[i].z; o.w = v.w * rstd * fw[i].w;
        *(float4*)(row + i * 256 + lane * 4) = o;
      }
    }
  }
}

DI int map_mtile(int skip_ctx, int i) { return skip_ctx ? (i >> 4) * 17 + (i & 15) : i; }

struct UnitOrder {
  int nM, nN, skip;
  DI bool operator()(int i, int& br, int& bc) const {
    int pm, pn;
    if (!unit_next(i, nM, nN, pm, pn)) return false;
    br = map_mtile(skip, pm) * 256;
    bc = pn * 256;
    return true;
  }
};
DI void phase_gemm_in(const Params& p, int layer, bf16_t* smem) {
  EpiProj epi{p.proj(), p.rss()};
  gemm256<false>(p.xn(), DM, p.wt_in() + (size_t)layer * NPW * 1024, 1024, 1024, smem, epi, UnitOrder{MT / 256, NPW / 256, 0});
}
DI void phase_gemm_qkv(const Params& p, int layer, bf16_t* smem) {
  EpiQ epq{&p};
  EpiKV epk{&p};
  int pm, pn;
  for (int i = 0; unit_next(i, MT / 256, 6, pm, pn); ++i) {
    if (pn < 3) gemm256_unit<false>(p.proj() + C_QA, NP, p.wt_qb() + (size_t)layer * NQ * 256, 256, 256, pm * 256, pn * 256, smem, epq);
    else gemm256_unit<false>(p.proj() + C_KVA, NP, p.wt_kvb() + (size_t)layer * 768 * 256, 256, 256, pm * 256, (pn - 3) * 256, smem, epk);
  }
}
DI void phase_gemm_out(const Params& p, int layer, bf16_t* smem) {
  EpiRes epi{&p, layer, 2048, layer == 0};
  const int skip = layer == 1;
  gemm256<false>(p.xn(), DM, p.wt_out() + (size_t)layer * 1024 * 1024, 1024, 1024, smem, epi, UnitOrder{skip ? NB * 16 : MT / 256, 4, skip});
}
DI void phase_gemm_m1(const Params& p, int layer, bf16_t* smem) {
  EpiRelu2 epi{p.hidden()};
  const int skip = layer == 1;
  gemm256<false>(p.xn(), DM, p.wt_m1() + (size_t)layer * 4096 * 1024, 1024, 1024, smem, epi, UnitOrder{skip ? NB * 16 : MT / 256, 16, skip});
}
DI void phase_gemm_m2(const Params& p, int layer, bf16_t* smem) {
  EpiRes epi{&p, layer, 5120, false};
  const int skip = layer == 1;
  gemm256<false>(p.hidden(), DFF, p.wt_m2() + (size_t)layer * 1024 * 4096, 4096, 4096, smem, epi, UnitOrder{skip ? NB * 16 : MT / 256, 4, skip});
}

DI void phase_tokops(const Params& p, int layer) {
  const int tid = otid();
  const int gtid = obid() * 512 + tid, gsz = ogrid_op() * 512;
  {
    const int nrt = gsz / 112;
    if (gtid < nrt * 112) {
      const int cg8 = (gtid % 112) * 8;
      const float* cw = p.conv_w + (size_t)layer * 4 * 896 + cg8;
      const float* cbp = p.conv_b + layer * 896 + cg8;
      float w[4][8], bias[8];
#pragma unroll
      for (int j = 0; j < 4; ++j)
#pragma unroll
        for (int e = 0; e < 8; ++e) w[j][e] = cw[j * 896 + e];
#pragma unroll
      for (int e = 0; e < 8; ++e) bias[e] = cbp[e];
      for (int run = gtid / 112; run < MT / 8; run += nrt) {
        const int r0 = run * 8;
        const int b = r0 / TT, tb = r0 - b * TT;
        const int seg_lo = tb < LSEQ ? 0 : LSEQ, seg_hi = tb < LSEQ ? LSEQ : TT;
        uint4 raw[11];
#pragma unroll
        for (int i = 0; i < 11; ++i) {
          const int tt = tb - 1 + i;
          if (tt >= seg_lo && tt < seg_hi) raw[i] = *(const uint4*)(p.proj() + ((size_t)b * TT + tt) * NP + C_XBC + cg8);
          else raw[i] = make_uint4(0, 0, 0, 0);
        }
#pragma unroll
        for (int o = 0; o < 8; ++o) {
          float a[8];
#pragma unroll
          for (int e = 0; e < 8; ++e) a[e] = bias[e];
#pragma unroll
          for (int j = 0; j < 4; ++j) {
            const uint4 u = raw[o + j];
            a[0] += w[j][0] * bflo(u.x); a[1] += w[j][1] * bfhi(u.x);
            a[2] += w[j][2] * bflo(u.y); a[3] += w[j][3] * bfhi(u.y);
            a[4] += w[j][4] * bflo(u.z); a[5] += w[j][5] * bfhi(u.z);
            a[6] += w[j][6] * bflo(u.w); a[7] += w[j][7] * bfhi(u.w);
          }
          uint4 ov;
          ov.x = pack2(silu(a[0]), silu(a[1])); ov.y = pack2(silu(a[2]), silu(a[3]));
          ov.z = pack2(silu(a[4]), silu(a[5])); ov.w = pack2(silu(a[6]), silu(a[7]));
          *(uint4*)(p.xbc() + ((size_t)b * TT + tb + o) * 896 + cg8) = ov;
        }
      }
    }
  }
  for (int idx = gtid; idx < MT * 2; idx += gsz) {
    const int r = idx >> 1, axis = idx & 1;
    const int b = r / TT, t = r - b * TT;
    const bf16_t* src = p.proj() + (size_t)r * NP + C_KR + axis * 16;
    const uint4 u1 = *(const uint4*)src, u2 = *(const uint4*)(src + 8);
    uint4 o1 = u1, o2 = u2;
    if (t < LSEQ) {
      const int pos = axis ? (t & 63) : (t >> 6);
      const float4* rp = (const float4*)(p.rope() + pos * 16);
      const float4 c0 = rp[0], c1 = rp[1], c2 = rp[2], c3 = rp[3];
      o1.x = pack2(bflo(u1.x) * c0.x - bflo(u2.x) * c0.y, bfhi(u1.x) * c0.z - bfhi(u2.x) * c0.w);
      o1.y = pack2(bflo(u1.y) * c1.x - bflo(u2.y) * c1.y, bfhi(u1.y) * c1.z - bfhi(u2.y) * c1.w);
      o1.z = pack2(bflo(u1.z) * c2.x - bflo(u2.z) * c2.y, bfhi(u1.z) * c2.z - bfhi(u2.z) * c2.w);
      o1.w = pack2(bflo(u1.w) * c3.x - bflo(u2.w) * c3.y, bfhi(u1.w) * c3.z - bfhi(u2.w) * c3.w);
      o2.x = pack2(bflo(u2.x) * c0.x + bflo(u1.x) * c0.y, bfhi(u2.x) * c0.z + bfhi(u1.x) * c0.w);
      o2.y = pack2(bflo(u2.y) * c1.x + bflo(u1.y) * c1.y, bfhi(u2.y) * c1.z + bfhi(u1.y) * c1.w);
      o2.z = pack2(bflo(u2.z) * c2.x + bflo(u1.z) * c2.y, bfhi(u2.z) * c2.z + bfhi(u1.z) * c2.w);
      o2.w = pack2(bflo(u2.w) * c3.x + bflo(u1.w) * c3.y, bfhi(u2.w) * c3.z + bfhi(u1.w) * c3.w);
    }
#pragma unroll
    for (int hh = 0; hh < 6; ++hh) {
      bf16_t* dst = p.Kc() + ((size_t)(b * 6 + hh) * TT + t) * 96 + 64 + axis * 16;
      *(uint4*)dst = o1;
      *(uint4*)(dst + 8) = o2;
    }
  }
  for (int idx = gtid; idx < (MT / 8) * 32; idx += gsz) {
    const int run = idx >> 5, cgp = idx & 31;
    const int r0 = run * 8;
    const int b = r0 / TT, t0 = r0 - b * TT;
    const int seg_lo = t0 < LSEQ ? 0 : LSEQ, seg_hi = t0 < LSEQ ? LSEQ : TT;
    const int g = cgp >> 3, half = 1 << g;
    const bf16_t* base = p.proj() + (size_t)b * TT * NP + C_POOL + cgp * 8;
    float a[8];
#pragma unroll
    for (int e = 0; e < 8; ++e) a[e] = 0.f;
    for (int tt = max(t0 - half, seg_lo); tt < min(t0 + half, seg_hi); ++tt) {
      const uint4 u = *(const uint4*)(base + (size_t)tt * NP);
      a[0] += bflo(u.x); a[1] += bfhi(u.x); a[2] += bflo(u.y); a[3] += bfhi(u.y);
      a[4] += bflo(u.z); a[5] += bfhi(u.z); a[6] += bflo(u.w); a[7] += bfhi(u.w);
    }
#pragma unroll
    for (int o = 0; o < 8; ++o) {
      const int t = t0 + o;
      const int lo = max(t - half, seg_lo), hi = min(t + half, seg_hi);
      const float inv = 1.f / (float)(hi - lo);
      const uint4 u = *(const uint4*)(base + (size_t)t * NP);
      uint4 ov;
      ov.x = pack2(a[0] * inv - bflo(u.x), a[1] * inv - bfhi(u.x));
      ov.y = pack2(a[2] * inv - bflo(u.y), a[3] * inv - bfhi(u.y));
      ov.z = pack2(a[4] * inv - bflo(u.z), a[5] * inv - bfhi(u.z));
      ov.w = pack2(a[6] * inv - bflo(u.w), a[7] * inv - bfhi(u.w));
      *(uint4*)(p.xn() + ((size_t)b * TT + t) * DM + 768 + cgp * 8) = ov;
      if (o < 7) {
        const int tin = t + half, tout = t - half;
        if (tin < seg_hi) {
          const uint4 w = *(const uint4*)(base + (size_t)tin * NP);
          a[0] += bflo(w.x); a[1] += bfhi(w.x); a[2] += bflo(w.y); a[3] += bfhi(w.y);
          a[4] += bflo(w.z); a[5] += bfhi(w.z); a[6] += bflo(w.w); a[7] += bfhi(w.w);
        }
        if (tout >= seg_lo) {
          const uint4 w = *(const uint4*)(base + (size_t)tout * NP);
          a[0] -= bflo(w.x); a[1] -= bfhi(w.x); a[2] -= bflo(w.y); a[3] -= bfhi(w.y);
          a[4] -= bflo(w.z); a[5] -= bfhi(w.z); a[6] -= bflo(w.w); a[7] -= bfhi(w.w);
        }
      }
    }
  }
}

typedef short s16x4 __attribute__((ext_vector_type(4)));
DI s16x4 tr4(const bf16_t* M, int LD, int krow, int ccol, int lane) {
  const int q = (lane & 15) >> 2, pp = lane & 3, blk = (lane >> 4) & 1;
  return __builtin_amdgcn_ds_read_tr16_b64_v4i16((LAS s16x4*)(LAS bf16_t*)(M + (krow + q) * LD + ccol + 16 * blk + 4 * pp));
}
DI bf16x8 cat8(s16x4 lo, s16x4 hi) { return __builtin_shufflevector(lo, hi, 0, 1, 2, 3, 4, 5, 6, 7); }

DI void ssd_store_x(bf16_t* sX, bf16_t* sXw, int row, int xch, uint4 g, float wl) {
  *(uint4*)(sX + row * 72 + xch) = g;
  uint4 u;
  u.x = pack2(bflo(g.x) * wl, bfhi(g.x) * wl);
  u.y = pack2(bflo(g.y) * wl, bfhi(g.y) * wl);
  u.z = pack2(bflo(g.z) * wl, bfhi(g.z) * wl);
  u.w = pack2(bflo(g.w) * wl, bfhi(g.w) * wl);
  *(uint4*)(sXw + row * 72 + xch) = u;
}
DI void ssd_job(const Params& p, int layer, int jobpair, bf16_t* smem_blk) {
  const int tid_full = otid(), jh = tid_full >> 8, tid = tid_full & 255;
  const int lane = tid & 63, wave = tid >> 6, r = lane & 31, h = lane >> 5;
  const int job = jobpair * 2 + jh;
  bf16_t* smem = smem_blk + jh * SSD_LDS_EL;
  const int b = job / 12, dir = (job / 6) & 1, head = job % 6, grp = head / 3;
  bf16_t* sB = smem;
  bf16_t* sC = sB + 64 * 136;
  bf16_t* sX = sC + 64 * 136;
  bf16_t* sXw = sX + 64 * 72;
  bf16_t* sH = sXw + 64 * 72;
  float* sfl = (float*)(sH + 64 * 136);
  const float a = -__expf(p.a_log[layer * 12 + dir * 6 + head]);
  const float dtb = p.dt_bias[layer * 12 + dir * 6 + head];
  for (int i = tid; i < 64 * 136 / 2; i += 256) ((unsigned*)sH)[i] = 0u;
  f32x16 hacc[2];
  hacc[0] = zero16();
  hacc[1] = zero16();
  const int pt = wave >> 1, lt = wave & 1;
  const int lidx = lt * 32 + r;
  const int brow_ = tid >> 4, bch = (tid & 15) * 8;
  const int xrow_ = tid >> 3, xch = (tid & 7) * 8;
  uint4 gB0, gB1, gB2, gB3, gC0, gC1, gC2, gC3, gX0, gX1;
  float dtraw = 0.f;
#define SSD_LOAD(it_)                                                                                  \
  do {                                                                                                 \
    const int sc_ = dir == 0 ? ((it_) < 4 ? 64 + (it_) : (it_) - 4) : 67 - (it_);                      \
    const bf16_t* base_ = p.xbc() + ((size_t)b * TT + sc_ * 64) * 896;                                 \
    if (wave == 0) {                                                                                   \
      const int tok_ = dir == 0 ? lane : 63 - lane;                                                    \
      dtraw = bf2f(p.proj()[((size_t)b * TT + sc_ * 64 + tok_) * NP + C_DT + dir * 6 + head]);         \
    }                                                                                                  \
    const bf16_t* bp_ = base_ + (size_t)brow_ * 896 + 384 + grp * 128 + bch;                            \
    gB0 = *(const uint4*)(bp_); gB1 = *(const uint4*)(bp_ + 16 * 896);                                  \
    gB2 = *(const uint4*)(bp_ + 32 * 896); gB3 = *(const uint4*)(bp_ + 48 * 896);                       \
    gC0 = *(const uint4*)(bp_ + 256); gC1 = *(const uint4*)(bp_ + 16 * 896 + 256);                      \
    gC2 = *(const uint4*)(bp_ + 32 * 896 + 256); gC3 = *(const uint4*)(bp_ + 48 * 896 + 256);           \
    const bf16_t* xp_ = base_ + (size_t)xrow_ * 896 + head * 64 + xch;                                  \
    gX0 = *(const uint4*)(xp_); gX1 = *(const uint4*)(xp_ + 32 * 896);                                  \
  } while (0)
#define SSD_SCAN(par_)                                                                                 \
  do {                                                                                                 \
    float* fl_ = sfl + (par_) * 200;                                                                   \
    const int tok = dir == 0 ? lane : 63 - lane;                                                       \
    const float xx = dtraw + dtb;                                                                      \
    const float dt = xx > 20.f ? xx : __logf(1.f + __expf(xx));                                        \
    float cs = dt * a;                                                                                 \
    _Pragma("unroll") for (int off = 1; off < 64; off <<= 1) {                                         \
      const float o_ = __shfl_up(cs, off);                                                             \
      if (lane >= off) cs += o_;                                                                       \
    }                                                                                                  \
    const float tot = __shfl(cs, 63);                                                                  \
    fl_[tok] = dt;                                                                                     \
    fl_[64 + tok] = cs;                                                                                \
    fl_[128 + tok] = dt * __expf(tot - cs);                                                            \
    if (lane == 0) fl_[192] = tot;                                                                     \
  } while (0)
  SSD_LOAD(0);
  if (wave == 0) SSD_SCAN(0);
  __syncthreads();
  for (int it = 0; it < 68; ++it) {
    const int sc = dir == 0 ? (it < 4 ? 64 + it : it - 4) : 67 - it;
    const size_t r0 = (size_t)b * TT + sc * 64;
    const float* fl = sfl + (it & 1) * 200;
    const float* sdt = fl;
    const float* scs = fl + 64;
    const float* sw = fl + 128;
    *(uint4*)(sB + (brow_ + 0) * 136 + bch) = gB0;  *(uint4*)(sC + (brow_ + 0) * 136 + bch) = gC0;
    *(uint4*)(sB + (brow_ + 16) * 136 + bch) = gB1; *(uint4*)(sC + (brow_ + 16) * 136 + bch) = gC1;
    *(uint4*)(sB + (brow_ + 32) * 136 + bch) = gB2; *(uint4*)(sC + (brow_ + 32) * 136 + bch) = gC2;
    *(uint4*)(sB + (brow_ + 48) * 136 + bch) = gB3; *(uint4*)(sC + (brow_ + 48) * 136 + bch) = gC3;
    ssd_store_x(sX, sXw, xrow_, xch, gX0, sw[xrow_]);
    ssd_store_x(sX, sXw, xrow_ + 32, xch, gX1, sw[xrow_ + 32]);
    { const int itn = it + 1 < 68 ? it + 1 : 67; SSD_LOAD(itn); }
    __syncthreads();
    bf16x8 creg[8];
#pragma unroll
    for (int ks = 0; ks < 8; ++ks) creg[ks] = *(const bf16x8*)(sC + lidx * 136 + ks * 16 + h * 8);
    f32x16 yacc = zero16();
    const float csl = scs[lidx];
#pragma unroll
    for (int st = 0; st < 2; ++st) {
      const bool skip = dir == 0 ? (st > lt) : (st < lt);
      if (!skip) {
        bf16x8 bf_[8];
#pragma unroll
        for (int ks = 0; ks < 8; ++ks) bf_[ks] = *(const bf16x8*)(sB + (st * 32 + r) * 136 + ks * 16 + h * 8);
        const s16x4 x0 = tr4(sX, 72, st * 32 + 4 * h, pt * 32, lane), x1 = tr4(sX, 72, st * 32 + 8 + 4 * h, pt * 32, lane);
        const s16x4 x2 = tr4(sX, 72, st * 32 + 16 + 4 * h, pt * 32, lane), x3 = tr4(sX, 72, st * 32 + 24 + 4 * h, pt * 32, lane);
        __builtin_amdgcn_sched_barrier(0);
        f32x16 sv = zero16();
#pragma unroll
        for (int ks = 0; ks < 8; ++ks) sv = MFMA(bf_[ks], creg[ks], sv);
#pragma unroll
        for (int g = 0; g < 4; ++g) {
          const float4 c4 = *(const float4*)(scs + st * 32 + 8 * g + 4 * h);
          const float4 d4 = *(const float4*)(sdt + st * 32 + 8 * g + 4 * h);
          const float cc[4] = {c4.x, c4.y, c4.z, c4.w};
          const float dd[4] = {d4.x, d4.y, d4.z, d4.w};
#pragma unroll
          for (int e = 0; e < 4; ++e) {
            const int sidx = st * 32 + 8 * g + 4 * h + e;
            const bool valid = dir == 0 ? (sidx <= lidx) : (sidx >= lidx);
            const float arg = valid ? (csl - cc[e]) : 0.f;
            const float dec = valid ? __expf(arg) * dd[e] : 0.f;
            sv[4 * g + e] *= dec;
          }
        }
        yacc = MFMA(cat8(x0, x1), pack8(sv, 0), yacc);
        yacc = MFMA(cat8(x2, x3), pack8(sv, 1), yacc);
      }
    }
    {
      bf16x8 hf_[8];
#pragma unroll
      for (int ks = 0; ks < 8; ++ks) hf_[ks] = *(const bf16x8*)(sH + (pt * 32 + r) * 136 + ks * 16 + h * 8);
      __builtin_amdgcn_sched_barrier(0);
      f32x16 yo = zero16();
#pragma unroll
      for (int ks = 0; ks < 8; ++ks) yo = MFMA(hf_[ks], creg[ks], yo);
      const float el = __expf(csl);
#pragma unroll
      for (int i = 0; i < 16; ++i) yacc[i] += el * yo[i];
    }
    {
      bf16_t* yout = p.yssd() + ((size_t)dir * MT + r0 + lidx) * 384 + head * 64 + pt * 32 + 4 * h;
#pragma unroll
      for (int g = 0; g < 4; ++g) {
        uint2 u;
        u.x = pack2(yacc[4 * g + 0], yacc[4 * g + 1]);
        u.y = pack2(yacc[4 * g + 2], yacc[4 * g + 3]);
        *(uint2*)(yout + 8 * g) = u;
      }
    }
    {
      const float et = __expf(fl[192]);
#pragma unroll
      for (int q = 0; q < 2; ++q)
#pragma unroll
        for (int i = 0; i < 16; ++i) hacc[q][i] *= et;
#pragma unroll
      for (int half = 0; half < 2; ++half) {
        bf16x8 av_[2], bv_[2][2];
#pragma unroll
        for (int k2 = 0; k2 < 2; ++k2) {
          const int ks = half * 2 + k2;
          av_[k2] = cat8(tr4(sXw, 72, ks * 16 + 8 * h, pt * 32, lane), tr4(sXw, 72, ks * 16 + 8 * h + 4, pt * 32, lane));
#pragma unroll
          for (int q = 0; q < 2; ++q) {
            const int nt = (wave & 1) * 2 + q;
            bv_[q][k2] = cat8(tr4(sB, 136, ks * 16 + 8 * h, nt * 32, lane), tr4(sB, 136, ks * 16 + 8 * h + 4, nt * 32, lane));
          }
        }
        __builtin_amdgcn_sched_barrier(0);
#pragma unroll
        for (int k2 = 0; k2 < 2; ++k2)
#pragma unroll
          for (int q = 0; q < 2; ++q) hacc[q] = MFMA(av_[k2], bv_[q][k2], hacc[q]);
        __builtin_amdgcn_sched_barrier(0);
      }
    }
    if (wave == 0 && it + 1 < 68) SSD_SCAN((it + 1) & 1);
    __syncthreads();
#pragma unroll
    for (int q = 0; q < 2; ++q) {
      const int nt = (wave & 1) * 2 + q;
#pragma unroll
      for (int reg = 0; reg < 16; ++reg) sH[(pt * 32 + crow(reg, h)) * 136 + nt * 32 + r] = f2bf(hacc[q][reg]);
    }
  }
#undef SSD_SCAN
#undef SSD_LOAD
  asm volatile("s_waitcnt vmcnt(0)" ::: "memory");
  __syncthreads();
  if (tid_full == 0) {
    __builtin_amdgcn_fence(__ATOMIC_RELEASE, "agent");
    asm volatile("s_waitcnt vmcnt(0)" ::: "memory");
    xb_add(p.bar() + 3700 + layer * 16 + b, 2u);
  }
  __syncthreads();
}

DI unsigned rope_word(unsigned mine, unsigned other, float4 cs, int h) {
  const float m0 = bflo(mine), m1 = bfhi(mine), o0 = bflo(other), o1 = bfhi(other);
  const float r0 = h ? (m0 * cs.x + o0 * cs.y) : (m0 * cs.x - o0 * cs.y);
  const float r1 = h ? (m1 * cs.z + o1 * cs.w) : (m1 * cs.z - o1 * cs.w);
  return pack2(r0, r1);
}
DI void attn_item(const Params& p, int b, int hh, int q0, int k_begin, int nkt, bf16_t* smem) {
  const int tid = otid(), lane = tid & 63, wave = tid >> 6, r = lane & 31, h = lane >> 5;
  const bf16_t* Kg = p.Kc() + ((size_t)(b * 6 + hh) * TT + k_begin) * 96;
  const bf16_t* Vg = p.Vt() + ((size_t)(b * 6 + hh) * 64) * TT + k_begin;
  const int qrow = q0 + wave * 32 + r;
  bf16x8 qreg[6];
  {
    const bf16_t* qp = p.Q() + ((size_t)(b * 6 + hh) * TT + qrow) * 96 + h * 8;
#pragma unroll
    for (int ks = 0; ks < 6; ++ks) qreg[ks] = *(const bf16x8*)(qp + ks * 16);
  }
  if (q0 < LSEQ) {
#pragma unroll
    for (int ax = 0; ax < 2; ++ax) {
      const int pos = ax ? (qrow & 63) : (qrow >> 6);
      const float* rp = p.rope() + pos * 16;
      const uint4 me = __builtin_bit_cast(uint4, qreg[4 + ax]);
      uint4 rr;
      rr.x = rope_word(me.x, __shfl_xor(me.x, 32), *(const float4*)(rp + 0), h);
      rr.y = rope_word(me.y, __shfl_xor(me.y, 32), *(const float4*)(rp + 4), h);
      rr.z = rope_word(me.z, __shfl_xor(me.z, 32), *(const float4*)(rp + 8), h);
      rr.w = rope_word(me.w, __shfl_xor(me.w, 32), *(const float4*)(rp + 12), h);
      qreg[4 + ax] = __builtin_bit_cast(bf16x8, rr);
    }
  }
  bf16_t* sK = smem;
  bf16_t* sV = smem + 2 * 64 * 104;
  uint4 rk0, rk1 = make_uint4(0u, 0u, 0u, 0u), rv;
  const int vrow = tid >> 3, vch = (tid & 7) * 8;
  const int kc1 = tid + 512;
  const int krow0 = tid / 12, kch0 = tid - krow0 * 12, krow1 = kc1 / 12, kch1 = kc1 - krow1 * 12;
#define K_LOAD(t_)                                                         \
  do {                                                                     \
    const bf16_t* kg_ = Kg + (size_t)(t_) * 64 * 96;                       \
    rk0 = *(const uint4*)(kg_ + (size_t)tid * 8);                          \
    if (tid < 256) rk1 = *(const uint4*)(kg_ + (size_t)kc1 * 8);           \
  } while (0)
#define K_STORE(buf_)                                                                      \
  do {                                                                                     \
    *(uint4*)(sK + ((buf_) * 64 + krow0) * 104 + kch0 * 8) = rk0;                          \
    if (tid < 256) *(uint4*)(sK + ((buf_) * 64 + krow1) * 104 + kch1 * 8) = rk1;           \
  } while (0)
#define V_LOAD(t_) rv = *(const uint4*)(Vg + (size_t)vrow * TT + (t_) * 64 + vch)
#define V_STORE(buf_)                                                                      \
  do {                                                                                     \
    bf16_t* vp_ = sV + ((buf_) * 64 + vrow) * 68 + vch;                                    \
    *(uint2*)vp_ = make_uint2(rv.x, rv.y);                                                 \
    *(uint2*)(vp_ + 4) = make_uint2(rv.z, rv.w);                                           \
  } while (0)
#define S_TILE(dst, buf_)                                                                                      \
  do {                                                                                                         \
    bf16x8 kf_[6];                                                                                             \
    const bf16_t* kb_ = sK + ((buf_) * 64 + r) * 104 + h * 8;                                                  \
    _Pragma("unroll") for (int ks = 0; ks < 6; ++ks) kf_[ks] = *(const bf16x8*)(kb_ + ks * 16);                \
    __builtin_amdgcn_sched_barrier(0);                                                                         \
    dst[0] = zero16();                                                                                         \
    _Pragma("unroll") for (int ks = 0; ks < 6; ++ks) dst[0] = MFMA(kf_[ks], qreg[ks], dst[0]);                 \
    __builtin_amdgcn_sched_barrier(0);                                                                         \
    _Pragma("unroll") for (int ks = 0; ks < 6; ++ks) kf_[ks] = *(const bf16x8*)(kb_ + 32 * 104 + ks * 16);     \
    __builtin_amdgcn_sched_barrier(0);                                                                         \
    dst[1] = zero16();                                                                                         \
    _Pragma("unroll") for (int ks = 0; ks < 6; ++ks) dst[1] = MFMA(kf_[ks], qreg[ks], dst[1]);                 \
    __builtin_amdgcn_sched_barrier(0);                                                                         \
  } while (0)
  K_LOAD(0); V_LOAD(0);
  K_STORE(0); V_STORE(0);
  if (nkt > 1) { K_LOAD(1); K_STORE(1); }
  __syncthreads();
  f32x16 o[2], o2, sc[2], negm;
  o[0] = zero16();
  o[1] = zero16();
  o2 = zero16();
  negm = zero16();
  bf16x8 ones;
  {
    const unsigned w = r == 0 ? 0x3F803F80u : 0u;
    uint4 u; u.x = w; u.y = w; u.z = w; u.w = w;
    ones = __builtin_bit_cast(bf16x8, u);
  }
#define S_CHAIN(dst, buf_)                                                                                 \
  do {                                                                                                     \
    bf16x8 kf_[6];                                                                                         \
    const bf16_t* kb_ = sK + ((buf_) * 64 + r) * 104 + h * 8;                                              \
    _Pragma("unroll") for (int ks = 0; ks < 6; ++ks) kf_[ks] = *(const bf16x8*)(kb_ + ks * 16);            \
    __builtin_amdgcn_sched_barrier(0);                                                                     \
    dst[0] = negm;                                                                                         \
    _Pragma("unroll") for (int ks = 0; ks < 6; ++ks) dst[0] = MFMA(kf_[ks], qreg[ks], dst[0]);             \
    __builtin_amdgcn_sched_barrier(0);                                                                     \
    _Pragma("unroll") for (int ks = 0; ks < 6; ++ks) kf_[ks] = *(const bf16x8*)(kb_ + 32 * 104 + ks * 16); \
    __builtin_amdgcn_sched_barrier(0);                                                                     \
    dst[1] = negm;                                                                                         \
    _Pragma("unroll") for (int ks = 0; ks < 6; ++ks) dst[1] = MFMA(kf_[ks], qreg[ks], dst[1]);             \
    __builtin_amdgcn_sched_barrier(0);                                                                     \
  } while (0)
#define ATT_STEP(sc_, sn_, kt_)                                                                            \
  do {                                                                                                     \
    const int buf = (kt_) & 1;                                                                             \
    if ((kt_) + 2 < nkt) K_LOAD((kt_) + 2);                                                                \
    if ((kt_) + 1 < nkt) { V_LOAD((kt_) + 1); S_CHAIN(sn_, buf ^ 1); }                                     \
    bf16x8 vf_[8];                                                                                         \
    _Pragma("unroll") for (int mt = 0; mt < 2; ++mt)                                                       \
    _Pragma("unroll") for (int s2 = 0; s2 < 2; ++s2)                                                       \
    _Pragma("unroll") for (int dt = 0; dt < 2; ++dt) {                                                     \
      const bf16_t* va = sV + (buf * 64 + dt * 32 + r) * 68 + mt * 32 + 16 * s2 + 4 * h;                   \
      vf_[(mt * 2 + s2) * 2 + dt] = join8(*(const uint2*)va, *(const uint2*)(va + 8));                     \
    }                                                                                                      \
    __builtin_amdgcn_sched_barrier(0);                                                                     \
    float mx = sc_[0][0];                                                                                  \
    _Pragma("unroll") for (int i = 1; i < 16; ++i) mx = fmaxf(mx, sc_[0][i]);                              \
    _Pragma("unroll") for (int i = 0; i < 16; ++i) mx = fmaxf(mx, sc_[1][i]);                              \
    mx = fmaxf(mx, __shfl_xor(mx, 32));                                                                    \
    if ((kt_) == 0 || __builtin_amdgcn_ballot_w64(mx > 8.f) != 0ull) {                                     \
      const float delta = ((kt_) == 0 || mx > 8.f) ? mx : 0.f;                                             \
      const float alpha = (kt_) == 0 ? 0.f : __builtin_amdgcn_exp2f(-delta);                               \
      _Pragma("unroll") for (int i = 0; i < 16; ++i) {                                                     \
        o[0][i] *= alpha; o[1][i] *= alpha; o2[i] *= alpha;                                                \
        sc_[0][i] -= delta; sc_[1][i] -= delta; sn_[0][i] -= delta; sn_[1][i] -= delta; negm[i] -= delta;  \
      }                                                                                                    \
    }                                                                                                      \
    _Pragma("unroll") for (int mt = 0; mt < 2; ++mt)                                                       \
    _Pragma("unroll") for (int i = 0; i < 16; ++i) sc_[mt][i] = __builtin_amdgcn_exp2f(sc_[mt][i]);        \
    _Pragma("unroll") for (int mt = 0; mt < 2; ++mt)                                                       \
    _Pragma("unroll") for (int s2 = 0; s2 < 2; ++s2) {                                                     \
      const bf16x8 pf = pack8(sc_[mt], s2);                                                                \
      o[0] = MFMA(vf_[(mt * 2 + s2) * 2 + 0], pf, o[0]);                                                   \
      o[1] = MFMA(vf_[(mt * 2 + s2) * 2 + 1], pf, o[1]);                                                   \
      o2 = MFMA(ones, pf, o2);                                                                             \
    }                                                                                                      \
    if ((kt_) + 2 < nkt) K_STORE(buf);                                                                     \
    if ((kt_) + 1 < nkt) V_STORE(buf ^ 1);                                                                 \
    __syncthreads();                                                                                       \
  } while (0)
  f32x16 sn[2];
  sn[0] = zero16();
  sn[1] = zero16();
  S_CHAIN(sc, 0);
  __syncthreads();
  for (int kt = 0; kt < nkt; kt += 2) {
    ATT_STEP(sc, sn, kt);
    ATT_STEP(sn, sc, kt + 1);
  }
#undef ATT_STEP
#undef S_CHAIN
  float l = __shfl(o2[0], r);
#undef K_LOAD
#undef K_STORE
#undef V_LOAD
#undef V_STORE
#undef S_TILE
  const float inv = 1.f / l;
  bf16_t* op = p.xn() + ((size_t)b * TT + qrow) * DM + 384 + hh * 64 + 4 * h;
#pragma unroll
  for (int dt = 0; dt < 2; ++dt)
#pragma unroll
    for (int g = 0; g < 4; ++g) {
      uint2 u;
      u.x = pack2(o[dt][4 * g + 0] * inv, o[dt][4 * g + 1] * inv);
      u.y = pack2(o[dt][4 * g + 2] * inv, o[dt][4 * g + 3] * inv);
      *(uint2*)(op + dt * 32 + 8 * g) = u;
    }
}

DI void ssd_out_rows(const Params& p, int layer, int r_begin, int nrows) {
  const int tid = otid(), lane = tid & 63, wave = tid >> 6;
  const int grp = lane >> 5, li = lane & 31;
  const int ch = grp * 192 + li * 6;
  float dsk[6], nw[6];
#pragma unroll
  for (int e = 0; e < 6; ++e) {
    dsk[e] = p.ssd_d[layer * 6 + (ch + e) / 64];
    nw[e] = p.ssd_norm_w[layer * 384 + ch + e];
  }
  for (int r = r_begin + wave; r < r_begin + nrows; r += 8) {
    const int b = r / TT, t = r - b * TT;
    if (t >= LSEQ && layer == 1) continue;
    const unsigned* yf = (const unsigned*)(p.yssd() + (size_t)r * 384 + ch);
    const unsigned* yb = (const unsigned*)(p.yssd() + ((size_t)MT + r) * 384 + ch);
    const unsigned* xs = (const unsigned*)(p.xbc() + (size_t)r * 896 + ch);
    const unsigned* zz = (const unsigned*)(p.proj() + (size_t)r * NP + C_Z + ch);
    float g[6];
    float ss = 0.f;
#pragma unroll
    for (int e2 = 0; e2 < 3; ++e2) {
      const unsigned a = yf[e2], bq = yb[e2], x = xs[e2], z = zz[e2];
      const float y0 = bflo(a) + bflo(bq) + bflo(x) * dsk[2 * e2];
      const float y1 = bfhi(a) + bfhi(bq) + bfhi(x) * dsk[2 * e2 + 1];
      g[2 * e2] = y0 * silu(bflo(z));
      g[2 * e2 + 1] = y1 * silu(bfhi(z));
      ss += g[2 * e2] * g[2 * e2] + g[2 * e2 + 1] * g[2 * e2 + 1];
    }
#pragma unroll
    for (int o = 16; o >= 1; o >>= 1) ss += __shfl_xor(ss, o);
    const float rstd = rsqrtf(ss * (1.f / 192.f) + 1e-6f);
    unsigned* dst = (unsigned*)(p.xn() + (size_t)r * DM + ch);
#pragma unroll
    for (int e2 = 0; e2 < 3; ++e2) dst[e2] = pack2(g[2 * e2] * rstd * nw[2 * e2], g[2 * e2 + 1] * rstd * nw[2 * e2 + 1]);
  }
}

DI void phase_mixers(const Params& p, int layer, bf16_t* smem, int rep) {
  if (EN(13) || ONLY == 3) for (int jp = obid(); jp < 96; jp += ogrid()) ssd_job(p, layer, jp, smem);
  if (ONLY == 13) return;
  if (layer == 0) {
    if (ogrid() > 96) { if (obid() >= 96) transpose_layer(p, 1, obid() - 96, ogrid() - 96, (float*)smem); }
    else transpose_layer(p, 1, obid(), ogrid(), (float*)smem);
  }
  volatile int* sitem = (volatile int*)((char*)smem + MISC_OFF + 1024);
  const int ipg = layer == 0 ? 17 : 16;
  const int nper = 12 * ipg;
  unsigned* qbase = p.bar() + 3616 + (layer + 2 * rep) * 8;
  const int xcc = (int)(xb_xcc_id() & 7u);
  for (int k = 0; k < 8; ++k) {
    const int xq = (xcc + k) & 7;
    while (true) {
      __syncthreads();
      if (threadIdx.x == 0) *sitem = (int)xb_add(qbase + xq, 1u);
      __syncthreads();
      const int idx = *sitem;
      if (idx >= nper) break;
      const int gi = idx / ipg, within = idx - gi * ipg;
      const int g = xq + 8 * gi;
      const int b = g / 6, hh = g - b * 6;
      if (within == 16) attn_item(p, b, hh, LSEQ, LSEQ, 4, smem);
      else attn_item(p, b, hh, within * 256, 0, 68, smem);
    }
  }
  {
    unsigned* done = p.bar() + 3700 + layer * 16;
    unsigned* rowq = p.bar() + 3740 + layer * 16;
    const int nchunk = layer == 0 ? 68 : 64;
    for (int bb = 0; bb < NB; ++bb) {
      __syncthreads();
      if (threadIdx.x == 0) {
        XB_SPIN(xb_ld(done + bb) < 12u, p.bar());
        __builtin_amdgcn_fence(__ATOMIC_ACQUIRE, "agent");
        asm volatile("s_waitcnt vmcnt(0)" ::: "memory");
      }
      __syncthreads();
      while (true) {
        if (threadIdx.x == 0) *sitem = (int)xb_add(rowq + bb, 1u);
        __syncthreads();
        const int c = *sitem;
        __syncthreads();
        if (c >= nchunk) break;
        ssd_out_rows(p, layer, bb * TT + c * 64, 64);
      }
    }
  }
}

struct XcdBarrier { unsigned* bar; unsigned x; volatile LAS unsigned* st; };
DI XcdBarrier xcd_barrier_post(unsigned* bar, volatile LAS unsigned* st) {
  XcdBarrier b; b.bar = bar; b.x = xb_xcc_id(); b.st = st;
  if (threadIdx.x == 0) (void)xb_add(&bar[XB_XCNT(b.x)], 1u);
  return b;
}
DI void xcd_barrier_complete(unsigned* bar, unsigned x, unsigned& nloc, unsigned& nx) {
  const unsigned G = gridDim.x * gridDim.y * gridDim.z;
  unsigned sum, cnt, mine, sp = 0u;
  for (;;) {
    sum = 0u; cnt = 0u; mine = 0u;
#pragma unroll
    for (unsigned j = 0; j < 16; ++j) { const unsigned c = xb_ld(&bar[XB_XCNT(j)]); sum += c; cnt += (c > 0u) ? 1u : 0u; mine = (j == x) ? c : mine; }
    if (sum == G) break;
    __builtin_amdgcn_s_sleep(1);
    if ((++sp & 255u) == 0u) { if (xb_ld(&bar[XB_TMO])) break; if (sp > XB_SPIN_CAP) { atomicAdd(&bar[XB_TMO], 1u); break; } }
  }
  nloc = mine > 0u ? mine : 1u; nx = cnt > 0u ? cnt : 1u;
}
DI void xcd_barrier(const XcdBarrier& b) {
  asm volatile("s_waitcnt vmcnt(0)" ::: "memory");
  __syncthreads();
  if (threadIdx.x == 0) {
    unsigned* bar = b.bar;
    __builtin_amdgcn_s_waitcnt(0);
    unsigned nloc = b.st[0], nx = b.st[1];
    if (nloc == 0u) { xcd_barrier_complete(bar, b.x, nloc, nx); b.st[0] = nloc; b.st[1] = nx; }
    const unsigned old = xb_add(&bar[XB_XSUB(b.x)], 1u);
    const unsigned gen = old / nloc;
    if (old + 1u == (gen + 1u) * nloc) {
      __builtin_amdgcn_fence(__ATOMIC_RELEASE, "agent");
      asm volatile("s_waitcnt vmcnt(0)" ::: "memory");
      const unsigned og = xb_add(&bar[XB_TOP], 1u);
      const unsigned tg = og / nx;
      if (og + 1u == (tg + 1u) * nx) xb_add(&bar[XB_TOPGEN], 1u);
      else XB_SPIN(xb_ld(&bar[XB_TOPGEN]) == tg, bar);
      __builtin_amdgcn_fence(__ATOMIC_ACQUIRE, "agent");
      xb_add(&bar[XB_XGEN(b.x)], 1u);
      asm volatile("s_waitcnt vmcnt(0)" ::: "memory");
    } else {
      XB_SPIN(xb_ld(&bar[XB_XGEN(b.x)]) == gen, bar);
      __builtin_amdgcn_fence(__ATOMIC_ACQUIRE, "agent");
      asm volatile("s_waitcnt vmcnt(0)" ::: "memory");
    }
  }
  __syncthreads();
}

DI void run_phase(const Params& p, int ph, bf16_t* smem, int rep) {
  if (ph == 0) { if (EN(10)) phase_prep(p, smem); return; }
  if (ph == NPHASE - 1) { if (EN(11)) phase_final(p); return; }
  const int layer = (ph - 1) / 9, s = (ph - 1) % 9;
  switch (s) {
    case 0: if (EN(0)) phase_norm(p, layer, 1); break;
    case 1: if (EN(1)) phase_gemm_in(p, layer, smem); break;
    case 2: if (EN(2)) phase_tokops(p, layer); if (EN(12)) phase_gemm_qkv(p, layer, smem); break;
    case 3: if (EN(3) || EN(13) || EN(14)) phase_mixers(p, layer, smem, rep); break;
    case 4: break;
    case 5: if (EN(5)) phase_gemm_out(p, layer, smem); break;
    case 6: if (EN(6)) phase_norm(p, layer, 2); break;
    case 7: if (EN(7)) phase_gemm_m1(p, layer, smem); break;
    default: if (EN(8)) phase_gemm_m2(p, layer, smem); break;
  }
}

__global__ void __launch_bounds__(512, 2) fwd_megakernel(Params p, int ph_begin, int ph_end) {
  __shared__ __attribute__((aligned(16))) unsigned char smem_raw[SMEM_BYTES];
  bf16_t* smem = (bf16_t*)smem_raw;
  cg::grid_group grid = cg::this_grid();
  volatile LAS unsigned* xst = (volatile LAS unsigned*)(LAS unsigned char*)(smem_raw + MISC_OFF + 1024 + 32);
  if (threadIdx.x == 0) { xst[0] = 0u; xst[1] = 0u; }
  __syncthreads();
  const XcdBarrier xb = xcd_barrier_post(p.bar(), xst);
  for (int ph = ph_begin; ph < ph_end; ++ph) {
    if (ph >= 1 && ph < NPHASE - 1 && (ph - 1) % 9 == 4) continue;
    run_phase(p, ph, smem, 0);
#if REPEAT_MASK
    if (ph >= 1 && ph < NPHASE - 1 && ((REPEAT_MASK >> ((ph - 1) % 9)) & 1)) {
      xcd_barrier(xb);
      run_phase(p, ph, smem, 1);
    }
#endif
    if (ph + 1 < ph_end) {
      if (ph == 0) grid.sync();
      else xcd_barrier(xb);
    }
  }
}

extern "C" void kernel_launch(void* const* d_in, const int* in_sizes, int n_in, void* d_out, int out_size, void* d_ws,
                              size_t ws_size, hipStream_t stream) {
  static int grid_blocks = 0;
  if (!grid_blocks) {
    int dev = 0, cus = 0, per_cu = 0;
    hipGetDevice(&dev);
    hipDeviceGetAttribute(&cus, hipDeviceAttributeMultiprocessorCount, dev);
    hipOccupancyMaxActiveBlocksPerMultiprocessor(&per_cu, fwd_megakernel, 512, 0);
    if (per_cu > 1) per_cu = 1;
    if (per_cu < 1) per_cu = 1;
    grid_blocks = cus * per_cu;
  }
  Params p{};
  const float** fp = (const float**)&p;
  for (int i = 0; i < 25; ++i) fp[i] = (const float*)d_in[i];
  p.out = (float*)d_out;
  p.ws = (char*)d_ws;
  if (WS_NEED > ws_size) fprintf(stderr, "workspace too small: need %zu have %zu\n", (size_t)WS_NEED, ws_size);
  hipMemsetAsync((char*)d_ws + O_BAR, 0, 16384, stream);
#if MULTI_LAUNCH
  for (int ph = 0; ph < NPHASE; ++ph)
    hipLaunchKernelGGL(fwd_megakernel, dim3(grid_blocks), dim3(512), 0, stream, p, ph, ph + 1);
#else
  int b0 = 0, b1 = NPHASE;
  void* args[] = {&p, &b0, &b1};
  hipError_t e = hipLaunchCooperativeKernel((void*)fwd_megakernel, dim3(grid_blocks), dim3(512), args, 0, stream);
  if (e != hipSuccess) fprintf(stderr, "cooperative launch failed: %s (grid %d)\n", hipGetErrorString(e), grid_blocks);
#endif
}
```

```cpp
#include <hip/hip_runtime.h>
#include <hip/hip_cooperative_groups.h>
#include <cstdio>
#include <cstdint>
namespace cg = cooperative_groups;

#ifndef MULTI_LAUNCH
#define MULTI_LAUNCH 0
#endif
#ifndef ONLY
#define ONLY -1
#endif
#define EN(k) (ONLY < 0 || ONLY == (k))
#ifndef REPEAT_MASK
#define REPEAT_MASK 0
#endif

#define DI __device__ __forceinline__
typedef unsigned short bf16_t;
using bf16x8 = __attribute__((ext_vector_type(8))) short;
using f32x16 = __attribute__((ext_vector_type(16))) float;
typedef __bf16 bfv2 __attribute__((ext_vector_type(2)));
typedef float f32v2 __attribute__((ext_vector_type(2)));
#define MFMA(a, b, c) __builtin_amdgcn_mfma_f32_32x32x16_bf16((a), (b), (c), 0, 0, 0)

constexpr int NB = 16, LSEQ = 4096, CTXL = 256, TT = 4352;
constexpr int MT = NB * TT;
constexpr int DM = 1024, DFF = 4096;
constexpr int NP = 2176;
constexpr int C_Z = 0, C_XBC = 384, C_DT = 1280, C_QA = 1344, C_KVA = 1600, C_KR = 1856, C_POOL = 1888;
constexpr int IN_COLS = 2092;
constexpr int NPHASE = 20;
constexpr int MISC_OFF = 145408;
constexpr int SMEM_BYTES = MISC_OFF + 1024 + 256;
constexpr int NPW = 2304;
constexpr int NQ = 768;
constexpr int SSD_LDS_EL = 36352;

constexpr size_t al256(size_t x) { return (x + 255) & ~(size_t)255; }
constexpr size_t O_WT_IN = 0;
constexpr size_t O_WT_OUT = O_WT_IN + al256((size_t)2 * NPW * 1024 * 2);
constexpr size_t O_WT_M1 = O_WT_OUT + al256((size_t)2 * 1024 * 1024 * 2);
constexpr size_t O_WT_M2 = O_WT_M1 + al256((size_t)2 * 4096 * 1024 * 2);
constexpr size_t O_WT_QB = O_WT_M2 + al256((size_t)2 * 1024 * 4096 * 2);
constexpr size_t O_WT_KVB = O_WT_QB + al256((size_t)2 * NQ * 256 * 2);
constexpr size_t O_MODS = O_WT_KVB + al256((size_t)2 * 768 * 256 * 2);
constexpr size_t O_ROPE = O_MODS + al256((size_t)2 * 17 * 6144 * 4);
constexpr size_t O_CTR = O_ROPE + al256(64 * 8 * 2 * 4);
constexpr size_t O_BAR = O_CTR + 256;
constexpr size_t O_RSS = O_BAR + 16384;
constexpr size_t O_CTXRES = O_RSS + al256((size_t)2 * MT * 4);
constexpr size_t O_XN = O_CTXRES + al256((size_t)NB * CTXL * DM * 4);
constexpr size_t O_YSSD = O_XN + al256((size_t)MT * DM * 2);
constexpr size_t O_BIG = O_YSSD + al256((size_t)2 * MT * 384 * 2);
constexpr size_t O_PROJ = O_BIG;
constexpr size_t O_XBC = O_PROJ + al256((size_t)MT * NP * 2);
constexpr size_t O_Q = O_XBC + al256((size_t)MT * 896 * 2);
constexpr size_t O_K = O_Q + al256((size_t)NB * 6 * TT * 96 * 2);
constexpr size_t O_VT = O_K + al256((size_t)NB * 6 * TT * 96 * 2);
constexpr size_t O_END1 = O_VT + al256((size_t)NB * 6 * 64 * TT * 2);
constexpr size_t O_END2 = O_BIG + (size_t)MT * DFF * 2;
constexpr size_t WS_NEED = O_END1 > O_END2 ? O_END1 : O_END2;

struct Params {
  const float *x, *c, *ctx, *c_ctx, *mod_w, *mod_b, *norm1_w, *norm2_w, *w_in, *conv_w, *conv_b, *dt_bias, *a_log,
      *ssd_d, *ssd_norm_w, *q_a_norm_w, *w_q_b, *kv_a_norm_w, *w_kv_b, *pool_w, *pool_scale, *w_out, *w_mlp1, *w_mlp2,
      *final_norm_w;
  float* out;
  char* ws;
  DI bf16_t* wt_in() const { return (bf16_t*)(ws + O_WT_IN); }
  DI bf16_t* wt_out() const { return (bf16_t*)(ws + O_WT_OUT); }
  DI bf16_t* wt_m1() const { return (bf16_t*)(ws + O_WT_M1); }
  DI bf16_t* wt_m2() const { return (bf16_t*)(ws + O_WT_M2); }
  DI bf16_t* wt_qb() const { return (bf16_t*)(ws + O_WT_QB); }
  DI bf16_t* wt_kvb() const { return (bf16_t*)(ws + O_WT_KVB); }
  DI float* mods() const { return (float*)(ws + O_MODS); }
  DI float* rope() const { return (float*)(ws + O_ROPE); }
  DI int* ctr() const { return (int*)(ws + O_CTR); }
  DI unsigned* bar() const { return (unsigned*)(ws + O_BAR); }
  DI float* rss() const { return (float*)(ws + O_RSS); }
  DI float* ctxres() const { return (float*)(ws + O_CTXRES); }
  DI bf16_t* xn() const { return (bf16_t*)(ws + O_XN); }
  DI bf16_t* yssd() const { return (bf16_t*)(ws + O_YSSD); }
  DI bf16_t* proj() const { return (bf16_t*)(ws + O_PROJ); }
  DI bf16_t* xbc() const { return (bf16_t*)(ws + O_XBC); }
  DI bf16_t* Q() const { return (bf16_t*)(ws + O_Q); }
  DI bf16_t* Kc() const { return (bf16_t*)(ws + O_K); }
  DI bf16_t* Vt() const { return (bf16_t*)(ws + O_VT); }
  DI bf16_t* hidden() const { return (bf16_t*)(ws + O_BIG); }
};

DI unsigned pack2(float a, float b) {
  f32v2 v = {a, b};
  bfv2 r = __builtin_convertvector(v, bfv2);
  return __builtin_bit_cast(unsigned, r);
}
DI bf16_t f2bf(float a) { return (bf16_t)(pack2(a, 0.f) & 0xffffu); }
DI float bf2f(bf16_t v) { return __uint_as_float(((unsigned)v) << 16); }
DI float bflo(unsigned w) { return __uint_as_float(w << 16); }
DI float bfhi(unsigned w) { return __uint_as_float(w & 0xffff0000u); }
DI float silu(float x) { return x / (1.f + __expf(-x)); }
DI int crow(int reg, int h) { return (reg & 3) + 8 * (reg >> 2) + 4 * h; }
DI float wave_sum(float v) {
#pragma unroll
  for (int o = 32; o >= 1; o >>= 1) v += __shfl_xor(v, o);
  return v;
}
DI bf16x8 pack8(const f32x16& x, int s) {
  uint4 u;
  u.x = pack2(x[8 * s + 0], x[8 * s + 1]);
  u.y = pack2(x[8 * s + 2], x[8 * s + 3]);
  u.z = pack2(x[8 * s + 4], x[8 * s + 5]);
  u.w = pack2(x[8 * s + 6], x[8 * s + 7]);
  return __builtin_bit_cast(bf16x8, u);
}
DI bf16x8 join8(uint2 lo, uint2 hi) {
  uint4 u; u.x = lo.x; u.y = lo.y; u.z = hi.x; u.w = hi.y;
  return __builtin_bit_cast(bf16x8, u);
}
DI int ogrid() { return gridDim.x; }
DI int obid() { return blockIdx.x; }
DI int ogrid_op() { int g = gridDim.x; asm volatile("" : "+s"(g)); return g; }
DI int otid() { int t = threadIdx.x; asm volatile("" : "+v"(t)); return t; }
DI unsigned xb_ld(unsigned* p) { return __hip_atomic_load(p, __ATOMIC_RELAXED, __HIP_MEMORY_SCOPE_AGENT); }
DI unsigned xb_add(unsigned* p, unsigned v) { return __hip_atomic_fetch_add(p, v, __ATOMIC_RELAXED, __HIP_MEMORY_SCOPE_AGENT); }
DI unsigned xb_xcc_id() { return (unsigned)__builtin_amdgcn_s_getreg((3 << 11) | 20) & 0xFu; }
#define XB_TMO      128
#define XB_XCNT(j)  (256  + 64 * (j))
#define XB_XSUB(j)  (1280 + 64 * (j))
#define XB_XGEN(j)  (2304 + 64 * (j))
#define XB_TOP      3328
#define XB_TOPGEN   3392
#define XCD_BAR_WORDS 3456
#define XB_SPIN_CAP (1u << 18)
#define XB_SPIN(cond, bar) do { unsigned _sp = 0; while (cond) { __builtin_amdgcn_s_sleep(1); \
    if ((++_sp & 255u) == 0u) { if (xb_ld(&(bar)[XB_TMO])) break; if (_sp > XB_SPIN_CAP) { atomicAdd(&(bar)[XB_TMO], 1u); break; } } } } while (0)
DI f32x16 zero16() { f32x16 z; for (int i = 0; i < 16; ++i) z[i] = 0.f; return z; }

DI float* res_row(const Params& p, int b, int t) {
  return t < LSEQ ? p.out + ((size_t)b * LSEQ + t) * DM : p.ctxres() + ((size_t)b * CTXL + (t - LSEQ)) * DM;
}
DI const float* in_row(const Params& p, int b, int t) {
  return t < LSEQ ? p.x + ((size_t)b * LSEQ + t) * DM : p.ctx + ((size_t)b * CTXL + (t - LSEQ)) * DM;
}

using f32x4 = __attribute__((ext_vector_type(4))) float;
constexpr int GBK = 64, GHALF = 128, GHT = GHALF * GBK;
#define LAS __attribute__((address_space(3)))
DI int lds_byte(int r, int c) {
  const int st = (r >> 4) * 2 + (c >> 5), rr = r & 15, cc = c & 31, ob = rr * 64 + cc * 2;
  return st * 1024 + (ob ^ (((ob >> 9) & 1) << 5));
}
DI void stage_rc(int b, int& R, int& C) {
  const int st = b / 1024, sb = b % 1024, swz = sb ^ (((sb >> 9) & 1) << 5);
  R = (st >> 1) * 16 + swz / 64;
  C = (st & 1) * 32 + (swz % 64) / 2;
}
typedef f32x4 acc_t[2][2][4][2];

template <bool RMS, class Epi, class UnitFn>
DI void gemm256(const bf16_t* __restrict__ A, int lda, const bf16_t* __restrict__ Bt, int ldb, int K,
                bf16_t* shm, Epi& epi, UnitFn unit) {
  const int tid = otid();
  const int wid = tid >> 6, lane = tid & 63, wr = wid >> 2, wc = wid & 3, fr = lane & 15, fq = lane >> 4;
  float* rs = (float*)((char*)shm + MISC_OFF);
  const int ldst0 = tid * 16;
  const unsigned swave = (unsigned)__builtin_amdgcn_readfirstlane((int)((unsigned)(size_t)(LAS char*)shm + (unsigned)((tid & ~63) * 16)));
  unsigned la0, la1, lb0, lb1;
  {
    int r0_, c0_, r1_, c1_;
    stage_rc(ldst0, r0_, c0_);
    stage_rc(ldst0 + 8192, r1_, c1_);
    la0 = (unsigned)(r0_ * lda + c0_) * 2u; la1 = (unsigned)(r1_ * lda + c1_) * 2u;
    lb0 = (unsigned)(r0_ * ldb + c0_) * 2u; lb1 = (unsigned)(r1_ * ldb + c1_) * 2u;
  }
#define SA(b, h) (shm + ((b) * 2 + (h)) * GHT)
#define SB(b, h) (shm + (4 + (b) * 2 + (h)) * GHT)
#define GLDS(voff, sbase, m0v)                                                                           \
  asm volatile("s_mov_b32 m0, %2\n\ts_nop 0\n\tglobal_load_lds_dwordx4 %0, %1" ::"v"(voff), "s"(sbase), "s"(m0v) : "memory", "m0")
#define STAGE(PB, BASE, LD, br, kt, L0, L1)                                                               \
  do {                                                                                                    \
    const char* _ub = (const char*)((BASE) + (long)(br) * (LD) + (long)(kt) * GBK);                       \
    const unsigned _m = swave + (unsigned)(PB);                                                           \
    GLDS(L0, _ub, _m);                                                                                    \
    GLDS(L1, _ub, _m + 8192u);                                                                            \
  } while (0)
#define SAB(b, h) ((((b) * 2 + (h)) * GHT) * 2)
#define SBB(b, h) (((4 + (b) * 2 + (h)) * GHT) * 2)
#define STA(P, br, kt) STAGE(P, A, lda, br, kt, la0, la1)
#define STB(P, br, kt) STAGE(P, Bt, ldb, br, kt, lb0, lb1)
#define LDA(dst, b, h)                                                                                    \
  _Pragma("unroll") for (int m = 0; m < 4; ++m) _Pragma("unroll") for (int k = 0; k < 2; ++k)             \
      dst[m][k] = *reinterpret_cast<const bf16x8*>((const char*)SA(b, h) + lds_byte(wr * 64 + m * 16 + fr, k * 32 + fq * 8))
#define LDB(dst, b, h)                                                                                    \
  _Pragma("unroll") for (int n = 0; n < 2; ++n) _Pragma("unroll") for (int k = 0; k < 2; ++k)             \
      dst[n][k] = *reinterpret_cast<const bf16x8*>((const char*)SB(b, h) + lds_byte(wc * 32 + n * 16 + fr, k * 32 + fq * 8))
#define MMA(ai, bj, At_, Bt_)                                                                             \
  do {                                                                                                    \
    __builtin_amdgcn_s_setprio(1);                                                                        \
    _Pragma("unroll") for (int m = 0; m < 4; ++m) _Pragma("unroll") for (int n = 0; n < 2; ++n)           \
        _Pragma("unroll") for (int k = 0; k < 2; ++k) acc[ai][bj][m][n] =                                 \
            __builtin_amdgcn_mfma_f32_16x16x32_bf16(Bt_[n][k], At_[m][k], acc[ai][bj][m][n], 0, 0, 0);   \
    __builtin_amdgcn_s_setprio(0);                                                                        \
  } while (0)
#define WAIT_V(n) asm volatile("s_waitcnt vmcnt(" #n ")" ::: "memory")
#define WAIT_L(n) asm volatile("s_waitcnt lgkmcnt(" #n ")" ::: "memory")
#define BAR __builtin_amdgcn_s_barrier()
#define SCHED __builtin_amdgcn_sched_barrier(0)
#define PROLOGUE(br_, bc_)                                                                                 \
  do {                                                                                                    \
    STB(SBB(0, 0), (bc_), 0); STA(SAB(0, 0), (br_), 0);                                                   \
    STB(SBB(0, 1), (bc_) + GHALF, 0); STA(SAB(0, 1), (br_) + GHALF, 0);                                   \
    STB(SBB(1, 0), (bc_), 1); STA(SAB(1, 0), (br_), 1); STB(SBB(1, 1), (bc_) + GHALF, 1);                 \
  } while (0)
  int brow = 0, bcol = 0;
  if (!unit(0, brow, bcol)) return;
  if (!RMS) PROLOGUE(brow, bcol);
  for (int ui = 0;; ++ui) {
  int nbrow = 0, nbcol = 0;
  const bool more = unit(ui + 1, nbrow, nbcol);
  if (RMS) {
    const int row = tid >> 1, half = tid & 1;
    const bf16_t* ap = A + (size_t)(brow + row) * lda + half * 128;
    float ss = 0.f;
#pragma unroll 4
    for (int i = 0; i < 16; ++i) {
      uint4 v = *(const uint4*)(ap + i * 8);
      float f;
      f = bflo(v.x); ss += f * f; f = bfhi(v.x); ss += f * f;
      f = bflo(v.y); ss += f * f; f = bfhi(v.y); ss += f * f;
      f = bflo(v.z); ss += f * f; f = bfhi(v.z); ss += f * f;
      f = bflo(v.w); ss += f * f; f = bfhi(v.w); ss += f * f;
    }
    ss += __shfl_xor(ss, 1);
    if (half == 0) rs[row] = rsqrtf(ss * (1.f / 256.f) + 1e-6f);
    WAIT_V(0);
    PROLOGUE(brow, bcol);
  }
  acc_t acc;
#pragma unroll
  for (int i0 = 0; i0 < 2; ++i0)
#pragma unroll
    for (int i1 = 0; i1 < 2; ++i1)
#pragma unroll
      for (int i2 = 0; i2 < 4; ++i2)
#pragma unroll
        for (int i3 = 0; i3 < 2; ++i3) acc[i0][i1][i2][i3] = (f32x4){0.f, 0.f, 0.f, 0.f};
  bf16x8 At[4][2], B0[2][2], B1[2][2];
  const int nt = K / GBK;
  if (wr == 1) BAR;
  WAIT_V(10); BAR;
  WAIT_V(6); BAR;
  for (int t = 0; t < nt - 2; t += 2) {
    LDB(B0, 0, 0); SCHED; LDA(At, 0, 0); STA(SAB(1, 1), brow + GHALF, t + 1);
    WAIT_L(8); BAR; WAIT_L(0); MMA(0, 0, At, B0); BAR; SCHED;
    LDB(B1, 0, 1); STB(SBB(0, 0), bcol, t + 2);
    BAR; WAIT_L(0); MMA(0, 1, At, B1); BAR;
    LDA(At, 0, 1); STA(SAB(0, 0), brow, t + 2);
    BAR; WAIT_L(0); MMA(1, 0, At, B0); BAR; SCHED;
    STB(SBB(0, 1), bcol + GHALF, t + 2);
    WAIT_V(6); BAR; MMA(1, 1, At, B1); BAR;
    LDB(B0, 1, 0); SCHED; LDA(At, 1, 0); STA(SAB(0, 1), brow + GHALF, t + 2);
    WAIT_L(8); BAR; WAIT_L(0); MMA(0, 0, At, B0); BAR; SCHED;
    LDB(B1, 1, 1); STB(SBB(1, 0), bcol, t + 3);
    BAR; WAIT_L(0); MMA(0, 1, At, B1); BAR;
    LDA(At, 1, 1); STA(SAB(1, 0), brow, t + 3);
    BAR; WAIT_L(0); MMA(1, 0, At, B0); BAR; SCHED;
    STB(SBB(1, 1), bcol + GHALF, t + 3);
    WAIT_V(6); BAR; MMA(1, 1, At, B1); BAR;
  }
  {
    LDB(B0, 0, 0); LDA(At, 0, 0); STA(SAB(1, 1), brow + GHALF, nt - 1);
    BAR; WAIT_L(0); MMA(0, 0, At, B0); BAR;
    LDB(B1, 0, 1); BAR; WAIT_L(0); MMA(0, 1, At, B1); BAR;
    LDA(At, 0, 1); WAIT_V(4); BAR; WAIT_L(0); MMA(1, 0, At, B0); MMA(1, 1, At, B1); BAR;
  }
  {
    LDB(B0, 1, 0); LDA(At, 1, 0); WAIT_V(2); BAR; WAIT_L(0); MMA(0, 0, At, B0); BAR;
    LDB(B1, 1, 1); WAIT_V(0); BAR; WAIT_L(0); MMA(0, 1, At, B1); BAR;
    LDA(At, 1, 1); BAR; WAIT_L(0); MMA(1, 0, At, B0); MMA(1, 1, At, B1); BAR;
  }
  if (wr == 0) BAR;
  if (!RMS && more) { PROLOGUE(nbrow, nbcol); }
  epi(acc, brow, bcol, wr, wc, fr, fq, rs);
  if (RMS) __syncthreads();
  if (!more) break;
  brow = nbrow; bcol = nbcol;
  }
}

template <bool RMS, class Epi>
DI void gemm256_unit(const bf16_t* __restrict__ A, int lda, const bf16_t* __restrict__ Bt, int ldb, int K, int brow, int bcol,
                bf16_t* shm, Epi& epi) {
  const int tid = otid();
  const int wid = tid >> 6, lane = tid & 63, wr = wid >> 2, wc = wid & 3, fr = lane & 15, fq = lane >> 4;
  float* rs = (float*)((char*)shm + MISC_OFF);
  const int ldst0 = tid * 16;
  const unsigned swave = (unsigned)__builtin_amdgcn_readfirstlane((int)((unsigned)(size_t)(LAS char*)shm + (unsigned)((tid & ~63) * 16)));
  unsigned la0, la1, lb0, lb1;
  {
    int r0_, c0_, r1_, c1_;
    stage_rc(ldst0, r0_, c0_);
    stage_rc(ldst0 + 8192, r1_, c1_);
    la0 = (unsigned)(r0_ * lda + c0_) * 2u; la1 = (unsigned)(r1_ * lda + c1_) * 2u;
    lb0 = (unsigned)(r0_ * ldb + c0_) * 2u; lb1 = (unsigned)(r1_ * ldb + c1_) * 2u;
  }
  if (RMS) {
    const int row = tid >> 1, half = tid & 1;
    const bf16_t* ap = A + (size_t)(brow + row) * lda + half * 128;
    float ss = 0.f;
#pragma unroll 4
    for (int i = 0; i < 16; ++i) {
      uint4 v = *(const uint4*)(ap + i * 8);
      float f;
      f = bflo(v.x); ss += f * f; f = bfhi(v.x); ss += f * f;
      f = bflo(v.y); ss += f * f; f = bfhi(v.y); ss += f * f;
      f = bflo(v.z); ss += f * f; f = bfhi(v.z); ss += f * f;
      f = bflo(v.w); ss += f * f; f = bfhi(v.w); ss += f * f;
    }
    ss += __shfl_xor(ss, 1);
    if (half == 0) rs[row] = rsqrtf(ss * (1.f / 256.f) + 1e-6f);
    WAIT_V(0);
  }
  acc_t acc;
#pragma unroll
  for (int i0 = 0; i0 < 2; ++i0)
#pragma unroll
    for (int i1 = 0; i1 < 2; ++i1)
#pragma unroll
      for (int i2 = 0; i2 < 4; ++i2)
#pragma unroll
        for (int i3 = 0; i3 < 2; ++i3) acc[i0][i1][i2][i3] = (f32x4){0.f, 0.f, 0.f, 0.f};
  bf16x8 At[4][2], B0[2][2], B1[2][2];
  const int nt = K / GBK;
  STB(SBB(0, 0), bcol, 0); STA(SAB(0, 0), brow, 0);
  STB(SBB(0, 1), bcol + GHALF, 0); STA(SAB(0, 1), brow + GHALF, 0);
  if (wr == 1) BAR;
  WAIT_V(4); BAR;
  STB(SBB(1, 0), bcol, 1); STA(SAB(1, 0), brow, 1); STB(SBB(1, 1), bcol + GHALF, 1);
  WAIT_V(6); BAR;
  for (int t = 0; t < nt - 2; t += 2) {
    LDB(B0, 0, 0); SCHED; LDA(At, 0, 0); STA(SAB(1, 1), brow + GHALF, t + 1);
    WAIT_L(8); BAR; WAIT_L(0); MMA(0, 0, At, B0); BAR; SCHED;
    LDB(B1, 0, 1); STB(SBB(0, 0), bcol, t + 2);
    BAR; WAIT_L(0); MMA(0, 1, At, B1); BAR;
    LDA(At, 0, 1); STA(SAB(0, 0), brow, t + 2);
    BAR; WAIT_L(0); MMA(1, 0, At, B0); BAR; SCHED;
    STB(SBB(0, 1), bcol + GHALF, t + 2);
    WAIT_V(6); BAR; MMA(1, 1, At, B1); BAR;
    LDB(B0, 1, 0); SCHED; LDA(At, 1, 0); STA(SAB(0, 1), brow + GHALF, t + 2);
    WAIT_L(8); BAR; WAIT_L(0); MMA(0, 0, At, B0); BAR; SCHED;
    LDB(B1, 1, 1); STB(SBB(1, 0), bcol, t + 3);
    BAR; WAIT_L(0); MMA(0, 1, At, B1); BAR;
    LDA(At, 1, 1); STA(SAB(1, 0), brow, t + 3);
    BAR; WAIT_L(0); MMA(1, 0, At, B0); BAR; SCHED;
    STB(SBB(1, 1), bcol + GHALF, t + 3);
    WAIT_V(6); BAR; MMA(1, 1, At, B1); BAR;
  }
  {
    LDB(B0, 0, 0); LDA(At, 0, 0); STA(SAB(1, 1), brow + GHALF, nt - 1);
    BAR; WAIT_L(0); MMA(0, 0, At, B0); BAR;
    LDB(B1, 0, 1); BAR; WAIT_L(0); MMA(0, 1, At, B1); BAR;
    LDA(At, 0, 1); WAIT_V(4); BAR; WAIT_L(0); MMA(1, 0, At, B0); MMA(1, 1, At, B1); BAR;
  }
  {
    LDB(B0, 1, 0); LDA(At, 1, 0); WAIT_V(2); BAR; WAIT_L(0); MMA(0, 0, At, B0); BAR;
    LDB(B1, 1, 1); WAIT_V(0); BAR; WAIT_L(0); MMA(0, 1, At, B1); BAR;
    LDA(At, 1, 1); BAR; WAIT_L(0); MMA(1, 0, At, B0); MMA(1, 1, At, B1); BAR;
  }
  if (wr == 0) BAR;
  epi(acc, brow, bcol, wr, wc, fr, fq, rs);
  __syncthreads();
}


DI bool unit_next(int i, int nM, int nN, int& pm, int& pn) {
  const int nwg = nM * nN;
  const long L = (long)i * ogrid() + obid();
  if (L >= nwg) return false;
  int wgid = (int)L;
  {
    const int q = nwg / 8, r = nwg % 8, xcd = wgid % 8, off = wgid / 8;
    wgid = (xcd < r ? xcd * (q + 1) : r * (q + 1) + (xcd - r) * q) + off;
  }
  const int nig = 8 * nN, gid = wgid / nig, fm = gid * 8, gsz = (nM - fm) < 8 ? (nM - fm) : 8;
  pm = fm + ((wgid % nig) % gsz);
  pn = (wgid % nig) / gsz;
  return true;
}

#define EPI_LOOP                                                   \
  _Pragma("unroll") for (int ai = 0; ai < 2; ++ai)                 \
  _Pragma("unroll") for (int m = 0; m < 4; ++m)                    \
  _Pragma("unroll") for (int bj = 0; bj < 2; ++bj)                 \
  _Pragma("unroll") for (int n = 0; n < 2; ++n)
struct EpiProj {
  bf16_t* proj; float* rss;
  DI void operator()(const acc_t& acc, int brow, int bcol, int wr, int wc, int fr, int fq, const float* rs) const {
    EPI_LOOP {
      const int row = brow + ai * 128 + wr * 64 + m * 16 + fr, col = bcol + bj * 128 + wc * 32 + n * 16 + 4 * fq;
      if (col < NP) {
        const f32x4 v = acc[ai][bj][m][n];
        uint2 u; u.x = pack2(v[0], v[1]); u.y = pack2(v[2], v[3]);
        *(uint2*)(proj + (size_t)row * NP + col) = u;
      }
    }
    if (bcol + 256 > C_QA && bcol < C_KR) {
#pragma unroll
      for (int ai = 0; ai < 2; ++ai)
#pragma unroll
        for (int m = 0; m < 4; ++m) {
          float sq = 0.f, sk = 0.f;
#pragma unroll
          for (int bj = 0; bj < 2; ++bj)
#pragma unroll
            for (int n = 0; n < 2; ++n) {
              const int col = bcol + bj * 128 + wc * 32 + n * 16 + 4 * fq;
              const f32x4 v = acc[ai][bj][m][n];
              const float t = v[0] * v[0] + v[1] * v[1] + v[2] * v[2] + v[3] * v[3];
              sq += (col >= C_QA && col < C_KVA) ? t : 0.f;
              sk += (col >= C_KVA && col < C_KR) ? t : 0.f;
            }
          sq += __shfl_xor(sq, 16); sq += __shfl_xor(sq, 32);
          sk += __shfl_xor(sk, 16); sk += __shfl_xor(sk, 32);
          if (fq == 0) {
            const int row = brow + ai * 128 + wr * 64 + m * 16 + fr;
            if (sq != 0.f) unsafeAtomicAdd(rss + row, sq);
            if (sk != 0.f) unsafeAtomicAdd(rss + MT + row, sk);
          }
        }
    }
  }
};
struct EpiRelu2 {
  bf16_t* hid;
  DI void operator()(const acc_t& acc, int brow, int bcol, int wr, int wc, int fr, int fq, const float* rs) const {
    EPI_LOOP {
      const int row = brow + ai * 128 + wr * 64 + m * 16 + fr, col = bcol + bj * 128 + wc * 32 + n * 16 + 4 * fq;
      const f32x4 v = acc[ai][bj][m][n];
      const float a0 = fmaxf(v[0], 0.f), a1 = fmaxf(v[1], 0.f), a2 = fmaxf(v[2], 0.f), a3 = fmaxf(v[3], 0.f);
      uint2 u; u.x = pack2(a0 * a0, a1 * a1); u.y = pack2(a2 * a2, a3 * a3);
      *(uint2*)(hid + (size_t)row * DFF + col) = u;
    }
  }
};
struct EpiRes {
  const Params* p; int layer; int gate_off; bool from_input;
  DI void operator()(const acc_t& acc, int brow, int bcol, int wr, int wc, int fr, int fq, const float* rs) const {
    const int b = brow / TT, tb = brow - b * TT;
    const bool isctx = tb >= LSEQ;
    const float* gp = p->mods() + ((size_t)layer * 17 + (isctx ? 16 : b)) * 6144 + gate_off;
    EPI_LOOP {
      const int lr = ai * 128 + wr * 64 + m * 16 + fr, col = bcol + bj * 128 + wc * 32 + n * 16 + 4 * fq;
      const f32x4 v = acc[ai][bj][m][n];
      const float4 g = *(const float4*)(gp + col);
      float* dst = res_row(*p, b, tb + lr) + col;
      const float4 s = from_input ? *(const float4*)(in_row(*p, b, tb + lr) + col) : *(const float4*)dst;
      float4 o; o.x = s.x + g.x * v[0]; o.y = s.y + g.y * v[1]; o.z = s.z + g.z * v[2]; o.w = s.w + g.w * v[3];
      *(float4*)dst = o;
    }
  }
};
struct EpiQ {
  const Params* p;
  DI void operator()(const acc_t& acc, int brow, int bcol, int wr, int wc, int fr, int fq, const float* rs) const {
    float rq[8];
#pragma unroll
    for (int i = 0; i < 8; ++i) rq[i] = rsqrtf(p->rss()[0 + brow + (i >> 2) * 128 + wr * 64 + (i & 3) * 16 + fr] * (1.f / 256.f) + 1e-6f);
    const int b = brow / TT, tb = brow - b * TT;
    EPI_LOOP {
      const int lr = ai * 128 + wr * 64 + m * 16 + fr, col = bcol + bj * 128 + wc * 32 + n * 16 + 4 * fq;
      if (col < 576) {
        const int hh = col / 96, d = col - hh * 96;
        const f32x4 v = acc[ai][bj][m][n];
        const float sc = rq[ai * 4 + m];
        uint2 u; u.x = pack2(v[0] * sc, v[1] * sc); u.y = pack2(v[2] * sc, v[3] * sc);
        *(uint2*)(p->Q() + ((size_t)(b * 6 + hh) * TT + tb + lr) * 96 + d) = u;
      }
    }
  }
};
struct EpiKV {
  const Params* p;
  DI void operator()(const acc_t& acc, int brow, int bcol, int wr, int wc, int fr, int fq, const float* rs) const {
    float rq[8];
#pragma unroll
    for (int i = 0; i < 8; ++i) rq[i] = rsqrtf(p->rss()[MT + brow + (i >> 2) * 128 + wr * 64 + (i & 3) * 16 + fr] * (1.f / 256.f) + 1e-6f);
    const int b = brow / TT, tb = brow - b * TT;
    EPI_LOOP {
      const int lr = ai * 128 + wr * 64 + m * 16 + fr, col = bcol + bj * 128 + wc * 32 + n * 16 + 4 * fq;
      const int hh = col >> 7, j = col & 127;
      const f32x4 v = acc[ai][bj][m][n];
      const float sc = rq[ai * 4 + m];
      if (j < 64) {
        uint2 u; u.x = pack2(v[0] * sc, v[1] * sc); u.y = pack2(v[2] * sc, v[3] * sc);
        *(uint2*)(p->Kc() + ((size_t)(b * 6 + hh) * TT + tb + lr) * 96 + j) = u;
      } else {
        bf16_t* vp = p->Vt() + ((size_t)(b * 6 + hh) * 64 + (j - 64)) * TT + tb + lr;
        vp[0] = f2bf(v[0] * sc); vp[TT] = f2bf(v[1] * sc); vp[2 * TT] = f2bf(v[2] * sc); vp[3 * TT] = f2bf(v[3] * sc);
      }
    }
  }
};

DI void transpose_tile(const float* __restrict__ W, int N, int k0, int n0, bf16_t* __restrict__ dst, int ldd,
                       int shift_from, int shift_by, const float* rowscale, float gscale, float* tile) {
  const int tid = otid();
  const int lane = tid & 63, wave = tid >> 6;
  float4 v[8];
#pragma unroll
  for (int i = 0; i < 8; ++i) {
    const int k = k0 + wave + 8 * i, n = n0 + lane * 4;
    v[i] = make_float4(0.f, 0.f, 0.f, 0.f);
    if (n < N) {
      v[i] = *(const float4*)(W + (size_t)k * N + n);
      const float sc = (rowscale ? rowscale[k] : 1.f) * gscale;
      v[i].x *= sc; v[i].y *= sc; v[i].z *= sc; v[i].w *= sc;
    }
  }
#pragma unroll
  for (int i = 0; i < 8; ++i) {
    *(float4*)(tile + (wave + 8 * i) * 260 + lane * 4) = v[i];
  }
  __syncthreads();
  {
    const int nn = tid >> 1, kq = (tid & 1) * 32;
    const int n = n0 + nn;
    if (n < N) {
      const int drow = n >= shift_from ? n + shift_by : n;
      bf16_t* dp = dst + (size_t)drow * ldd + k0 + kq;
#pragma unroll
      for (int j = 0; j < 4; ++j) {
        const float* tp = tile + (kq + 8 * j) * 260 + nn;
        uint4 u;
        u.x = pack2(tp[0 * 260], tp[1 * 260]);
        u.y = pack2(tp[2 * 260], tp[3 * 260]);
        u.z = pack2(tp[4 * 260], tp[5 * 260]);
        u.w = pack2(tp[6 * 260], tp[7 * 260]);
        *(uint4*)(dp + 8 * j) = u;
      }
    }
  }
  __syncthreads();
}

DI void transpose_layer(const Params& p, int l, int first, int step, float* tile) {
  const float qscale = 0.10206207261596577f * 1.4426950408889634f;
  for (int v = first; v < 728; v += step) {
    if (v < 144) {
      const int kt = v / 9, nt = v - kt * 9;
      transpose_tile(p.w_in + (size_t)l * 1024 * IN_COLS, IN_COLS, kt * 64, nt * 256, p.wt_in() + (size_t)l * NPW * 1024, 1024, 1292, 52, nullptr, 1.f, tile);
    } else if (v < 192) {
      const int w = v - 144, kt = w >> 2, nt = w & 3;
      transpose_tile(p.w_out + (size_t)l * 1024 * 1024, 1024, kt * 64, nt * 256, p.wt_out() + (size_t)l * 1024 * 1024, 1024, 1 << 30, 0, nullptr, 1.f, tile);
    } else if (v < 448) {
      const int w = v - 192, kt = w >> 4, nt = w & 15;
      transpose_tile(p.w_mlp1 + (size_t)l * 1024 * 4096, 4096, kt * 64, nt * 256, p.wt_m1() + (size_t)l * 4096 * 1024, 1024, 1 << 30, 0, nullptr, 1.f, tile);
    } else if (v < 704) {
      const int w = v - 448, kt = w >> 2, nt = w & 3;
      transpose_tile(p.w_mlp2 + (size_t)l * 4096 * 1024, 1024, kt * 64, nt * 256, p.wt_m2() + (size_t)l * 1024 * 4096, 4096, 1 << 30, 0, nullptr, 1.f, tile);
    } else if (v < 716) {
      const int w = v - 704, kt = w / 3, nt = w - kt * 3;
      transpose_tile(p.w_q_b + (size_t)l * 256 * 576, 576, kt * 64, nt * 256, p.wt_qb() + (size_t)l * NQ * 256, 256, 1 << 30, 0, p.q_a_norm_w + l * 256, qscale, tile);
    } else {
      const int w = v - 716, kt = w / 3, nt = w - kt * 3;
      transpose_tile(p.w_kv_b + (size_t)l * 256 * 768, 768, kt * 64, nt * 256, p.wt_kvb() + (size_t)l * 768 * 256, 256, 1 << 30, 0, p.kv_a_norm_w + l * 256, 1.f, tile);
    }
  }
}

DI void phase_prep(const Params& p, bf16_t* smem) {
  float* tile = (float*)smem;
  const int tid = otid();
  const int gtid = obid() * 512 + tid, gsz = ogrid_op() * 512;
  if (gtid < 16) p.ctr()[gtid] = 0;
  if (gtid < 512) {
    const int pos = gtid >> 3, pair = gtid & 7;
    const float inv = powf(10000.f, -(float)pair / 8.f);
    const float ang = (float)pos * inv;
    p.rope()[gtid * 2] = cosf(ang);
    p.rope()[gtid * 2 + 1] = sinf(ang);
  }
  for (int i = gtid; i < 2 * 212 * 1024; i += gsz) {
    const int l = i / (212 * 1024), rem = i - l * 212 * 1024, rr = rem >> 10, k = rem & 1023;
    const int row = rr < 52 ? 1292 + rr : 2144 + (rr - 52);
    p.wt_in()[((size_t)l * NPW + row) * 1024 + k] = 0;
  }
  for (int i = gtid; i < 2 * 192 * 256; i += gsz) {
    const int l = i / (192 * 256), rem = i - l * 192 * 256;
    p.wt_qb()[(size_t)l * NQ * 256 + 576 * 256 + rem] = 0;
  }
  transpose_layer(p, 0, obid(), ogrid(), tile);
  {
    const int nn = tid & 63, c8 = __builtin_amdgcn_readfirstlane(tid >> 6);
    for (int it = obid(); it < 128; it += ogrid()) {
      const int l = it >> 6, g = (it >> 4) & 3, nblk = it & 15;
      const int n = nblk * 64 + nn;
      const float* wo = p.w_out + (size_t)l * 1024 * 1024 + (size_t)(768 + g * 64) * 1024 + n;
      const float* pw = p.pool_w + ((size_t)l * 4 + g) * 4096 + c8 * 8 * 64;
      const float* ps = p.pool_scale + l * 256 + g * 64;
      float o[8];
#pragma unroll
      for (int e = 0; e < 8; ++e) o[e] = 0.f;
#pragma unroll 8
      for (int d = 0; d < 64; ++d) {
        const float wv = wo[(size_t)d * 1024] * ps[d];
#pragma unroll
        for (int e = 0; e < 8; ++e) o[e] += pw[e * 64 + d] * wv;
      }
      uint4 u;
      u.x = pack2(o[0], o[1]); u.y = pack2(o[2], o[3]); u.z = pack2(o[4], o[5]); u.w = pack2(o[6], o[7]);
      *(uint4*)(p.wt_out() + (size_t)l * 1024 * 1024 + (size_t)n * 1024 + 768 + g * 64 + c8 * 8) = u;
    }
  }
  {
    float* sc = (float*)smem;
    const int lane = tid & 63, wave = tid >> 6;
    bool loaded = false;
    for (int it = ogrid() - 1 - obid(); it < 192; it += ogrid()) {
      const int l = it / 96, cb = it - l * 96;
      if (!loaded) {
        for (int i = tid; i < 17 * 1024; i += 512) {
          const int ci = i >> 10, k = i & 1023;
          const float v = ci < 16 ? p.c[ci * 1024 + k] : p.c_ctx[k];
          sc[i] = silu(v);
        }
        loaded = true;
        __syncthreads();
      }
      float acc[17];
#pragma unroll
      for (int i = 0; i < 17; ++i) acc[i] = 0.f;
      const float* mw = p.mod_w + (size_t)l * 1024 * 6144 + cb * 64 + lane;
      for (int k0 = wave * 128; k0 < wave * 128 + 128; k0 += 16) {
        float wv[16];
#pragma unroll
        for (int j = 0; j < 16; ++j) wv[j] = mw[(size_t)(k0 + j) * 6144];
#pragma unroll
        for (int j = 0; j < 16; ++j)
#pragma unroll
          for (int i = 0; i < 17; ++i) acc[i] += sc[i * 1024 + k0 + j] * wv[j];
      }
      float* sred = (float*)smem + 17 * 1024;
      for (int w = 0; w < 8; ++w) {
        if (wave == w) {
#pragma unroll
          for (int i = 0; i < 17; ++i) {
            if (w == 0) sred[i * 64 + lane] = acc[i];
            else sred[i * 64 + lane] += acc[i];
          }
        }
        __syncthreads();
      }
      for (int i = tid; i < 17 * 64; i += 512) {
        const int ci = i >> 6, cc = i & 63;
        p.mods()[((size_t)l * 17 + ci) * 6144 + cb * 64 + cc] = sred[i] + p.mod_b[l * 6144 + cb * 64 + cc];
      }
      __syncthreads();
    }
  }
}

DI void phase_norm(const Params& p, int layer, int which) {
  const int tid = otid(), lane = tid & 63, wave = tid >> 6;
  if (which == 1) { const int gs_ = ogrid_op() * 512; for (int i = obid() * 512 + tid; i < 2 * MT; i += gs_) p.rss()[i] = 0.f; }
  const float* nwt = (which == 1 ? p.norm1_w : p.norm2_w) + layer * 1024;
  const int chunk = (MT + ogrid() - 1) / ogrid();
  const int r_begin = obid() * chunk, r_end = min(MT, r_begin + chunk);
  float4 fw[4], fs[4];
  int cur_ci = -1;
  for (int r = r_begin + wave; r < r_end; r += 16) {
    const int r2 = r + 8;
    const bool has2 = r2 < r_end;
    const int b = r / TT, t = r - b * TT, b2 = r2 / TT, t2 = r2 - b2 * TT;
    const bool skip1 = t >= LSEQ && layer == 1 && which == 2;
    const bool skip2 = !has2 || (t2 >= LSEQ && layer == 1 && which == 2);
    const float* src1 = (layer == 0 && which == 1) ? in_row(p, b, t) : res_row(p, b, t);
    const float* src2 = (layer == 0 && which == 1) ? in_row(p, has2 ? b2 : b, has2 ? t2 : t) : res_row(p, has2 ? b2 : b, has2 ? t2 : t);
    float4 v1[4], v2[4];
#pragma unroll
    for (int i = 0; i < 4; ++i) {
      v1[i] = *(const float4*)(src1 + i * 256 + lane * 4);
      v2[i] = *(const float4*)(src2 + i * 256 + lane * 4);
    }
#pragma unroll
    for (int half = 0; half < 2; ++half) {
      const bool skip = half ? skip2 : skip1;
      if (skip) continue;
      const int rr = half ? r2 : r, bb = half ? b2 : b, tt = half ? t2 : t;
      const int ci = tt >= LSEQ ? 16 : bb;
      if (ci != cur_ci) {
        cur_ci = ci;
        const float* md = p.mods() + ((size_t)layer * 17 + ci) * 6144 + (which == 1 ? 0 : 3072);
#pragma unroll
        for (int i = 0; i < 4; ++i) {
          const int k = i * 256 + lane * 4;
          const float4 w = *(const float4*)(nwt + k);
          const float4 sc = *(const float4*)(md + 1024 + k);
          fs[i] = *(const float4*)(md + k);
          fw[i] = make_float4(w.x * (1.f + sc.x), w.y * (1.f + sc.y), w.z * (1.f + sc.z), w.w * (1.f + sc.w));
        }
      }
      float ss = 0.f;
#pragma unroll
      for (int i = 0; i < 4; ++i) {
        const float4 v = half ? v2[i] : v1[i];
        ss += v.x * v.x + v.y * v.y + v.z * v.z + v.w * v.w;
      }
      ss = wave_sum(ss);
      const float rstd = rsqrtf(ss * (1.f / 1024.f) + 1e-6f);
#pragma unroll
      for (int i = 0; i < 4; ++i) {
        const float4 v = half ? v2[i] : v1[i];
        uint2 u;
        u.x = pack2(v.x * rstd * fw[i].x + fs[i].x, v.y * rstd * fw[i].y + fs[i].y);
        u.y = pack2(v.z * rstd * fw[i].z + fs[i].z, v.w * rstd * fw[i].w + fs[i].w);
        *(uint2*)(p.xn() + (size_t)rr * DM + i * 256 + lane * 4) = u;
      }
    }
  }
}

DI void phase_final(const Params& p) {
  const int tid = otid(), lane = tid & 63, wave = tid >> 6;
  float4 fw[4];
#pragma unroll
  for (int i = 0; i < 4; ++i) fw[i] = *(const float4*)(p.final_norm_w + i * 256 + lane * 4);
  const int NR = NB * LSEQ;
  for (int r = obid() * 8 + wave; r < NR; r += ogrid() * 16) {
    const int r2 = r + ogrid() * 8;
    const bool has2 = r2 < NR;
    float* row1 = p.out + (size_t)r * DM;
    float* row2 = p.out + (size_t)(has2 ? r2 : r) * DM;
    float4 v1[4], v2[4];
#pragma unroll
    for (int i = 0; i < 4; ++i) {
      v1[i] = *(const float4*)(row1 + i * 256 + lane * 4);
      v2[i] = *(const float4*)(row2 + i * 256 + lane * 4);
    }
#pragma unroll
    for (int half = 0; half < 2; ++half) {
      if (half && !has2) continue;
      float* row = half ? row2 : row1;
      float ss = 0.f;
#pragma unroll
      for (int i = 0; i < 4; ++i) {
        const float4 v = half ? v2[i] : v1[i];
        ss += v.x * v.x + v.y * v.y + v.z * v.z + v.w * v.w;
      }
      ss = wave_sum(ss);
      const float rstd = rsqrtf(ss * (1.f / 1024.f) + 1e-6f);
#pragma unroll
      for (int i = 0; i < 4; ++i) {
        const float4 v = half ? v2[i] : v1[i];
        float4 o;
        o.x = v.x * rstd * fw[i].x; o.y = v.y * rstd * fw[i].y; o.z = v.z * rstd * fw[i].z; o.w = v.w * rstd * fw[i].w;
        *(float4*)(row + i * 256 + lane * 4) = o;
      }
    }
  }
}

DI int map_mtile(int skip_ctx, int i) { return skip_ctx ? (i >> 4) * 17 + (i & 15) : i; }

struct UnitOrder {
  int nM, nN, skip;
  DI bool operator()(int i, int& br, int& bc) const {
    int pm, pn;
    if (!unit_next(i, nM, nN, pm, pn)) return false;
    br = map_mtile(skip, pm) * 256;
    bc = pn * 256;
    return true;
  }
};
DI void phase_gemm_in(const Params& p, int layer, bf16_t* smem) {
  EpiProj epi{p.proj(), p.rss()};
  gemm256<false>(p.xn(), DM, p.wt_in() + (size_t)layer * NPW * 1024, 1024, 1024, smem, epi, UnitOrder{MT / 256, NPW / 256, 0});
}
DI void phase_gemm_qkv(const Params& p, int layer, bf16_t* smem) {
  EpiQ epq{&p};
  EpiKV epk{&p};
  int pm, pn;
  for (int i = 0; unit_next(i, MT / 256, 6, pm, pn); ++i) {
    if (pn < 3) gemm256_unit<false>(p.proj() + C_QA, NP, p.wt_qb() + (size_t)layer * NQ * 256, 256, 256, pm * 256, pn * 256, smem, epq);
    else gemm256_unit<false>(p.proj() + C_KVA, NP, p.wt_kvb() + (size_t)layer * 768 * 256, 256, 256, pm * 256, (pn - 3) * 256, smem, epk);
  }
}
DI void phase_gemm_out(const Params& p, int layer, bf16_t* smem) {
  EpiRes epi{&p, layer, 2048, layer == 0};
  const int skip = layer == 1;
  gemm256<false>(p.xn(), DM, p.wt_out() + (size_t)layer * 1024 * 1024, 1024, 1024, smem, epi, UnitOrder{skip ? NB * 16 : MT / 256, 4, skip});
}
DI void phase_gemm_m1(const Params& p, int layer, bf16_t* smem) {
  EpiRelu2 epi{p.hidden()};
  const int skip = layer == 1;
  gemm256<false>(p.xn(), DM, p.wt_m1() + (size_t)layer * 4096 * 1024, 1024, 1024, smem, epi, UnitOrder{skip ? NB * 16 : MT / 256, 16, skip});
}
DI void phase_gemm_m2(const Params& p, int layer, bf16_t* smem) {
  EpiRes epi{&p, layer, 5120, false};
  const int skip = layer == 1;
  gemm256<false>(p.hidden(), DFF, p.wt_m2() + (size_t)layer * 1024 * 4096, 4096, 4096, smem, epi, UnitOrder{skip ? NB * 16 : MT / 256, 4, skip});
}

DI void phase_tokops(const Params& p, int layer) {
  const int tid = otid();
  const int gtid = obid() * 512 + tid, gsz = ogrid_op() * 512;
  {
    const int nrt = gsz / 112;
    if (gtid < nrt * 112) {
      const int cg8 = (gtid % 112) * 8;
      const float* cw = p.conv_w + (size_t)layer * 4 * 896 + cg8;
      const float* cbp = p.conv_b + layer * 896 + cg8;
      float w[4][8], bias[8];
#pragma unroll
      for (int j = 0; j < 4; ++j)
#pragma unroll
        for (int e = 0; e < 8; ++e) w[j][e] = cw[j * 896 + e];
#pragma unroll
      for (int e = 0; e < 8; ++e) bias[e] = cbp[e];
      for (int run = gtid / 112; run < MT / 8; run += nrt) {
        const int r0 = run * 8;
        const int b = r0 / TT, tb = r0 - b * TT;
        const int seg_lo = tb < LSEQ ? 0 : LSEQ, seg_hi = tb < LSEQ ? LSEQ : TT;
        uint4 raw[11];
#pragma unroll
        for (int i = 0; i < 11; ++i) {
          const int tt = tb - 1 + i;
          if (tt >= seg_lo && tt < seg_hi) raw[i] = *(const uint4*)(p.proj() + ((size_t)b * TT + tt) * NP + C_XBC + cg8);
          else raw[i] = make_uint4(0, 0, 0, 0);
        }
#pragma unroll
        for (int o = 0; o < 8; ++o) {
          float a[8];
#pragma unroll
          for (int e = 0; e < 8; ++e) a[e] = bias[e];
#pragma unroll
          for (int j = 0; j < 4; ++j) {
            const uint4 u = raw[o + j];
            a[0] += w[j][0] * bflo(u.x); a[1] += w[j][1] * bfhi(u.x);
            a[2] += w[j][2] * bflo(u.y); a[3] += w[j][3] * bfhi(u.y);
            a[4] += w[j][4] * bflo(u.z); a[5] += w[j][5] * bfhi(u.z);
            a[6] += w[j][6] * bflo(u.w); a[7] += w[j][7] * bfhi(u.w);
          }
          uint4 ov;
          ov.x = pack2(silu(a[0]), silu(a[1])); ov.y = pack2(silu(a[2]), silu(a[3]));
          ov.z = pack2(silu(a[4]), silu(a[5])); ov.w = pack2(silu(a[6]), silu(a[7]));
          *(uint4*)(p.xbc() + ((size_t)b * TT + tb + o) * 896 + cg8) = ov;
        }
      }
    }
  }
  for (int idx = gtid; idx < MT * 2; idx += gsz) {
    const int r = idx >> 1, axis = idx & 1;
    const int b = r / TT, t = r - b * TT;
    const bf16_t* src = p.proj() + (size_t)r * NP + C_KR + axis * 16;
    const uint4 u1 = *(const uint4*)src, u2 = *(const uint4*)(src + 8);
    uint4 o1 = u1, o2 = u2;
    if (t < LSEQ) {
      const int pos = axis ? (t & 63) : (t >> 6);
      const float4* rp = (const float4*)(p.rope() + pos * 16);
      const float4 c0 = rp[0], c1 = rp[1], c2 = rp[2], c3 = rp[3];
      o1.x = pack2(bflo(u1.x) * c0.x - bflo(u2.x) * c0.y, bfhi(u1.x) * c0.z - bfhi(u2.x) * c0.w);
      o1.y = pack2(bflo(u1.y) * c1.x - bflo(u2.y) * c1.y, bfhi(u1.y) * c1.z - bfhi(u2.y) * c1.w);
      o1.z = pack2(bflo(u1.z) * c2.x - bflo(u2.z) * c2.y, bfhi(u1.z) * c2.z - bfhi(u2.z) * c2.w);
      o1.w = pack2(bflo(u1.w) * c3.x - bflo(u2.w) * c3.y, bfhi(u1.w) * c3.z - bfhi(u2.w) * c3.w);
      o2.x = pack2(bflo(u2.x) * c0.x + bflo(u1.x) * c0.y, bfhi(u2.x) * c0.z + bfhi(u1.x) * c0.w);
      o2.y = pack2(bflo(u2.y) * c1.x + bflo(u1.y) * c1.y, bfhi(u2.y) * c1.z + bfhi(u1.y) * c1.w);
      o2.z = pack2(bflo(u2.z) * c2.x + bflo(u1.z) * c2.y, bfhi(u2.z) * c2.z + bfhi(u1.z) * c2.w);
      o2.w = pack2(bflo(u2.w) * c3.x + bflo(u1.w) * c3.y, bfhi(u2.w) * c3.z + bfhi(u1.w) * c3.w);
    }
#pragma unroll
    for (int hh = 0; hh < 6; ++hh) {
      bf16_t* dst = p.Kc() + ((size_t)(b * 6 + hh) * TT + t) * 96 + 64 + axis * 16;
      *(uint4*)dst = o1;
      *(uint4*)(dst + 8) = o2;
    }
  }
  for (int idx = gtid; idx < (MT / 8) * 32; idx += gsz) {
    const int run = idx >> 5, cgp = idx & 31;
    const int r0 = run * 8;
    const int b = r0 / TT, t0 = r0 - b * TT;
    const int seg_lo = t0 < LSEQ ? 0 : LSEQ, seg_hi = t0 < LSEQ ? LSEQ : TT;
    const int g = cgp >> 3, half = 1 << g;
    const bf16_t* base = p.proj() + (size_t)b * TT * NP + C_POOL + cgp * 8;
    float a[8];
#pragma unroll
    for (int e = 0; e < 8; ++e) a[e] = 0.f;
    for (int tt = max(t0 - half, seg_lo); tt < min(t0 + half, seg_hi); ++tt) {
      const uint4 u = *(const uint4*)(base + (size_t)tt * NP);
      a[0] += bflo(u.x); a[1] += bfhi(u.x); a[2] += bflo(u.y); a[3] += bfhi(u.y);
      a[4] += bflo(u.z); a[5] += bfhi(u.z); a[6] += bflo(u.w); a[7] += bfhi(u.w);
    }
#pragma unroll
    for (int o = 0; o < 8; ++o) {
      const int t = t0 + o;
      const int lo = max(t - half, seg_lo), hi = min(t + half, seg_hi);
      const float inv = 1.f / (float)(hi - lo);
      const uint4 u = *(const uint4*)(base + (size_t)t * NP);
      uint4 ov;
      ov.x = pack2(a[0] * inv - bflo(u.x), a[1] * inv - bfhi(u.x));
      ov.y = pack2(a[2] * inv - bflo(u.y), a[3] * inv - bfhi(u.y));
      ov.z = pack2(a[4] * inv - bflo(u.z), a[5] * inv - bfhi(u.z));
      ov.w = pack2(a[6] * inv - bflo(u.w), a[7] * inv - bfhi(u.w));
      *(uint4*)(p.xn() + ((size_t)b * TT + t) * DM + 768 + cgp * 8) = ov;
      if (o < 7) {
        const int tin = t + half, tout = t - half;
        if (tin < seg_hi) {
          const uint4 w = *(const uint4*)(base + (size_t)tin * NP);
          a[0] += bflo(w.x); a[1] += bfhi(w.x); a[2] += bflo(w.y); a[3] += bfhi(w.y);
          a[4] += bflo(w.z); a[5] += bfhi(w.z); a[6] += bflo(w.w); a[7] += bfhi(w.w);
        }
        if (tout >= seg_lo) {
          const uint4 w = *(const uint4*)(base + (size_t)tout * NP);
          a[0] -= bflo(w.x); a[1] -= bfhi(w.x); a[2] -= bflo(w.y); a[3] -= bfhi(w.y);
          a[4] -= bflo(w.z); a[5] -= bfhi(w.z); a[6] -= bflo(w.w); a[7] -= bfhi(w.w);
        }
      }
    }
  }
}

typedef short s16x4 __attribute__((ext_vector_type(4)));
DI s16x4 tr4(const bf16_t* M, int LD, int krow, int ccol, int lane) {
  const int q = (lane & 15) >> 2, pp = lane & 3, blk = (lane >> 4) & 1;
  return __builtin_amdgcn_ds_read_tr16_b64_v4i16((LAS s16x4*)(LAS bf16_t*)(M + (krow + q) * LD + ccol + 16 * blk + 4 * pp));
}
DI bf16x8 cat8(s16x4 lo, s16x4 hi) { return __builtin_shufflevector(lo, hi, 0, 1, 2, 3, 4, 5, 6, 7); }

DI void ssd_store_x(bf16_t* sX, bf16_t* sXw, int row, int xch, uint4 g, float wl) {
  *(uint4*)(sX + row * 72 + xch) = g;
  uint4 u;
  u.x = pack2(bflo(g.x) * wl, bfhi(g.x) * wl);
  u.y = pack2(bflo(g.y) * wl, bfhi(g.y) * wl);
  u.z = pack2(bflo(g.z) * wl, bfhi(g.z) * wl);
  u.w = pack2(bflo(g.w) * wl, bfhi(g.w) * wl);
  *(uint4*)(sXw + row * 72 + xch) = u;
}
DI void ssd_job(const Params& p, int layer, int jobpair, bf16_t* smem_blk) {
  const int tid_full = otid(), jh = tid_full >> 8, tid = tid_full & 255;
  const int lane = tid & 63, wave = tid >> 6, r = lane & 31, h = lane >> 5;
  const int job = jobpair * 2 + jh;
  bf16_t* smem = smem_blk + jh * SSD_LDS_EL;
  const int b = job / 12, dir = (job / 6) & 1, head = job % 6, grp = head / 3;
  bf16_t* sB = smem;
  bf16_t* sC = sB + 64 * 136;
  bf16_t* sX = sC + 64 * 136;
  bf16_t* sXw = sX + 64 * 72;
  bf16_t* sH = sXw + 64 * 72;
  float* sfl = (float*)(sH + 64 * 136);
  const float a = -__expf(p.a_log[layer * 12 + dir * 6 + head]);
  const float dtb = p.dt_bias[layer * 12 + dir * 6 + head];
  for (int i = tid; i < 64 * 136 / 2; i += 256) ((unsigned*)sH)[i] = 0u;
  f32x16 hacc[2];
  hacc[0] = zero16();
  hacc[1] = zero16();
  const int pt = wave >> 1, lt = wave & 1;
  const int lidx = lt * 32 + r;
  const int brow_ = tid >> 4, bch = (tid & 15) * 8;
  const int xrow_ = tid >> 3, xch = (tid & 7) * 8;
  uint4 gB0, gB1, gB2, gB3, gC0, gC1, gC2, gC3, gX0, gX1;
  float dtraw = 0.f;
#define SSD_LOAD(it_)                                                                                  \
  do {                                                                                                 \
    const int sc_ = dir == 0 ? ((it_) < 4 ? 64 + (it_) : (it_) - 4) : 67 - (it_);                      \
    const bf16_t* base_ = p.xbc() + ((size_t)b * TT + sc_ * 64) * 896;                                 \
    if (wave == 0) {                                                                                   \
      const int tok_ = dir == 0 ? lane : 63 - lane;                                                    \
      dtraw = bf2f(p.proj()[((size_t)b * TT + sc_ * 64 + tok_) * NP + C_DT + dir * 6 + head]);         \
    }                                                                                                  \
    const bf16_t* bp_ = base_ + (size_t)brow_ * 896 + 384 + grp * 128 + bch;                            \
    gB0 = *(const uint4*)(bp_); gB1 = *(const uint4*)(bp_ + 16 * 896);                                  \
    gB2 = *(const uint4*)(bp_ + 32 * 896); gB3 = *(const uint4*)(bp_ + 48 * 896);                       \
    gC0 = *(const uint4*)(bp_ + 256); gC1 = *(const uint4*)(bp_ + 16 * 896 + 256);                      \
    gC2 = *(const uint4*)(bp_ + 32 * 896 + 256); gC3 = *(const uint4*)(bp_ + 48 * 896 + 256);           \
    const bf16_t* xp_ = base_ + (size_t)xrow_ * 896 + head * 64 + xch;                                  \
    gX0 = *(const uint4*)(xp_); gX1 = *(const uint4*)(xp_ + 32 * 896);                                  \
  } while (0)
#define SSD_SCAN(par_)                                                                                 \
  do {                                                                                                 \
    float* fl_ = sfl + (par_) * 200;                                                                   \
    const int tok = dir == 0 ? lane : 63 - lane;                                                       \
    const float xx = dtraw + dtb;                                                                      \
    const float dt = xx > 20.f ? xx : __logf(1.f + __expf(xx));                                        \
    float cs = dt * a;                                                                                 \
    _Pragma("unroll") for (int off = 1; off < 64; off <<= 1) {                                         \
      const float o_ = __shfl_up(cs, off);                                                             \
      if (lane >= off) cs += o_;                                                                       \
    }                                                                                                  \
    const float tot = __shfl(cs, 63);                                                                  \
    fl_[tok] = dt;                                                                                     \
    fl_[64 + tok] = cs;                                                                                \
    fl_[128 + tok] = dt * __expf(tot - cs);                                                            \
    if (lane == 0) fl_[192] = tot;                                                                     \
  } while (0)
  SSD_LOAD(0);
  if (wave == 0) SSD_SCAN(0);
  __syncthreads();
  for (int it = 0; it < 68; ++it) {
    const int sc = dir == 0 ? (it < 4 ? 64 + it : it - 4) : 67 - it;
    const size_t r0 = (size_t)b * TT + sc * 64;
    const float* fl = sfl + (it & 1) * 200;
    const float* sdt = fl;
    const float* scs = fl + 64;
    const float* sw = fl + 128;
    *(uint4*)(sB + (brow_ + 0) * 136 + bch) = gB0;  *(uint4*)(sC + (brow_ + 0) * 136 + bch) = gC0;
    *(uint4*)(sB + (brow_ + 16) * 136 + bch) = gB1; *(uint4*)(sC + (brow_ + 16) * 136 + bch) = gC1;
    *(uint4*)(sB + (brow_ + 32) * 136 + bch) = gB2; *(uint4*)(sC + (brow_ + 32) * 136 + bch) = gC2;
    *(uint4*)(sB + (brow_ + 48) * 136 + bch) = gB3; *(uint4*)(sC + (brow_ + 48) * 136 + bch) = gC3;
    ssd_store_x(sX, sXw, xrow_, xch, gX0, sw[xrow_]);
    ssd_store_x(sX, sXw, xrow_ + 32, xch, gX1, sw[xrow_ + 32]);
    { const int itn = it + 1 < 68 ? it + 1 : 67; SSD_LOAD(itn); }
    __syncthreads();
    bf16x8 creg[8];
#pragma unroll
    for (int ks = 0; ks < 8; ++ks) creg[ks] = *(const bf16x8*)(sC + lidx * 136 + ks * 16 + h * 8);
    f32x16 yacc = zero16();
    const float csl = scs[lidx];
#pragma unroll
    for (int st = 0; st < 2; ++st) {
      const bool skip = dir == 0 ? (st > lt) : (st < lt);
      if (!skip) {
        bf16x8 bf_[8];
#pragma unroll
        for (int ks = 0; ks < 8; ++ks) bf_[ks] = *(const bf16x8*)(sB + (st * 32 + r) * 136 + ks * 16 + h * 8);
        const s16x4 x0 = tr4(sX, 72, st * 32 + 4 * h, pt * 32, lane), x1 = tr4(sX, 72, st * 32 + 8 + 4 * h, pt * 32, lane);
        const s16x4 x2 = tr4(sX, 72, st * 32 + 16 + 4 * h, pt * 32, lane), x3 = tr4(sX, 72, st * 32 + 24 + 4 * h, pt * 32, lane);
        __builtin_amdgcn_sched_barrier(0);
        f32x16 sv = zero16();
#pragma unroll
        for (int ks = 0; ks < 8; ++ks) sv = MFMA(bf_[ks], creg[ks], sv);
#pragma unroll
        for (int g = 0; g < 4; ++g) {
          const float4 c4 = *(const float4*)(scs + st * 32 + 8 * g + 4 * h);
          const float4 d4 = *(const float4*)(sdt + st * 32 + 8 * g + 4 * h);
          const float cc[4] = {c4.x, c4.y, c4.z, c4.w};
          const float dd[4] = {d4.x, d4.y, d4.z, d4.w};
#pragma unroll
          for (int e = 0; e < 4; ++e) {
            const int sidx = st * 32 + 8 * g + 4 * h + e;
            const bool valid = dir == 0 ? (sidx <= lidx) : (sidx >= lidx);
            const float arg = valid ? (csl - cc[e]) : 0.f;
            const float dec = valid ? __expf(arg) * dd[e] : 0.f;
            sv[4 * g + e] *= dec;
          }
        }
        yacc = MFMA(cat8(x0, x1), pack8(sv, 0), yacc);
        yacc = MFMA(cat8(x2, x3), pack8(sv, 1), yacc);
      }
    }
    {
      bf16x8 hf_[8];
#pragma unroll
      for (int ks = 0; ks < 8; ++ks) hf_[ks] = *(const bf16x8*)(sH + (pt * 32 + r) * 136 + ks * 16 + h * 8);
      __builtin_amdgcn_sched_barrier(0);
      f32x16 yo = zero16();
#pragma unroll
      for (int ks = 0; ks < 8; ++ks) yo = MFMA(hf_[ks], creg[ks], yo);
      const float el = __expf(csl);
#pragma unroll
      for (int i = 0; i < 16; ++i) yacc[i] += el * yo[i];
    }
    {
      bf16_t* yout = p.yssd() + ((size_t)dir * MT + r0 + lidx) * 384 + head * 64 + pt * 32 + 4 * h;
#pragma unroll
      for (int g = 0; g < 4; ++g) {
        uint2 u;
        u.x = pack2(yacc[4 * g + 0], yacc[4 * g + 1]);
        u.y = pack2(yacc[4 * g + 2], yacc[4 * g + 3]);
        *(uint2*)(yout + 8 * g) = u;
      }
    }
    {
      const float et = __expf(fl[192]);
#pragma unroll
      for (int q = 0; q < 2; ++q)
#pragma unroll
        for (int i = 0; i < 16; ++i) hacc[q][i] *= et;
#pragma unroll
      for (int half = 0; half < 2; ++half) {
        bf16x8 av_[2], bv_[2][2];
#pragma unroll
        for (int k2 = 0; k2 < 2; ++k2) {
          const int ks = half * 2 + k2;
          av_[k2] = cat8(tr4(sXw, 72, ks * 16 + 8 * h, pt * 32, lane), tr4(sXw, 72, ks * 16 + 8 * h + 4, pt * 32, lane));
#pragma unroll
          for (int q = 0; q < 2; ++q) {
            const int nt = (wave & 1) * 2 + q;
            bv_[q][k2] = cat8(tr4(sB, 136, ks * 16 + 8 * h, nt * 32, lane), tr4(sB, 136, ks * 16 + 8 * h + 4, nt * 32, lane));
          }
        }
        __builtin_amdgcn_sched_barrier(0);
#pragma unroll
        for (int k2 = 0; k2 < 2; ++k2)
#pragma unroll
          for (int q = 0; q < 2; ++q) hacc[q] = MFMA(av_[k2], bv_[q][k2], hacc[q]);
        __builtin_amdgcn_sched_barrier(0);
      }
    }
    if (wave == 0 && it + 1 < 68) SSD_SCAN((it + 1) & 1);
    __syncthreads();
#pragma unroll
    for (int q = 0; q < 2; ++q) {
      const int nt = (wave & 1) * 2 + q;
#pragma unroll
      for (int reg = 0; reg < 16; ++reg) sH[(pt * 32 + crow(reg, h)) * 136 + nt * 32 + r] = f2bf(hacc[q][reg]);
    }
  }
#undef SSD_SCAN
#undef SSD_LOAD
  asm volatile("s_waitcnt vmcnt(0)" ::: "memory");
  __syncthreads();
  if (tid_full == 0) {
    __builtin_amdgcn_fence(__ATOMIC_RELEASE, "agent");
    asm volatile("s_waitcnt vmcnt(0)" ::: "memory");
    xb_add(p.bar() + 3700 + layer * 16 + b, 2u);
  }
  __syncthreads();
}

DI unsigned rope_word(unsigned mine, unsigned other, float4 cs, int h) {
  const float m0 = bflo(mine), m1 = bfhi(mine), o0 = bflo(other), o1 = bfhi(other);
  const float r0 = h ? (m0 * cs.x + o0 * cs.y) : (m0 * cs.x - o0 * cs.y);
  const float r1 = h ? (m1 * cs.z + o1 * cs.w) : (m1 * cs.z - o1 * cs.w);
  return pack2(r0, r1);
}
DI void attn_item(const Params& p, int b, int hh, int q0, int k_begin, int nkt, bf16_t* smem) {
  const int tid = otid(), lane = tid & 63, wave = tid >> 6, r = lane & 31, h = lane >> 5;
  const bf16_t* Kg = p.Kc() + ((size_t)(b * 6 + hh) * TT + k_begin) * 96;
  const bf16_t* Vg = p.Vt() + ((size_t)(b * 6 + hh) * 64) * TT + k_begin;
  const int qrow = q0 + wave * 32 + r;
  bf16x8 qreg[6];
  {
    const bf16_t* qp = p.Q() + ((size_t)(b * 6 + hh) * TT + qrow) * 96 + h * 8;
#pragma unroll
    for (int ks = 0; ks < 6; ++ks) qreg[ks] = *(const bf16x8*)(qp + ks * 16);
  }
  if (q0 < LSEQ) {
#pragma unroll
    for (int ax = 0; ax < 2; ++ax) {
      const int pos = ax ? (qrow & 63) : (qrow >> 6);
      const float* rp = p.rope() + pos * 16;
      const uint4 me = __builtin_bit_cast(uint4, qreg[4 + ax]);
      uint4 rr;
      rr.x = rope_word(me.x, __shfl_xor(me.x, 32), *(const float4*)(rp + 0), h);
      rr.y = rope_word(me.y, __shfl_xor(me.y, 32), *(const float4*)(rp + 4), h);
      rr.z = rope_word(me.z, __shfl_xor(me.z, 32), *(const float4*)(rp + 8), h);
      rr.w = rope_word(me.w, __shfl_xor(me.w, 32), *(const float4*)(rp + 12), h);
      qreg[4 + ax] = __builtin_bit_cast(bf16x8, rr);
    }
  }
  bf16_t* sK = smem;
  bf16_t* sV = smem + 2 * 64 * 104;
  uint4 rk0, rk1 = make_uint4(0u, 0u, 0u, 0u), rv;
  const int vrow = tid >> 3, vch = (tid & 7) * 8;
  const int kc1 = tid + 512;
  const int krow0 = tid / 12, kch0 = tid - krow0 * 12, krow1 = kc1 / 12, kch1 = kc1 - krow1 * 12;
#define K_LOAD(t_)                                                         \
  do {                                                                     \
    const bf16_t* kg_ = Kg + (size_t)(t_) * 64 * 96;                       \
    rk0 = *(const uint4*)(kg_ + (size_t)tid * 8);                          \
    if (tid < 256) rk1 = *(const uint4*)(kg_ + (size_t)kc1 * 8);           \
  } while (0)
#define K_STORE(buf_)                                                                      \
  do {                                                                                     \
    *(uint4*)(sK + ((buf_) * 64 + krow0) * 104 + kch0 * 8) = rk0;                          \
    if (tid < 256) *(uint4*)(sK + ((buf_) * 64 + krow1) * 104 + kch1 * 8) = rk1;           \
  } while (0)
#define V_LOAD(t_) rv = *(const uint4*)(Vg + (size_t)vrow * TT + (t_) * 64 + vch)
#define V_STORE(buf_)                                                                      \
  do {                                                                                     \
    bf16_t* vp_ = sV + ((buf_) * 64 + vrow) * 68 + vch;                                    \
    *(uint2*)vp_ = make_uint2(rv.x, rv.y);                                                 \
    *(uint2*)(vp_ + 4) = make_uint2(rv.z, rv.w);                                           \
  } while (0)
#define S_TILE(dst, buf_)                                                                                      \
  do {                                                                                                         \
    bf16x8 kf_[6];                                                                                             \
    const bf16_t* kb_ = sK + ((buf_) * 64 + r) * 104 + h * 8;                                                  \
    _Pragma("unroll") for (int ks = 0; ks < 6; ++ks) kf_[ks] = *(const bf16x8*)(kb_ + ks * 16);                \
    __builtin_amdgcn_sched_barrier(0);                                                                         \
    dst[0] = zero16();                                                                                         \
    _Pragma("unroll") for (int ks = 0; ks < 6; ++ks) dst[0] = MFMA(kf_[ks], qreg[ks], dst[0]);                 \
    __builtin_amdgcn_sched_barrier(0);                                                                         \
    _Pragma("unroll") for (int ks = 0; ks < 6; ++ks) kf_[ks] = *(const bf16x8*)(kb_ + 32 * 104 + ks * 16);     \
    __builtin_amdgcn_sched_barrier(0);                                                                         \
    dst[1] = zero16();                                                                                         \
    _Pragma("unroll") for (int ks = 0; ks < 6; ++ks) dst[1] = MFMA(kf_[ks], qreg[ks], dst[1]);                 \
    __builtin_amdgcn_sched_barrier(0);                                                                         \
  } while (0)
  K_LOAD(0); V_LOAD(0);
  K_STORE(0); V_STORE(0);
  if (nkt > 1) { K_LOAD(1); K_STORE(1); }
  __syncthreads();
  f32x16 o[2], o2, sc[2], negm;
  o[0] = zero16();
  o[1] = zero16();
  o2 = zero16();
  negm = zero16();
  bf16x8 ones;
  {
    const unsigned w = r == 0 ? 0x3F803F80u : 0u;
    uint4 u; u.x = w; u.y = w; u.z = w; u.w = w;
    ones = __builtin_bit_cast(bf16x8, u);
  }
#define S_CHAIN(dst, buf_)                                                                                 \
  do {                                                                                                     \
    bf16x8 kf_[6];                                                                                         \
    const bf16_t* kb_ = sK + ((buf_) * 64 + r) * 104 + h * 8;                                              \
    _Pragma("unroll") for (int ks = 0; ks < 6; ++ks) kf_[ks] = *(const bf16x8*)(kb_ + ks * 16);            \
    __builtin_amdgcn_sched_barrier(0);                                                                     \
    dst[0] = negm;                                                                                         \
    __builtin_amdgcn_s_setprio(1);                                                                         \
    _Pragma("unroll") for (int ks = 0; ks < 6; ++ks) dst[0] = MFMA(kf_[ks], qreg[ks], dst[0]);             \
    __builtin_amdgcn_s_setprio(0);                                                                         \
    __builtin_amdgcn_sched_barrier(0);                                                                     \
    _Pragma("unroll") for (int ks = 0; ks < 6; ++ks) kf_[ks] = *(const bf16x8*)(kb_ + 32 * 104 + ks * 16); \
    __builtin_amdgcn_sched_barrier(0);                                                                     \
    dst[1] = negm;                                                                                         \
    __builtin_amdgcn_s_setprio(1);                                                                         \
    _Pragma("unroll") for (int ks = 0; ks < 6; ++ks) dst[1] = MFMA(kf_[ks], qreg[ks], dst[1]);             \
    __builtin_amdgcn_s_setprio(0);                                                                         \
    __builtin_amdgcn_sched_barrier(0);                                                                     \
  } while (0)
#define ATT_STEP(sc_, sn_, kt_)                                                                            \
  do {                                                                                                     \
    const int buf = (kt_) & 1;                                                                             \
    if ((kt_) + 2 < nkt) K_LOAD((kt_) + 2);                                                                \
    if ((kt_) + 1 < nkt) { V_LOAD((kt_) + 1); S_CHAIN(sn_, buf ^ 1); }                                     \
    bf16x8 vf_[8];                                                                                         \
    _Pragma("unroll") for (int mt = 0; mt < 2; ++mt)                                                       \
    _Pragma("unroll") for (int s2 = 0; s2 < 2; ++s2)                                                       \
    _Pragma("unroll") for (int dt = 0; dt < 2; ++dt) {                                                     \
      const bf16_t* va = sV + (buf * 64 + dt * 32 + r) * 68 + mt * 32 + 16 * s2 + 4 * h;                   \
      vf_[(mt * 2 + s2) * 2 + dt] = join8(*(const uint2*)va, *(const uint2*)(va + 8));                     \
    }                                                                                                      \
    __builtin_amdgcn_sched_barrier(0);                                                                     \
    float mx = sc_[0][0];                                                                                  \
    _Pragma("unroll") for (int i = 1; i < 16; ++i) mx = fmaxf(mx, sc_[0][i]);                              \
    _Pragma("unroll") for (int i = 0; i < 16; ++i) mx = fmaxf(mx, sc_[1][i]);                              \
    mx = fmaxf(mx, __shfl_xor(mx, 32));                                                                    \
    if ((kt_) == 0 || __builtin_amdgcn_ballot_w64(mx > 8.f) != 0ull) {                                     \
      const float delta = ((kt_) == 0 || mx > 8.f) ? mx : 0.f;                                             \
      const float alpha = (kt_) == 0 ? 0.f : __builtin_amdgcn_exp2f(-delta);                               \
      _Pragma("unroll") for (int i = 0; i < 16; ++i) {                                                     \
        o[0][i] *= alpha; o[1][i] *= alpha; o2[i] *= alpha;                                                \
        sc_[0][i] -= delta; sc_[1][i] -= delta; sn_[0][i] -= delta; sn_[1][i] -= delta; negm[i] -= delta;  \
      }                                                                                                    \
    }                                                                                                      \
    _Pragma("unroll") for (int mt = 0; mt < 2; ++mt)                                                       \
    _Pragma("unroll") for (int i = 0; i < 16; ++i) sc_[mt][i] = __builtin_amdgcn_exp2f(sc_[mt][i]);        \
    __builtin_amdgcn_s_setprio(1);                                                                         \
    _Pragma("unroll") for (int mt = 0; mt < 2; ++mt)                                                       \
    _Pragma("unroll") for (int s2 = 0; s2 < 2; ++s2) {                                                     \
      const bf16x8 pf = pack8(sc_[mt], s2);                                                                \
      o[0] = MFMA(vf_[(mt * 2 + s2) * 2 + 0], pf, o[0]);                                                   \
      o[1] = MFMA(vf_[(mt * 2 + s2) * 2 + 1], pf, o[1]);                                                   \
      o2 = MFMA(ones, pf, o2);                                                                             \
    }                                                                                                      \
    __builtin_amdgcn_s_setprio(0);                                                                         \
    if ((kt_) + 2 < nkt) K_STORE(buf);                                                                     \
    if ((kt_) + 1 < nkt) V_STORE(buf ^ 1);                                                                 \
    __syncthreads();                                                                                       \
  } while (0)
  f32x16 sn[2];
  sn[0] = zero16();
  sn[1] = zero16();
  S_CHAIN(sc, 0);
  __syncthreads();
  for (int kt = 0; kt < nkt; kt += 2) {
    ATT_STEP(sc, sn, kt);
    ATT_STEP(sn, sc, kt + 1);
  }
#undef ATT_STEP
#undef S_CHAIN
  float l = __shfl(o2[0], r);
#undef K_LOAD
#undef K_STORE
#undef V_LOAD
#undef V_STORE
#undef S_TILE
  const float inv = 1.f / l;
  bf16_t* op = p.xn() + ((size_t)b * TT + qrow) * DM + 384 + hh * 64 + 4 * h;
#pragma unroll
  for (int dt = 0; dt < 2; ++dt)
#pragma unroll
    for (int g = 0; g < 4; ++g) {
      uint2 u;
      u.x = pack2(o[dt][4 * g + 0] * inv, o[dt][4 * g + 1] * inv);
      u.y = pack2(o[dt][4 * g + 2] * inv, o[dt][4 * g + 3] * inv);
      *(uint2*)(op + dt * 32 + 8 * g) = u;
    }
}

DI void ssd_out_rows(const Params& p, int layer, int r_begin, int nrows) {
  const int tid = otid(), lane = tid & 63, wave = tid >> 6;
  const int grp = lane >> 5, li = lane & 31;
  const int ch = grp * 192 + li * 6;
  float dsk[6], nw[6];
#pragma unroll
  for (int e = 0; e < 6; ++e) {
    dsk[e] = p.ssd_d[layer * 6 + (ch + e) / 64];
    nw[e] = p.ssd_norm_w[layer * 384 + ch + e];
  }
  for (int r = r_begin + wave; r < r_begin + nrows; r += 8) {
    const int b = r / TT, t = r - b * TT;
    if (t >= LSEQ && layer == 1) continue;
    const unsigned* yf = (const unsigned*)(p.yssd() + (size_t)r * 384 + ch);
    const unsigned* yb = (const unsigned*)(p.yssd() + ((size_t)MT + r) * 384 + ch);
    const unsigned* xs = (const unsigned*)(p.xbc() + (size_t)r * 896 + ch);
    const unsigned* zz = (const unsigned*)(p.proj() + (size_t)r * NP + C_Z + ch);
    float g[6];
    float ss = 0.f;
#pragma unroll
    for (int e2 = 0; e2 < 3; ++e2) {
      const unsigned a = yf[e2], bq = yb[e2], x = xs[e2], z = zz[e2];
      const float y0 = bflo(a) + bflo(bq) + bflo(x) * dsk[2 * e2];
      const float y1 = bfhi(a) + bfhi(bq) + bfhi(x) * dsk[2 * e2 + 1];
      g[2 * e2] = y0 * silu(bflo(z));
      g[2 * e2 + 1] = y1 * silu(bfhi(z));
      ss += g[2 * e2] * g[2 * e2] + g[2 * e2 + 1] * g[2 * e2 + 1];
    }
#pragma unroll
    for (int o = 16; o >= 1; o >>= 1) ss += __shfl_xor(ss, o);
    const float rstd = rsqrtf(ss * (1.f / 192.f) + 1e-6f);
    unsigned* dst = (unsigned*)(p.xn() + (size_t)r * DM + ch);
#pragma unroll
    for (int e2 = 0; e2 < 3; ++e2) dst[e2] = pack2(g[2 * e2] * rstd * nw[2 * e2], g[2 * e2 + 1] * rstd * nw[2 * e2 + 1]);
  }
}

DI void phase_mixers(const Params& p, int layer, bf16_t* smem, int rep) {
  if (EN(13) || ONLY == 3) for (int jp = obid(); jp < 96; jp += ogrid()) ssd_job(p, layer, jp, smem);
  if (ONLY == 13) return;
  if (layer == 0) {
    if (ogrid() > 96) { if (obid() >= 96) transpose_layer(p, 1, obid() - 96, ogrid() - 96, (float*)smem); }
    else transpose_layer(p, 1, obid(), ogrid(), (float*)smem);
  }
  volatile int* sitem = (volatile int*)((char*)smem + MISC_OFF + 1024);
  const int ipg = layer == 0 ? 17 : 16;
  const int nper = 12 * ipg;
  unsigned* qbase = p.bar() + 3616 + (layer + 2 * rep) * 8;
  const int xcc = (int)(xb_xcc_id() & 7u);
  for (int k = 0; k < 8; ++k) {
    const int xq = (xcc + k) & 7;
    while (true) {
      __syncthreads();
      if (threadIdx.x == 0) *sitem = (int)xb_add(qbase + xq, 1u);
      __syncthreads();
      const int idx = *sitem;
      if (idx >= nper) break;
      const int gi = idx / ipg, within = idx - gi * ipg;
      const int g = xq + 8 * gi;
      const int b = g / 6, hh = g - b * 6;
      if (within == 16) attn_item(p, b, hh, LSEQ, LSEQ, 4, smem);
      else attn_item(p, b, hh, within * 256, 0, 68, smem);
    }
  }
  {
    unsigned* done = p.bar() + 3700 + layer * 16;
    unsigned* rowq = p.bar() + 3740 + layer * 16;
    const int nchunk = layer == 0 ? 68 : 64;
    for (int bb = 0; bb < NB; ++bb) {
      __syncthreads();
      if (threadIdx.x == 0) {
        XB_SPIN(xb_ld(done + bb) < 12u, p.bar());
        __builtin_amdgcn_fence(__ATOMIC_ACQUIRE, "agent");
        asm volatile("s_waitcnt vmcnt(0)" ::: "memory");
      }
      __syncthreads();
      while (true) {
        if (threadIdx.x == 0) *sitem = (int)xb_add(rowq + bb, 1u);
        __syncthreads();
        const int c = *sitem;
        __syncthreads();
        if (c >= nchunk) break;
        ssd_out_rows(p, layer, bb * TT + c * 64, 64);
      }
    }
  }
}

struct XcdBarrier { unsigned* bar; unsigned x; volatile LAS unsigned* st; };
DI XcdBarrier xcd_barrier_post(unsigned* bar, volatile LAS unsigned* st) {
  XcdBarrier b; b.bar = bar; b.x = xb_xcc_id(); b.st = st;
  if (threadIdx.x == 0) (void)xb_add(&bar[XB_XCNT(b.x)], 1u);
  return b;
}
DI void xcd_barrier_complete(unsigned* bar, unsigned x, unsigned& nloc, unsigned& nx) {
  const unsigned G = gridDim.x * gridDim.y * gridDim.z;
  unsigned sum, cnt, mine, sp = 0u;
  for (;;) {
    sum = 0u; cnt = 0u; mine = 0u;
#pragma unroll
    for (unsigned j = 0; j < 16; ++j) { const unsigned c = xb_ld(&bar[XB_XCNT(j)]); sum += c; cnt += (c > 0u) ? 1u : 0u; mine = (j == x) ? c : mine; }
    if (sum == G) break;
    __builtin_amdgcn_s_sleep(1);
    if ((++sp & 255u) == 0u) { if (xb_ld(&bar[XB_TMO])) break; if (sp > XB_SPIN_CAP) { atomicAdd(&bar[XB_TMO], 1u); break; } }
  }
  nloc = mine > 0u ? mine : 1u; nx = cnt > 0u ? cnt : 1u;
}
DI void xcd_barrier(const XcdBarrier& b) {
  asm volatile("s_waitcnt vmcnt(0)" ::: "memory");
  __syncthreads();
  if (threadIdx.x == 0) {
    unsigned* bar = b.bar;
    __builtin_amdgcn_s_waitcnt(0);
    unsigned nloc = b.st[0], nx = b.st[1];
    if (nloc == 0u) { xcd_barrier_complete(bar, b.x, nloc, nx); b.st[0] = nloc; b.st[1] = nx; }
    const unsigned old = xb_add(&bar[XB_XSUB(b.x)], 1u);
    const unsigned gen = old / nloc;
    if (old + 1u == (gen + 1u) * nloc) {
      __builtin_amdgcn_fence(__ATOMIC_RELEASE, "agent");
      asm volatile("s_waitcnt vmcnt(0)" ::: "memory");
      const unsigned og = xb_add(&bar[XB_TOP], 1u);
      const unsigned tg = og / nx;
      if (og + 1u == (tg + 1u) * nx) xb_add(&bar[XB_TOPGEN], 1u);
      else XB_SPIN(xb_ld(&bar[XB_TOPGEN]) == tg, bar);
      __builtin_amdgcn_fence(__ATOMIC_ACQUIRE, "agent");
      xb_add(&bar[XB_XGEN(b.x)], 1u);
      asm volatile("s_waitcnt vmcnt(0)" ::: "memory");
    } else {
      XB_SPIN(xb_ld(&bar[XB_XGEN(b.x)]) == gen, bar);
      __builtin_amdgcn_fence(__ATOMIC_ACQUIRE, "agent");
      asm volatile("s_waitcnt vmcnt(0)" ::: "memory");
    }
  }
  __syncthreads();
}

DI void run_phase(const Params& p, int ph, bf16_t* smem, int rep) {
  if (ph == 0) { if (EN(10)) phase_prep(p, smem); return; }
  if (ph == NPHASE - 1) { if (EN(11)) phase_final(p); return; }
  const int layer = (ph - 1) / 9, s = (ph - 1) % 9;
  switch (s) {
    case 0: if (EN(0)) phase_norm(p, layer, 1); break;
    case 1: if (EN(1)) phase_gemm_in(p, layer, smem); break;
    case 2: if (EN(2)) phase_tokops(p, layer); if (EN(12)) phase_gemm_qkv(p, layer, smem); break;
    case 3: if (EN(3) || EN(13) || EN(14)) phase_mixers(p, layer, smem, rep); break;
    case 4: break;
    case 5: if (EN(5)) phase_gemm_out(p, layer, smem); break;
    case 6: if (EN(6)) phase_norm(p, layer, 2); break;
    case 7: if (EN(7)) phase_gemm_m1(p, layer, smem); break;
    default: if (EN(8)) phase_gemm_m2(p, layer, smem); break;
  }
}

__global__ void __launch_bounds__(512, 2) fwd_megakernel(Params p, int ph_begin, int ph_end) {
  __shared__ __attribute__((aligned(16))) unsigned char smem_raw[SMEM_BYTES];
  bf16_t* smem = (bf16_t*)smem_raw;
  cg::grid_group grid = cg::this_grid();
  volatile LAS unsigned* xst = (volatile LAS unsigned*)(LAS unsigned char*)(smem_raw + MISC_OFF + 1024 + 32);
  if (threadIdx.x == 0) { xst[0] = 0u; xst[1] = 0u; }
  __syncthreads();
  const XcdBarrier xb = xcd_barrier_post(p.bar(), xst);
  for (int ph = ph_begin; ph < ph_end; ++ph) {
    if (ph >= 1 && ph < NPHASE - 1 && (ph - 1) % 9 == 4) continue;
    run_phase(p, ph, smem, 0);
#if REPEAT_MASK
    if (ph >= 1 && ph < NPHASE - 1 && ((REPEAT_MASK >> ((ph - 1) % 9)) & 1)) {
      xcd_barrier(xb);
      run_phase(p, ph, smem, 1);
    }
#endif
    if (ph + 1 < ph_end) {
      if (ph == 0) grid.sync();
      else xcd_barrier(xb);
    }
  }
}

extern "C" void kernel_launch(void* const* d_in, const int* in_sizes, int n_in, void* d_out, int out_size, void* d_ws,
                              size_t ws_size, hipStream_t stream) {
  static int grid_blocks = 0;
  if (!grid_blocks) {
    int dev = 0, cus = 0, per_cu = 0;
    hipGetDevice(&dev);
    hipDeviceGetAttribute(&cus, hipDeviceAttributeMultiprocessorCount, dev);
    hipOccupancyMaxActiveBlocksPerMultiprocessor(&per_cu, fwd_megakernel, 512, 0);
    if (per_cu > 1) per_cu = 1;
    if (per_cu < 1) per_cu = 1;
    grid_blocks = cus * per_cu;
  }
  Params p{};
  const float** fp = (const float**)&p;
  for (int i = 0; i < 25; ++i) fp[i] = (const float*)d_in[i];
  p.out = (float*)d_out;
  p.ws = (char*)d_ws;
  if (WS_NEED > ws_size) fprintf(stderr, "workspace too small: need %zu have %zu\n", (size_t)WS_NEED, ws_size);
  hipMemsetAsync((char*)d_ws + O_BAR, 0, 16384, stream);
#if MULTI_LAUNCH
  for (int ph = 0; ph < NPHASE; ++ph)
    hipLaunchKernelGGL(fwd_megakernel, dim3(grid_blocks), dim3(512), 0, stream, p, ph, ph + 1);
#else
  int b0 = 0, b1 = NPHASE;
  void* args[] = {&p, &b0, &b1};
  hipError_t e = hipLaunchCooperativeKernel((void*)fwd_megakernel, dim3(grid_blocks), dim3(512), args, 0, stream);
  if (e != hipSuccess) fprintf(stderr, "cooperative launch failed: %s (grid %d)\n", hipGetErrorString(e), grid_blocks);
#endif
}
```

```cpp
#include <hip/hip_runtime.h>
#include <hip/hip_cooperative_groups.h>
#include <cstdio>
#include <cstdint>
namespace cg = cooperative_groups;

#ifndef MULTI_LAUNCH
#define MULTI_LAUNCH 0
#endif
#ifndef ONLY
#define ONLY -1
#endif
#define EN(k) (ONLY < 0 || ONLY == (k))
#ifndef REPEAT_MASK
#define REPEAT_MASK 0
#endif

#define DI __device__ __forceinline__
typedef unsigned short bf16_t;
using bf16x8 = __attribute__((ext_vector_type(8))) short;
using f32x16 = __attribute__((ext_vector_type(16))) float;
typedef __bf16 bfv2 __attribute__((ext_vector_type(2)));
typedef float f32v2 __attribute__((ext_vector_type(2)));
#define MFMA(a, b, c) __builtin_amdgcn_mfma_f32_32x32x16_bf16((a), (b), (c), 0, 0, 0)

constexpr int NB = 16, LSEQ = 4096, CTXL = 256, TT = 4352;
constexpr int MT = NB * TT;
constexpr int DM = 1024, DFF = 4096;
constexpr int NP = 2176;
constexpr int C_Z = 0, C_XBC = 384, C_DT = 1280, C_QA = 1344, C_KVA = 1600, C_KR = 1856, C_POOL = 1888;
constexpr int IN_COLS = 2092;
constexpr int NPHASE = 20;
constexpr int MISC_OFF = 145408;
constexpr int SMEM_BYTES = MISC_OFF + 1024 + 256;
constexpr int NPW = 2304;
constexpr int NQ = 768;
constexpr int SSD_LDS_EL = 36352;

constexpr size_t al256(size_t x) { return (x + 255) & ~(size_t)255; }
constexpr size_t O_WT_IN = 0;
constexpr size_t O_WT_OUT = O_WT_IN + al256((size_t)2 * NPW * 1024 * 2);
constexpr size_t O_WT_M1 = O_WT_OUT + al256((size_t)2 * 1024 * 1024 * 2);
constexpr size_t O_WT_M2 = O_WT_M1 + al256((size_t)2 * 4096 * 1024 * 2);
constexpr size_t O_WT_QB = O_WT_M2 + al256((size_t)2 * 1024 * 4096 * 2);
constexpr size_t O_WT_KVB = O_WT_QB + al256((size_t)2 * NQ * 256 * 2);
constexpr size_t O_MODS = O_WT_KVB + al256((size_t)2 * 768 * 256 * 2);
constexpr size_t O_ROPE = O_MODS + al256((size_t)2 * 17 * 6144 * 4);
constexpr size_t O_CTR = O_ROPE + al256(64 * 8 * 2 * 4);
constexpr size_t O_BAR = O_CTR + 256;
constexpr size_t O_RSS = O_BAR + 16384;
constexpr size_t O_CTXRES = O_RSS + al256((size_t)2 * MT * 4);
constexpr size_t O_XN = O_CTXRES + al256((size_t)NB * CTXL * DM * 4);
constexpr size_t O_YSSD = O_XN + al256((size_t)MT * DM * 2);
constexpr size_t O_BIG = O_YSSD + al256((size_t)2 * MT * 384 * 2);
constexpr size_t O_PROJ = O_BIG;
constexpr size_t O_XBC = O_PROJ + al256((size_t)MT * NP * 2);
constexpr size_t O_Q = O_XBC + al256((size_t)MT * 896 * 2);
constexpr size_t O_K = O_Q + al256((size_t)NB * 6 * TT * 96 * 2);
constexpr size_t O_VT = O_K + al256((size_t)NB * 6 * TT * 96 * 2);
constexpr size_t O_END1 = O_VT + al256((size_t)NB * 6 * 64 * TT * 2);
constexpr size_t O_END2 = O_BIG + (size_t)MT * DFF * 2;
constexpr size_t WS_NEED = O_END1 > O_END2 ? O_END1 : O_END2;

struct Params {
  const float *x, *c, *ctx, *c_ctx, *mod_w, *mod_b, *norm1_w, *norm2_w, *w_in, *conv_w, *conv_b, *dt_bias, *a_log,
      *ssd_d, *ssd_norm_w, *q_a_norm_w, *w_q_b, *kv_a_norm_w, *w_kv_b, *pool_w, *pool_scale, *w_out, *w_mlp1, *w_mlp2,
      *final_norm_w;
  float* out;
  char* ws;
  DI bf16_t* wt_in() const { return (bf16_t*)(ws + O_WT_IN); }
  DI bf16_t* wt_out() const { return (bf16_t*)(ws + O_WT_OUT); }
  DI bf16_t* wt_m1() const { return (bf16_t*)(ws + O_WT_M1); }
  DI bf16_t* wt_m2() const { return (bf16_t*)(ws + O_WT_M2); }
  DI bf16_t* wt_qb() const { return (bf16_t*)(ws + O_WT_QB); }
  DI bf16_t* wt_kvb() const { return (bf16_t*)(ws + O_WT_KVB); }
  DI float* mods() const { return (float*)(ws + O_MODS); }
  DI float* rope() const { return (float*)(ws + O_ROPE); }
  DI int* ctr() const { return (int*)(ws + O_CTR); }
  DI unsigned* bar() const { return (unsigned*)(ws + O_BAR); }
  DI float* rss() const { return (float*)(ws + O_RSS); }
  DI float* ctxres() const { return (float*)(ws + O_CTXRES); }
  DI bf16_t* xn() const { return (bf16_t*)(ws + O_XN); }
  DI bf16_t* yssd() const { return (bf16_t*)(ws + O_YSSD); }
  DI bf16_t* proj() const { return (bf16_t*)(ws + O_PROJ); }
  DI bf16_t* xbc() const { return (bf16_t*)(ws + O_XBC); }
  DI bf16_t* Q() const { return (bf16_t*)(ws + O_Q); }
  DI bf16_t* Kc() const { return (bf16_t*)(ws + O_K); }
  DI bf16_t* Vt() const { return (bf16_t*)(ws + O_VT); }
  DI bf16_t* hidden() const { return (bf16_t*)(ws + O_BIG); }
};

DI unsigned pack2(float a, float b) {
  f32v2 v = {a, b};
  bfv2 r = __builtin_convertvector(v, bfv2);
  return __builtin_bit_cast(unsigned, r);
}
DI bf16_t f2bf(float a) { return (bf16_t)(pack2(a, 0.f) & 0xffffu); }
DI float bf2f(bf16_t v) { return __uint_as_float(((unsigned)v) << 16); }
DI float bflo(unsigned w) { return __uint_as_float(w << 16); }
DI float bfhi(unsigned w) { return __uint_as_float(w & 0xffff0000u); }
DI float silu(float x) { return x / (1.f + __expf(-x)); }
DI int crow(int reg, int h) { return (reg & 3) + 8 * (reg >> 2) + 4 * h; }
DI float wave_sum(float v) {
#pragma unroll
  for (int o = 32; o >= 1; o >>= 1) v += __shfl_xor(v, o);
  return v;
}
DI bf16x8 pack8(const f32x16& x, int s) {
  uint4 u;
  u.x = pack2(x[8 * s + 0], x[8 * s + 1]);
  u.y = pack2(x[8 * s + 2], x[8 * s + 3]);
  u.z = pack2(x[8 * s + 4], x[8 * s + 5]);
  u.w = pack2(x[8 * s + 6], x[8 * s + 7]);
  return __builtin_bit_cast(bf16x8, u);
}
DI bf16x8 join8(uint2 lo, uint2 hi) {
  uint4 u; u.x = lo.x; u.y = lo.y; u.z = hi.x; u.w = hi.y;
  return __builtin_bit_cast(bf16x8, u);
}
DI int ogrid() { return gridDim.x; }
DI int obid() { return blockIdx.x; }
DI int ogrid_op() { int g = gridDim.x; asm volatile("" : "+s"(g)); return g; }
DI int otid() { int t = threadIdx.x; asm volatile("" : "+v"(t)); return t; }
DI unsigned xb_ld(unsigned* p) { return __hip_atomic_load(p, __ATOMIC_RELAXED, __HIP_MEMORY_SCOPE_AGENT); }
DI unsigned xb_add(unsigned* p, unsigned v) { return __hip_atomic_fetch_add(p, v, __ATOMIC_RELAXED, __HIP_MEMORY_SCOPE_AGENT); }
DI unsigned xb_xcc_id() { return (unsigned)__builtin_amdgcn_s_getreg((3 << 11) | 20) & 0xFu; }
#define XB_TMO      128
#define XB_XCNT(j)  (256  + 64 * (j))
#define XB_XSUB(j)  (1280 + 64 * (j))
#define XB_XGEN(j)  (2304 + 64 * (j))
#define XB_TOP      3328
#define XB_TOPGEN   3392
#define XCD_BAR_WORDS 3456
#define XB_SPIN_CAP (1u << 18)
#define XB_SPIN(cond, bar) do { unsigned _sp = 0; while (cond) { __builtin_amdgcn_s_sleep(1); \
    if ((++_sp & 255u) == 0u) { if (xb_ld(&(bar)[XB_TMO])) break; if (_sp > XB_SPIN_CAP) { atomicAdd(&(bar)[XB_TMO], 1u); break; } } } } while (0)
DI f32x16 zero16() { f32x16 z; for (int i = 0; i < 16; ++i) z[i] = 0.f; return z; }

DI float* res_row(const Params& p, int b, int t) {
  return t < LSEQ ? p.out + ((size_t)b * LSEQ + t) * DM : p.ctxres() + ((size_t)b * CTXL + (t - LSEQ)) * DM;
}
DI const float* in_row(const Params& p, int b, int t) {
  return t < LSEQ ? p.x + ((size_t)b * LSEQ + t) * DM : p.ctx + ((size_t)b * CTXL + (t - LSEQ)) * DM;
}

using f32x4 = __attribute__((ext_vector_type(4))) float;
constexpr int GBK = 64, GHALF = 128, GHT = GHALF * GBK;
#define LAS __attribute__((address_space(3)))
DI int lds_byte(int r, int c) {
  const int st = (r >> 4) * 2 + (c >> 5), rr = r & 15, cc = c & 31, ob = rr * 64 + cc * 2;
  return st * 1024 + (ob ^ (((ob >> 9) & 1) << 5));
}
DI void stage_rc(int b, int& R, int& C) {
  const int st = b / 1024, sb = b % 1024, swz = sb ^ (((sb >> 9) & 1) << 5);
  R = (st >> 1) * 16 + swz / 64;
  C = (st & 1) * 32 + (swz % 64) / 2;
}
typedef f32x4 acc_t[2][2][4][2];
DI int perm32(int rho) { const int n = rho >> 4, i = rho & 15; return 8 * (i >> 2) + 4 * n + (i & 3); }

template <bool RMS, class Epi, class UnitFn>
DI void gemm256(const bf16_t* __restrict__ A, int lda, const bf16_t* __restrict__ Bt, int ldb, int K,
                bf16_t* shm, Epi& epi, UnitFn unit) {
  const int tid = otid();
  const int wid = tid >> 6, lane = tid & 63, wr = wid >> 2, wc = wid & 3, fr = lane & 15, fq = lane >> 4;
  float* rs = (float*)((char*)shm + MISC_OFF);
  const int ldst0 = tid * 16;
  const unsigned swave = (unsigned)__builtin_amdgcn_readfirstlane((int)((unsigned)(size_t)(LAS char*)shm + (unsigned)((tid & ~63) * 16)));
  unsigned la0, la1, lb0, lb1;
  {
    int r0_, c0_, r1_, c1_;
    stage_rc(ldst0, r0_, c0_);
    stage_rc(ldst0 + 8192, r1_, c1_);
    la0 = (unsigned)(r0_ * lda + c0_) * 2u; la1 = (unsigned)(r1_ * lda + c1_) * 2u;
    if (Epi::PERM) { r0_ = (r0_ & ~31) | perm32(r0_ & 31); r1_ = (r1_ & ~31) | perm32(r1_ & 31); }
    lb0 = (unsigned)(r0_ * ldb + c0_) * 2u; lb1 = (unsigned)(r1_ * ldb + c1_) * 2u;
  }
#define SA(b, h) (shm + ((b) * 2 + (h)) * GHT)
#define SB(b, h) (shm + (4 + (b) * 2 + (h)) * GHT)
#define GLDS(voff, sbase, m0v)                                                                           \
  asm volatile("s_mov_b32 m0, %2\n\ts_nop 0\n\tglobal_load_lds_dwordx4 %0, %1" ::"v"(voff), "s"(sbase), "s"(m0v) : "memory", "m0")
#define STAGE(PB, BASE, LD, br, kt, L0, L1)                                                               \
  do {                                                                                                    \
    const char* _ub = (const char*)((BASE) + (long)(br) * (LD) + (long)(kt) * GBK);                       \
    const unsigned _m = swave + (unsigned)(PB);                                                           \
    GLDS(L0, _ub, _m);                                                                                    \
    GLDS(L1, _ub, _m + 8192u);                                                                            \
  } while (0)
#define SAB(b, h) ((((b) * 2 + (h)) * GHT) * 2)
#define SBB(b, h) (((4 + (b) * 2 + (h)) * GHT) * 2)
#define STA(P, br, kt) STAGE(P, A, lda, br, kt, la0, la1)
#define STB(P, br, kt) STAGE(P, Bt, ldb, br, kt, lb0, lb1)
#define LDA(dst, b, h)                                                                                    \
  _Pragma("unroll") for (int m = 0; m < 4; ++m) _Pragma("unroll") for (int k = 0; k < 2; ++k)             \
      dst[m][k] = *reinterpret_cast<const bf16x8*>((const char*)SA(b, h) + lds_byte(wr * 64 + m * 16 + fr, k * 32 + fq * 8))
#define LDB(dst, b, h)                                                                                    \
  _Pragma("unroll") for (int n = 0; n < 2; ++n) _Pragma("unroll") for (int k = 0; k < 2; ++k)             \
      dst[n][k] = *reinterpret_cast<const bf16x8*>((const char*)SB(b, h) + lds_byte(wc * 32 + n * 16 + fr, k * 32 + fq * 8))
#define MMA(ai, bj, At_, Bt_)                                                                             \
  do {                                                                                                    \
    __builtin_amdgcn_s_setprio(1);                                                                        \
    _Pragma("unroll") for (int m = 0; m < 4; ++m) _Pragma("unroll") for (int n = 0; n < 2; ++n)           \
        _Pragma("unroll") for (int k = 0; k < 2; ++k) acc[ai][bj][m][n] =                                 \
            __builtin_amdgcn_mfma_f32_16x16x32_bf16(Bt_[n][k], At_[m][k], acc[ai][bj][m][n], 0, 0, 0);   \
    __builtin_amdgcn_s_setprio(0);                                                                        \
  } while (0)
#define WAIT_V(n) asm volatile("s_waitcnt vmcnt(" #n ")" ::: "memory")
#define WAIT_L(n) asm volatile("s_waitcnt lgkmcnt(" #n ")" ::: "memory")
#define BAR __builtin_amdgcn_s_barrier()
#define SCHED __builtin_amdgcn_sched_barrier(0)
#define PROLOGUE(br_, bc_)                                                                                 \
  do {                                                                                                    \
    STB(SBB(0, 0), (bc_), 0); STA(SAB(0, 0), (br_), 0);                                                   \
    STB(SBB(0, 1), (bc_) + GHALF, 0); STA(SAB(0, 1), (br_) + GHALF, 0);                                   \
    STB(SBB(1, 0), (bc_), 1); STA(SAB(1, 0), (br_), 1); STB(SBB(1, 1), (bc_) + GHALF, 1);                 \
  } while (0)
  int brow = 0, bcol = 0;
  if (!unit(0, brow, bcol)) return;
  if (!RMS) PROLOGUE(brow, bcol);
  for (int ui = 0;; ++ui) {
  int nbrow = 0, nbcol = 0;
  const bool more = unit(ui + 1, nbrow, nbcol);
  if (RMS) {
    const int row = tid >> 1, half = tid & 1;
    const bf16_t* ap = A + (size_t)(brow + row) * lda + half * 128;
    float ss = 0.f;
#pragma unroll 4
    for (int i = 0; i < 16; ++i) {
      uint4 v = *(const uint4*)(ap + i * 8);
      float f;
      f = bflo(v.x); ss += f * f; f = bfhi(v.x); ss += f * f;
      f = bflo(v.y); ss += f * f; f = bfhi(v.y); ss += f * f;
      f = bflo(v.z); ss += f * f; f = bfhi(v.z); ss += f * f;
      f = bflo(v.w); ss += f * f; f = bfhi(v.w); ss += f * f;
    }
    ss += __shfl_xor(ss, 1);
    if (half == 0) rs[row] = rsqrtf(ss * (1.f / 256.f) + 1e-6f);
    WAIT_V(0);
    PROLOGUE(brow, bcol);
  }
  acc_t acc;
#pragma unroll
  for (int i0 = 0; i0 < 2; ++i0)
#pragma unroll
    for (int i1 = 0; i1 < 2; ++i1)
#pragma unroll
      for (int i2 = 0; i2 < 4; ++i2)
#pragma unroll
        for (int i3 = 0; i3 < 2; ++i3) acc[i0][i1][i2][i3] = (f32x4){0.f, 0.f, 0.f, 0.f};
  bf16x8 At[4][2], B0[2][2], B1[2][2];
  const int nt = K / GBK;
  if (wr == 1) BAR;
  WAIT_V(10); BAR;
  WAIT_V(6); BAR;
  for (int t = 0; t < nt - 2; t += 2) {
    LDB(B0, 0, 0); SCHED; LDA(At, 0, 0); STA(SAB(1, 1), brow + GHALF, t + 1);
    WAIT_L(8); BAR; WAIT_L(0); MMA(0, 0, At, B0); BAR; SCHED;
    LDB(B1, 0, 1); STB(SBB(0, 0), bcol, t + 2);
    BAR; WAIT_L(0); MMA(0, 1, At, B1); BAR;
    LDA(At, 0, 1); STA(SAB(0, 0), brow, t + 2);
    BAR; WAIT_L(0); MMA(1, 0, At, B0); BAR; SCHED;
    STB(SBB(0, 1), bcol + GHALF, t + 2);
    WAIT_V(6); BAR; MMA(1, 1, At, B1); BAR;
    LDB(B0, 1, 0); SCHED; LDA(At, 1, 0); STA(SAB(0, 1), brow + GHALF, t + 2);
    WAIT_L(8); BAR; WAIT_L(0); MMA(0, 0, At, B0); BAR; SCHED;
    LDB(B1, 1, 1); STB(SBB(1, 0), bcol, t + 3);
    BAR; WAIT_L(0); MMA(0, 1, At, B1); BAR;
    LDA(At, 1, 1); STA(SAB(1, 0), brow, t + 3);
    BAR; WAIT_L(0); MMA(1, 0, At, B0); BAR; SCHED;
    STB(SBB(1, 1), bcol + GHALF, t + 3);
    WAIT_V(6); BAR; MMA(1, 1, At, B1); BAR;
  }
  {
    LDB(B0, 0, 0); LDA(At, 0, 0); STA(SAB(1, 1), brow + GHALF, nt - 1);
    BAR; WAIT_L(0); MMA(0, 0, At, B0); BAR;
    LDB(B1, 0, 1); BAR; WAIT_L(0); MMA(0, 1, At, B1); BAR;
    LDA(At, 0, 1); WAIT_V(4); BAR; WAIT_L(0); MMA(1, 0, At, B0); MMA(1, 1, At, B1); BAR;
  }
  {
    LDB(B0, 1, 0); LDA(At, 1, 0); WAIT_V(2); BAR; WAIT_L(0); MMA(0, 0, At, B0); BAR;
    LDB(B1, 1, 1); WAIT_V(0); BAR; WAIT_L(0); MMA(0, 1, At, B1); BAR;
    LDA(At, 1, 1); BAR; WAIT_L(0); MMA(1, 0, At, B0); MMA(1, 1, At, B1); BAR;
  }
  if (wr == 0) BAR;
  if (!RMS && more) { PROLOGUE(nbrow, nbcol); }
  epi(acc, brow, bcol, wr, wc, fr, fq, rs);
  if (RMS) __syncthreads();
  if (!more) break;
  brow = nbrow; bcol = nbcol;
  }
}

template <bool RMS, class Epi>
DI void gemm256_unit(const bf16_t* __restrict__ A, int lda, const bf16_t* __restrict__ Bt, int ldb, int K, int brow, int bcol,
                bf16_t* shm, Epi& epi) {
  const int tid = otid();
  const int wid = tid >> 6, lane = tid & 63, wr = wid >> 2, wc = wid & 3, fr = lane & 15, fq = lane >> 4;
  float* rs = (float*)((char*)shm + MISC_OFF);
  const int ldst0 = tid * 16;
  const unsigned swave = (unsigned)__builtin_amdgcn_readfirstlane((int)((unsigned)(size_t)(LAS char*)shm + (unsigned)((tid & ~63) * 16)));
  unsigned la0, la1, lb0, lb1;
  {
    int r0_, c0_, r1_, c1_;
    stage_rc(ldst0, r0_, c0_);
    stage_rc(ldst0 + 8192, r1_, c1_);
    la0 = (unsigned)(r0_ * lda + c0_) * 2u; la1 = (unsigned)(r1_ * lda + c1_) * 2u;
    lb0 = (unsigned)(r0_ * ldb + c0_) * 2u; lb1 = (unsigned)(r1_ * ldb + c1_) * 2u;
  }
  if (RMS) {
    const int row = tid >> 1, half = tid & 1;
    const bf16_t* ap = A + (size_t)(brow + row) * lda + half * 128;
    float ss = 0.f;
#pragma unroll 4
    for (int i = 0; i < 16; ++i) {
      uint4 v = *(const uint4*)(ap + i * 8);
      float f;
      f = bflo(v.x); ss += f * f; f = bfhi(v.x); ss += f * f;
      f = bflo(v.y); ss += f * f; f = bfhi(v.y); ss += f * f;
      f = bflo(v.z); ss += f * f; f = bfhi(v.z); ss += f * f;
      f = bflo(v.w); ss += f * f; f = bfhi(v.w); ss += f * f;
    }
    ss += __shfl_xor(ss, 1);
    if (half == 0) rs[row] = rsqrtf(ss * (1.f / 256.f) + 1e-6f);
    WAIT_V(0);
  }
  acc_t acc;
#pragma unroll
  for (int i0 = 0; i0 < 2; ++i0)
#pragma unroll
    for (int i1 = 0; i1 < 2; ++i1)
#pragma unroll
      for (int i2 = 0; i2 < 4; ++i2)
#pragma unroll
        for (int i3 = 0; i3 < 2; ++i3) acc[i0][i1][i2][i3] = (f32x4){0.f, 0.f, 0.f, 0.f};
  bf16x8 At[4][2], B0[2][2], B1[2][2];
  const int nt = K / GBK;
  STB(SBB(0, 0), bcol, 0); STA(SAB(0, 0), brow, 0);
  STB(SBB(0, 1), bcol + GHALF, 0); STA(SAB(0, 1), brow + GHALF, 0);
  if (wr == 1) BAR;
  WAIT_V(4); BAR;
  STB(SBB(1, 0), bcol, 1); STA(SAB(1, 0), brow, 1); STB(SBB(1, 1), bcol + GHALF, 1);
  WAIT_V(6); BAR;
  for (int t = 0; t < nt - 2; t += 2) {
    LDB(B0, 0, 0); SCHED; LDA(At, 0, 0); STA(SAB(1, 1), brow + GHALF, t + 1);
    WAIT_L(8); BAR; WAIT_L(0); MMA(0, 0, At, B0); BAR; SCHED;
    LDB(B1, 0, 1); STB(SBB(0, 0), bcol, t + 2);
    BAR; WAIT_L(0); MMA(0, 1, At, B1); BAR;
    LDA(At, 0, 1); STA(SAB(0, 0), brow, t + 2);
    BAR; WAIT_L(0); MMA(1, 0, At, B0); BAR; SCHED;
    STB(SBB(0, 1), bcol + GHALF, t + 2);
    WAIT_V(6); BAR; MMA(1, 1, At, B1); BAR;
    LDB(B0, 1, 0); SCHED; LDA(At, 1, 0); STA(SAB(0, 1), brow + GHALF, t + 2);
    WAIT_L(8); BAR; WAIT_L(0); MMA(0, 0, At, B0); BAR; SCHED;
    LDB(B1, 1, 1); STB(SBB(1, 0), bcol, t + 3);
    BAR; WAIT_L(0); MMA(0, 1, At, B1); BAR;
    LDA(At, 1, 1); STA(SAB(1, 0), brow, t + 3);
    BAR; WAIT_L(0); MMA(1, 0, At, B0); BAR; SCHED;
    STB(SBB(1, 1), bcol + GHALF, t + 3);
    WAIT_V(6); BAR; MMA(1, 1, At, B1); BAR;
  }
  {
    LDB(B0, 0, 0); LDA(At, 0, 0); STA(SAB(1, 1), brow + GHALF, nt - 1);
    BAR; WAIT_L(0); MMA(0, 0, At, B0); BAR;
    LDB(B1, 0, 1); BAR; WAIT_L(0); MMA(0, 1, At, B1); BAR;
    LDA(At, 0, 1); WAIT_V(4); BAR; WAIT_L(0); MMA(1, 0, At, B0); MMA(1, 1, At, B1); BAR;
  }
  {
    LDB(B0, 1, 0); LDA(At, 1, 0); WAIT_V(2); BAR; WAIT_L(0); MMA(0, 0, At, B0); BAR;
    LDB(B1, 1, 1); WAIT_V(0); BAR; WAIT_L(0); MMA(0, 1, At, B1); BAR;
    LDA(At, 1, 1); BAR; WAIT_L(0); MMA(1, 0, At, B0); MMA(1, 1, At, B1); BAR;
  }
  if (wr == 0) BAR;
  epi(acc, brow, bcol, wr, wc, fr, fq, rs);
  __syncthreads();
}


DI bool unit_next(int i, int nM, int nN, int& pm, int& pn) {
  const int nwg = nM * nN;
  const long L = (long)i * ogrid() + obid();
  if (L >= nwg) return false;
  int wgid = (int)L;
  {
    const int q = nwg / 8, r = nwg % 8, xcd = wgid % 8, off = wgid / 8;
    wgid = (xcd < r ? xcd * (q + 1) : r * (q + 1) + (xcd - r) * q) + off;
  }
  const int nig = 8 * nN, gid = wgid / nig, fm = gid * 8, gsz = (nM - fm) < 8 ? (nM - fm) : 8;
  pm = fm + ((wgid % nig) % gsz);
  pn = (wgid % nig) / gsz;
  return true;
}

#define EPI_LOOP                                                   \
  _Pragma("unroll") for (int ai = 0; ai < 2; ++ai)                 \
  _Pragma("unroll") for (int m = 0; m < 4; ++m)                    \
  _Pragma("unroll") for (int bj = 0; bj < 2; ++bj)                 \
  _Pragma("unroll") for (int n = 0; n < 2; ++n)
#define EPI_LOOP8                                                  \
  _Pragma("unroll") for (int ai = 0; ai < 2; ++ai)                 \
  _Pragma("unroll") for (int m = 0; m < 4; ++m)                    \
  _Pragma("unroll") for (int bj = 0; bj < 2; ++bj)
struct EpiProj {
  static constexpr bool PERM = true;
  bf16_t* proj; float* rss;
  DI void operator()(const acc_t& acc, int brow, int bcol, int wr, int wc, int fr, int fq, const float* rs) const {
    EPI_LOOP8 {
      const int row = brow + ai * 128 + wr * 64 + m * 16 + fr, col = bcol + bj * 128 + wc * 32 + 8 * fq;
      if (col < NP) {
        const f32x4 v0 = acc[ai][bj][m][0], v1 = acc[ai][bj][m][1];
        uint4 u; u.x = pack2(v0[0], v0[1]); u.y = pack2(v0[2], v0[3]); u.z = pack2(v1[0], v1[1]); u.w = pack2(v1[2], v1[3]);
        *(uint4*)(proj + (size_t)row * NP + col) = u;
      }
    }
    if (bcol + 256 > C_QA && bcol < C_KR) {
#pragma unroll
      for (int ai = 0; ai < 2; ++ai)
#pragma unroll
        for (int m = 0; m < 4; ++m) {
          float sq = 0.f, sk = 0.f;
#pragma unroll
          for (int bj = 0; bj < 2; ++bj) {
            const int col = bcol + bj * 128 + wc * 32 + 8 * fq;
            const f32x4 v0 = acc[ai][bj][m][0], v1 = acc[ai][bj][m][1];
            const float t = v0[0] * v0[0] + v0[1] * v0[1] + v0[2] * v0[2] + v0[3] * v0[3] +
                            v1[0] * v1[0] + v1[1] * v1[1] + v1[2] * v1[2] + v1[3] * v1[3];
            sq += (col >= C_QA && col < C_KVA) ? t : 0.f;
            sk += (col >= C_KVA && col < C_KR) ? t : 0.f;
          }
          sq += __shfl_xor(sq, 16); sq += __shfl_xor(sq, 32);
          sk += __shfl_xor(sk, 16); sk += __shfl_xor(sk, 32);
          if (fq == 0) {
            const int row = brow + ai * 128 + wr * 64 + m * 16 + fr;
            if (sq != 0.f) unsafeAtomicAdd(rss + row, sq);
            if (sk != 0.f) unsafeAtomicAdd(rss + MT + row, sk);
          }
        }
    }
  }
};
struct EpiRelu2 {
  static constexpr bool PERM = true;
  bf16_t* hid;
  DI void operator()(const acc_t& acc, int brow, int bcol, int wr, int wc, int fr, int fq, const float* rs) const {
    EPI_LOOP8 {
      const int row = brow + ai * 128 + wr * 64 + m * 16 + fr, col = bcol + bj * 128 + wc * 32 + 8 * fq;
      const f32x4 v0 = acc[ai][bj][m][0], v1 = acc[ai][bj][m][1];
      const float a0 = fmaxf(v0[0], 0.f), a1 = fmaxf(v0[1], 0.f), a2 = fmaxf(v0[2], 0.f), a3 = fmaxf(v0[3], 0.f);
      const float a4 = fmaxf(v1[0], 0.f), a5 = fmaxf(v1[1], 0.f), a6 = fmaxf(v1[2], 0.f), a7 = fmaxf(v1[3], 0.f);
      uint4 u; u.x = pack2(a0 * a0, a1 * a1); u.y = pack2(a2 * a2, a3 * a3); u.z = pack2(a4 * a4, a5 * a5); u.w = pack2(a6 * a6, a7 * a7);
      *(uint4*)(hid + (size_t)row * DFF + col) = u;
    }
  }
};
struct EpiRes {
  static constexpr bool PERM = false;
  const Params* p; int layer; int gate_off; bool from_input;
  DI void operator()(const acc_t& acc, int brow, int bcol, int wr, int wc, int fr, int fq, const float* rs) const {
    const int b = brow / TT, tb = brow - b * TT;
    const bool isctx = tb >= LSEQ;
    const float* gp = p->mods() + ((size_t)layer * 17 + (isctx ? 16 : b)) * 6144 + gate_off;
    EPI_LOOP {
      const int lr = ai * 128 + wr * 64 + m * 16 + fr, col = bcol + bj * 128 + wc * 32 + n * 16 + 4 * fq;
      const f32x4 v = acc[ai][bj][m][n];
      const float4 g = *(const float4*)(gp + col);
      float* dst = res_row(*p, b, tb + lr) + col;
      const float4 s = from_input ? *(const float4*)(in_row(*p, b, tb + lr) + col) : *(const float4*)dst;
      float4 o; o.x = s.x + g.x * v[0]; o.y = s.y + g.y * v[1]; o.z = s.z + g.z * v[2]; o.w = s.w + g.w * v[3];
      *(float4*)dst = o;
    }
  }
};
struct EpiQ {
  static constexpr bool PERM = false;
  const Params* p;
  DI void operator()(const acc_t& acc, int brow, int bcol, int wr, int wc, int fr, int fq, const float* rs) const {
    float rq[8];
#pragma unroll
    for (int i = 0; i < 8; ++i) rq[i] = rsqrtf(p->rss()[0 + brow + (i >> 2) * 128 + wr * 64 + (i & 3) * 16 + fr] * (1.f / 256.f) + 1e-6f);
    const int b = brow / TT, tb = brow - b * TT;
    EPI_LOOP {
      const int lr = ai * 128 + wr * 64 + m * 16 + fr, col = bcol + bj * 128 + wc * 32 + n * 16 + 4 * fq;
      if (col < 576) {
        const int hh = col / 96, d = col - hh * 96;
        const f32x4 v = acc[ai][bj][m][n];
        const float sc = rq[ai * 4 + m];
        uint2 u; u.x = pack2(v[0] * sc, v[1] * sc); u.y = pack2(v[2] * sc, v[3] * sc);
        *(uint2*)(p->Q() + ((size_t)(b * 6 + hh) * TT + tb + lr) * 96 + d) = u;
      }
    }
  }
};
struct EpiKV {
  static constexpr bool PERM = false;
  const Params* p;
  DI void operator()(const acc_t& acc, int brow, int bcol, int wr, int wc, int fr, int fq, const float* rs) const {
    float rq[8];
#pragma unroll
    for (int i = 0; i < 8; ++i) rq[i] = rsqrtf(p->rss()[MT + brow + (i >> 2) * 128 + wr * 64 + (i & 3) * 16 + fr] * (1.f / 256.f) + 1e-6f);
    const int b = brow / TT, tb = brow - b * TT;
    EPI_LOOP {
      const int lr = ai * 128 + wr * 64 + m * 16 + fr, col = bcol + bj * 128 + wc * 32 + n * 16 + 4 * fq;
      const int hh = col >> 7, j = col & 127;
      const f32x4 v = acc[ai][bj][m][n];
      const float sc = rq[ai * 4 + m];
      if (j < 64) {
        uint2 u; u.x = pack2(v[0] * sc, v[1] * sc); u.y = pack2(v[2] * sc, v[3] * sc);
        *(uint2*)(p->Kc() + ((size_t)(b * 6 + hh) * TT + tb + lr) * 96 + j) = u;
      } else {
        bf16_t* vp = p->Vt() + ((size_t)(b * 6 + hh) * 64 + (j - 64)) * TT + tb + lr;
        vp[0] = f2bf(v[0] * sc); vp[TT] = f2bf(v[1] * sc); vp[2 * TT] = f2bf(v[2] * sc); vp[3 * TT] = f2bf(v[3] * sc);
      }
    }
  }
};

DI void transpose_tile(const float* __restrict__ W, int N, int k0, int n0, bf16_t* __restrict__ dst, int ldd,
                       int shift_from, int shift_by, const float* rowscale, float gscale, float* tile) {
  const int tid = otid();
  const int lane = tid & 63, wave = tid >> 6;
  float4 v[8];
#pragma unroll
  for (int i = 0; i < 8; ++i) {
    const int k = k0 + wave + 8 * i, n = n0 + lane * 4;
    v[i] = make_float4(0.f, 0.f, 0.f, 0.f);
    if (n < N) {
      v[i] = *(const float4*)(W + (size_t)k * N + n);
      const float sc = (rowscale ? rowscale[k] : 1.f) * gscale;
      v[i].x *= sc; v[i].y *= sc; v[i].z *= sc; v[i].w *= sc;
    }
  }
#pragma unroll
  for (int i = 0; i < 8; ++i) {
    *(float4*)(tile + (wave + 8 * i) * 260 + lane * 4) = v[i];
  }
  __syncthreads();
  {
    const int nn = tid >> 1, kq = (tid & 1) * 32;
    const int n = n0 + nn;
    if (n < N) {
      const int drow = n >= shift_from ? n + shift_by : n;
      bf16_t* dp = dst + (size_t)drow * ldd + k0 + kq;
#pragma unroll
      for (int j = 0; j < 4; ++j) {
        const float* tp = tile + (kq + 8 * j) * 260 + nn;
        uint4 u;
        u.x = pack2(tp[0 * 260], tp[1 * 260]);
        u.y = pack2(tp[2 * 260], tp[3 * 260]);
        u.z = pack2(tp[4 * 260], tp[5 * 260]);
        u.w = pack2(tp[6 * 260], tp[7 * 260]);
        *(uint4*)(dp + 8 * j) = u;
      }
    }
  }
  __syncthreads();
}

DI void transpose_layer(const Params& p, int l, int first, int step, float* tile) {
  const float qscale = 0.10206207261596577f * 1.4426950408889634f;
  for (int v = first; v < 728; v += step) {
    if (v < 144) {
      const int kt = v / 9, nt = v - kt * 9;
      transpose_tile(p.w_in + (size_t)l * 1024 * IN_COLS, IN_COLS, kt * 64, nt * 256, p.wt_in() + (size_t)l * NPW * 1024, 1024, 1292, 52, nullptr, 1.f, tile);
    } else if (v < 192) {
      const int w = v - 144, kt = w >> 2, nt = w & 3;
      transpose_tile(p.w_out + (size_t)l * 1024 * 1024, 1024, kt * 64, nt * 256, p.wt_out() + (size_t)l * 1024 * 1024, 1024, 1 << 30, 0, nullptr, 1.f, tile);
    } else if (v < 448) {
      const int w = v - 192, kt = w >> 4, nt = w & 15;
      transpose_tile(p.w_mlp1 + (size_t)l * 1024 * 4096, 4096, kt * 64, nt * 256, p.wt_m1() + (size_t)l * 4096 * 1024, 1024, 1 << 30, 0, nullptr, 1.f, tile);
    } else if (v < 704) {
      const int w = v - 448, kt = w >> 2, nt = w & 3;
      transpose_tile(p.w_mlp2 + (size_t)l * 4096 * 1024, 1024, kt * 64, nt * 256, p.wt_m2() + (size_t)l * 1024 * 4096, 4096, 1 << 30, 0, nullptr, 1.f, tile);
    } else if (v < 716) {
      const int w = v - 704, kt = w / 3, nt = w - kt * 3;
      transpose_tile(p.w_q_b + (size_t)l * 256 * 576, 576, kt * 64, nt * 256, p.wt_qb() + (size_t)l * NQ * 256, 256, 1 << 30, 0, p.q_a_norm_w + l * 256, qscale, tile);
    } else {
      const int w = v - 716, kt = w / 3, nt = w - kt * 3;
      transpose_tile(p.w_kv_b + (size_t)l * 256 * 768, 768, kt * 64, nt * 256, p.wt_kvb() + (size_t)l * 768 * 256, 256, 1 << 30, 0, p.kv_a_norm_w + l * 256, 1.f, tile);
    }
  }
}

DI void phase_prep(const Params& p, bf16_t* smem) {
  float* tile = (float*)smem;
  const int tid = otid();
  const int gtid = obid() * 512 + tid, gsz = ogrid_op() * 512;
  if (gtid < 16) p.ctr()[gtid] = 0;
  if (gtid < 512) {
    const int pos = gtid >> 3, pair = gtid & 7;
    const float inv = powf(10000.f, -(float)pair / 8.f);
    const float ang = (float)pos * inv;
    p.rope()[gtid * 2] = cosf(ang);
    p.rope()[gtid * 2 + 1] = sinf(ang);
  }
  for (int i = gtid; i < 2 * 212 * 1024; i += gsz) {
    const int l = i / (212 * 1024), rem = i - l * 212 * 1024, rr = rem >> 10, k = rem & 1023;
    const int row = rr < 52 ? 1292 + rr : 2144 + (rr - 52);
    p.wt_in()[((size_t)l * NPW + row) * 1024 + k] = 0;
  }
  for (int i = gtid; i < 2 * 192 * 256; i += gsz) {
    const int l = i / (192 * 256), rem = i - l * 192 * 256;
    p.wt_qb()[(size_t)l * NQ * 256 + 576 * 256 + rem] = 0;
  }
  transpose_layer(p, 0, obid(), ogrid(), tile);
  {
    const int nn = tid & 63, c8 = __builtin_amdgcn_readfirstlane(tid >> 6);
    for (int it = obid(); it < 128; it += ogrid()) {
      const int l = it >> 6, g = (it >> 4) & 3, nblk = it & 15;
      const int n = nblk * 64 + nn;
      const float* wo = p.w_out + (size_t)l * 1024 * 1024 + (size_t)(768 + g * 64) * 1024 + n;
      const float* pw = p.pool_w + ((size_t)l * 4 + g) * 4096 + c8 * 8 * 64;
      const float* ps = p.pool_scale + l * 256 + g * 64;
      float o[8];
#pragma unroll
      for (int e = 0; e < 8; ++e) o[e] = 0.f;
#pragma unroll 8
      for (int d = 0; d < 64; ++d) {
        const float wv = wo[(size_t)d * 1024] * ps[d];
#pragma unroll
        for (int e = 0; e < 8; ++e) o[e] += pw[e * 64 + d] * wv;
      }
      uint4 u;
      u.x = pack2(o[0], o[1]); u.y = pack2(o[2], o[3]); u.z = pack2(o[4], o[5]); u.w = pack2(o[6], o[7]);
      *(uint4*)(p.wt_out() + (size_t)l * 1024 * 1024 + (size_t)n * 1024 + 768 + g * 64 + c8 * 8) = u;
    }
  }
  {
    float* sc = (float*)smem;
    const int lane = tid & 63, wave = tid >> 6;
    bool loaded = false;
    for (int it = ogrid() - 1 - obid(); it < 192; it += ogrid()) {
      const int l = it / 96, cb = it - l * 96;
      if (!loaded) {
        for (int i = tid; i < 17 * 1024; i += 512) {
          const int ci = i >> 10, k = i & 1023;
          const float v = ci < 16 ? p.c[ci * 1024 + k] : p.c_ctx[k];
          sc[i] = silu(v);
        }
        loaded = true;
        __syncthreads();
      }
      float acc[17];
#pragma unroll
      for (int i = 0; i < 17; ++i) acc[i] = 0.f;
      const float* mw = p.mod_w + (size_t)l * 1024 * 6144 + cb * 64 + lane;
      for (int k0 = wave * 128; k0 < wave * 128 + 128; k0 += 16) {
        float wv[16];
#pragma unroll
        for (int j = 0; j < 16; ++j) wv[j] = mw[(size_t)(k0 + j) * 6144];
#pragma unroll
        for (int j = 0; j < 16; ++j)
#pragma unroll
          for (int i = 0; i < 17; ++i) acc[i] += sc[i * 1024 + k0 + j] * wv[j];
      }
      float* sred = (float*)smem + 17 * 1024;
      for (int w = 0; w < 8; ++w) {
        if (wave == w) {
#pragma unroll
          for (int i = 0; i < 17; ++i) {
            if (w == 0) sred[i * 64 + lane] = acc[i];
            else sred[i * 64 + lane] += acc[i];
          }
        }
        __syncthreads();
      }
      for (int i = tid; i < 17 * 64; i += 512) {
        const int ci = i >> 6, cc = i & 63;
        p.mods()[((size_t)l * 17 + ci) * 6144 + cb * 64 + cc] = sred[i] + p.mod_b[l * 6144 + cb * 64 + cc];
      }
      __syncthreads();
    }
  }
}

DI void phase_norm(const Params& p, int layer, int which) {
  const int tid = otid(), lane = tid & 63, wave = tid >> 6;
  if (which == 1) { const int gs_ = ogrid_op() * 512; for (int i = obid() * 512 + tid; i < 2 * MT; i += gs_) p.rss()[i] = 0.f; }
  const float* nwt = (which == 1 ? p.norm1_w : p.norm2_w) + layer * 1024;
  const int chunk = (MT + ogrid() - 1) / ogrid();
  const int r_begin = obid() * chunk, r_end = min(MT, r_begin + chunk);
  float4 fw[4], fs[4];
  int cur_ci = -1;
  for (int r = r_begin + wave; r < r_end; r += 16) {
    const int r2 = r + 8;
    const bool has2 = r2 < r_end;
    const int b = r / TT, t = r - b * TT, b2 = r2 / TT, t2 = r2 - b2 * TT;
    const bool skip1 = t >= LSEQ && layer == 1 && which == 2;
    const bool skip2 = !has2 || (t2 >= LSEQ && layer == 1 && which == 2);
    const float* src1 = (layer == 0 && which == 1) ? in_row(p, b, t) : res_row(p, b, t);
    const float* src2 = (layer == 0 && which == 1) ? in_row(p, has2 ? b2 : b, has2 ? t2 : t) : res_row(p, has2 ? b2 : b, has2 ? t2 : t);
    float4 v1[4], v2[4];
#pragma unroll
    for (int i = 0; i < 4; ++i) {
      v1[i] = *(const float4*)(src1 + i * 256 + lane * 4);
      v2[i] = *(const float4*)(src2 + i * 256 + lane * 4);
    }
#pragma unroll
    for (int half = 0; half < 2; ++half) {
      const bool skip = half ? skip2 : skip1;
      if (skip) continue;
      const int rr = half ? r2 : r, bb = half ? b2 : b, tt = half ? t2 : t;
      const int ci = tt >= LSEQ ? 16 : bb;
      if (ci != cur_ci) {
        cur_ci = ci;
        const float* md = p.mods() + ((size_t)layer * 17 + ci) * 6144 + (which == 1 ? 0 : 3072);
#pragma unroll
        for (int i = 0; i < 4; ++i) {
          const int k = i * 256 + lane * 4;
          const float4 w = *(const float4*)(nwt + k);
          const float4 sc = *(const float4*)(md + 1024 + k);
          fs[i] = *(const float4*)(md + k);
          fw[i] = make_float4(w.x * (1.f + sc.x), w.y * (1.f + sc.y), w.z * (1.f + sc.z), w.w * (1.f + sc.w));
        }
      }
      float ss = 0.f;
#pragma unroll
      for (int i = 0; i < 4; ++i) {
        const float4 v = half ? v2[i] : v1[i];
        ss += v.x * v.x + v.y * v.y + v.z * v.z + v.w * v.w;
      }
      ss = wave_sum(ss);
      const float rstd = rsqrtf(ss * (1.f / 1024.f) + 1e-6f);
#pragma unroll
      for (int i = 0; i < 4; ++i) {
        const float4 v = half ? v2[i] : v1[i];
        uint2 u;
        u.x = pack2(v.x * rstd * fw[i].x + fs[i].x, v.y * rstd * fw[i].y + fs[i].y);
        u.y = pack2(v.z * rstd * fw[i].z + fs[i].z, v.w * rstd * fw[i].w + fs[i].w);
        *(uint2*)(p.xn() + (size_t)rr * DM + i * 256 + lane * 4) = u;
      }
    }
  }
}

DI void phase_final(const Params& p) {
  const int tid = otid(), lane = tid & 63, wave = tid >> 6;
  float4 fw[4];
#pragma unroll
  for (int i = 0; i < 4; ++i) fw[i] = *(const float4*)(p.final_norm_w + i * 256 + lane * 4);
  const int NR = NB * LSEQ;
  for (int r = obid() * 8 + wave; r < NR; r += ogrid() * 16) {
    const int r2 = r + ogrid() * 8;
    const bool has2 = r2 < NR;
    float* row1 = p.out + (size_t)r * DM;
    float* row2 = p.out + (size_t)(has2 ? r2 : r) * DM;
    float4 v1[4], v2[4];
#pragma unroll
    for (int i = 0; i < 4; ++i) {
      v1[i] = *(const float4*)(row1 + i * 256 + lane * 4);
      v2[i] = *(const float4*)(row2 + i * 256 + lane * 4);
    }
#pragma unroll
    for (int half = 0; half < 2; ++half) {
      if (half && !has2) continue;
      float* row = half ? row2 : row1;
      float ss = 0.f;
#pragma unroll
      for (int i = 0; i < 4; ++i) {
        const float4 v = half ? v2[i] : v1[i];
        ss += v.x * v.x + v.y * v.y + v.z * v.z + v.w * v.w;
      }
      ss = wave_sum(ss);
      const float rstd = rsqrtf(ss * (1.f / 1024.f) + 1e-6f);
#pragma unroll
      for (int i = 0; i < 4; ++i) {
        const float4 v = half ? v2[i] : v1[i];
        float4 o;
        o.x = v.x * rstd * fw[i].x; o.y = v.y * rstd * fw[i].y; o.z = v.z * rstd * fw[i].z; o.w = v.w * rstd * fw[i].w;
        *(float4*)(row + i * 256 + lane * 4) = o;
      }
    }
  }
}

DI int map_mtile(int skip_ctx, int i) { return skip_ctx ? (i >> 4) * 17 + (i & 15) : i; }

struct UnitOrder {
  int nM, nN, skip;
  DI bool operator()(int i, int& br, int& bc) const {
    int pm, pn;
    if (!unit_next(i, nM, nN, pm, pn)) return false;
    br = map_mtile(skip, pm) * 256;
    bc = pn * 256;
    return true;
  }
};
DI void phase_gemm_in(const Params& p, int layer, bf16_t* smem) {
  EpiProj epi{p.proj(), p.rss()};
  gemm256<false>(p.xn(), DM, p.wt_in() + (size_t)layer * NPW * 1024, 1024, 1024, smem, epi, UnitOrder{MT / 256, NPW / 256, 0});
}
DI void phase_gemm_qkv(const Params& p, int layer, bf16_t* smem) {
  EpiQ epq{&p};
  EpiKV epk{&p};
  int pm, pn;
  for (int i = 0; unit_next(i, MT / 256, 6, pm, pn); ++i) {
    if (pn < 3) gemm256_unit<false>(p.proj() + C_QA, NP, p.wt_qb() + (size_t)layer * NQ * 256, 256, 256, pm * 256, pn * 256, smem, epq);
    else gemm256_unit<false>(p.proj() + C_KVA, NP, p.wt_kvb() + (size_t)layer * 768 * 256, 256, 256, pm * 256, (pn - 3) * 256, smem, epk);
  }
}
DI void phase_gemm_out(const Params& p, int layer, bf16_t* smem) {
  EpiRes epi{&p, layer, 2048, layer == 0};
  const int skip = layer == 1;
  gemm256<false>(p.xn(), DM, p.wt_out() + (size_t)layer * 1024 * 1024, 1024, 1024, smem, epi, UnitOrder{skip ? NB * 16 : MT / 256, 4, skip});
}
DI void phase_gemm_m1(const Params& p, int layer, bf16_t* smem) {
  EpiRelu2 epi{p.hidden()};
  const int skip = layer == 1;
  gemm256<false>(p.xn(), DM, p.wt_m1() + (size_t)layer * 4096 * 1024, 1024, 1024, smem, epi, UnitOrder{skip ? NB * 16 : MT / 256, 16, skip});
}
DI void phase_gemm_m2(const Params& p, int layer, bf16_t* smem) {
  EpiRes epi{&p, layer, 5120, false};
  const int skip = layer == 1;
  gemm256<false>(p.hidden(), DFF, p.wt_m2() + (size_t)layer * 1024 * 4096, 4096, 4096, smem, epi, UnitOrder{skip ? NB * 16 : MT / 256, 4, skip});
}

DI void phase_tokops(const Params& p, int layer) {
  const int tid = otid();
  const int gtid = obid() * 512 + tid, gsz = ogrid_op() * 512;
  {
    const int nrt = gsz / 112;
    if (gtid < nrt * 112) {
      const int cg8 = (gtid % 112) * 8;
      const float* cw = p.conv_w + (size_t)layer * 4 * 896 + cg8;
      const float* cbp = p.conv_b + layer * 896 + cg8;
      float w[4][8], bias[8];
#pragma unroll
      for (int j = 0; j < 4; ++j)
#pragma unroll
        for (int e = 0; e < 8; ++e) w[j][e] = cw[j * 896 + e];
#pragma unroll
      for (int e = 0; e < 8; ++e) bias[e] = cbp[e];
      for (int run = gtid / 112; run < MT / 8; run += nrt) {
        const int r0 = run * 8;
        const int b = r0 / TT, tb = r0 - b * TT;
        const int seg_lo = tb < LSEQ ? 0 : LSEQ, seg_hi = tb < LSEQ ? LSEQ : TT;
        uint4 raw[11];
#pragma unroll
        for (int i = 0; i < 11; ++i) {
          const int tt = tb - 1 + i;
          if (tt >= seg_lo && tt < seg_hi) raw[i] = *(const uint4*)(p.proj() + ((size_t)b * TT + tt) * NP + C_XBC + cg8);
          else raw[i] = make_uint4(0, 0, 0, 0);
        }
#pragma unroll
        for (int o = 0; o < 8; ++o) {
          float a[8];
#pragma unroll
          for (int e = 0; e < 8; ++e) a[e] = bias[e];
#pragma unroll
          for (int j = 0; j < 4; ++j) {
            const uint4 u = raw[o + j];
            a[0] += w[j][0] * bflo(u.x); a[1] += w[j][1] * bfhi(u.x);
            a[2] += w[j][2] * bflo(u.y); a[3] += w[j][3] * bfhi(u.y);
            a[4] += w[j][4] * bflo(u.z); a[5] += w[j][5] * bfhi(u.z);
            a[6] += w[j][6] * bflo(u.w); a[7] += w[j][7] * bfhi(u.w);
          }
          uint4 ov;
          ov.x = pack2(silu(a[0]), silu(a[1])); ov.y = pack2(silu(a[2]), silu(a[3]));
          ov.z = pack2(silu(a[4]), silu(a[5])); ov.w = pack2(silu(a[6]), silu(a[7]));
          *(uint4*)(p.xbc() + ((size_t)b * TT + tb + o) * 896 + cg8) = ov;
        }
      }
    }
  }
  for (int idx = gtid; idx < MT * 2; idx += gsz) {
    const int r = idx >> 1, axis = idx & 1;
    const int b = r / TT, t = r - b * TT;
    const bf16_t* src = p.proj() + (size_t)r * NP + C_KR + axis * 16;
    const uint4 u1 = *(const uint4*)src, u2 = *(const uint4*)(src + 8);
    uint4 o1 = u1, o2 = u2;
    if (t < LSEQ) {
      const int pos = axis ? (t & 63) : (t >> 6);
      const float4* rp = (const float4*)(p.rope() + pos * 16);
      const float4 c0 = rp[0], c1 = rp[1], c2 = rp[2], c3 = rp[3];
      o1.x = pack2(bflo(u1.x) * c0.x - bflo(u2.x) * c0.y, bfhi(u1.x) * c0.z - bfhi(u2.x) * c0.w);
      o1.y = pack2(bflo(u1.y) * c1.x - bflo(u2.y) * c1.y, bfhi(u1.y) * c1.z - bfhi(u2.y) * c1.w);
      o1.z = pack2(bflo(u1.z) * c2.x - bflo(u2.z) * c2.y, bfhi(u1.z) * c2.z - bfhi(u2.z) * c2.w);
      o1.w = pack2(bflo(u1.w) * c3.x - bflo(u2.w) * c3.y, bfhi(u1.w) * c3.z - bfhi(u2.w) * c3.w);
      o2.x = pack2(bflo(u2.x) * c0.x + bflo(u1.x) * c0.y, bfhi(u2.x) * c0.z + bfhi(u1.x) * c0.w);
      o2.y = pack2(bflo(u2.y) * c1.x + bflo(u1.y) * c1.y, bfhi(u2.y) * c1.z + bfhi(u1.y) * c1.w);
      o2.z = pack2(bflo(u2.z) * c2.x + bflo(u1.z) * c2.y, bfhi(u2.z) * c2.z + bfhi(u1.z) * c2.w);
      o2.w = pack2(bflo(u2.w) * c3.x + bflo(u1.w) * c3.y, bfhi(u2.w) * c3.z + bfhi(u1.w) * c3.w);
    }
#pragma unroll
    for (int hh = 0; hh < 6; ++hh) {
      bf16_t* dst = p.Kc() + ((size_t)(b * 6 + hh) * TT + t) * 96 + 64 + axis * 16;
      *(uint4*)dst = o1;
      *(uint4*)(dst + 8) = o2;
    }
  }
  for (int idx = gtid; idx < (MT / 8) * 32; idx += gsz) {
    const int run = idx >> 5, cgp = idx & 31;
    const int r0 = run * 8;
    const int b = r0 / TT, t0 = r0 - b * TT;
    const int seg_lo = t0 < LSEQ ? 0 : LSEQ, seg_hi = t0 < LSEQ ? LSEQ : TT;
    const int g = cgp >> 3, half = 1 << g;
    const bf16_t* base = p.proj() + (size_t)b * TT * NP + C_POOL + cgp * 8;
    float a[8];
#pragma unroll
    for (int e = 0; e < 8; ++e) a[e] = 0.f;
    for (int tt = max(t0 - half, seg_lo); tt < min(t0 + half, seg_hi); ++tt) {
      const uint4 u = *(const uint4*)(base + (size_t)tt * NP);
      a[0] += bflo(u.x); a[1] += bfhi(u.x); a[2] += bflo(u.y); a[3] += bfhi(u.y);
      a[4] += bflo(u.z); a[5] += bfhi(u.z); a[6] += bflo(u.w); a[7] += bfhi(u.w);
    }
#pragma unroll
    for (int o = 0; o < 8; ++o) {
      const int t = t0 + o;
      const int lo = max(t - half, seg_lo), hi = min(t + half, seg_hi);
      const float inv = 1.f / (float)(hi - lo);
      const uint4 u = *(const uint4*)(base + (size_t)t * NP);
      uint4 ov;
      ov.x = pack2(a[0] * inv - bflo(u.x), a[1] * inv - bfhi(u.x));
      ov.y = pack2(a[2] * inv - bflo(u.y), a[3] * inv - bfhi(u.y));
      ov.z = pack2(a[4] * inv - bflo(u.z), a[5] * inv - bfhi(u.z));
      ov.w = pack2(a[6] * inv - bflo(u.w), a[7] * inv - bfhi(u.w));
      *(uint4*)(p.xn() + ((size_t)b * TT + t) * DM + 768 + cgp * 8) = ov;
      if (o < 7) {
        const int tin = t + half, tout = t - half;
        if (tin < seg_hi) {
          const uint4 w = *(const uint4*)(base + (size_t)tin * NP);
          a[0] += bflo(w.x); a[1] += bfhi(w.x); a[2] += bflo(w.y); a[3] += bfhi(w.y);
          a[4] += bflo(w.z); a[5] += bfhi(w.z); a[6] += bflo(w.w); a[7] += bfhi(w.w);
        }
        if (tout >= seg_lo) {
          const uint4 w = *(const uint4*)(base + (size_t)tout * NP);
          a[0] -= bflo(w.x); a[1] -= bfhi(w.x); a[2] -= bflo(w.y); a[3] -= bfhi(w.y);
          a[4] -= bflo(w.z); a[5] -= bfhi(w.z); a[6] -= bflo(w.w); a[7] -= bfhi(w.w);
        }
      }
    }
  }
}

typedef short s16x4 __attribute__((ext_vector_type(4)));
DI s16x4 tr4(const bf16_t* M, int LD, int krow, int ccol, int lane) {
  const int q = (lane & 15) >> 2, pp = lane & 3, blk = (lane >> 4) & 1;
  return __builtin_amdgcn_ds_read_tr16_b64_v4i16((LAS s16x4*)(LAS bf16_t*)(M + (krow + q) * LD + ccol + 16 * blk + 4 * pp));
}
DI bf16x8 cat8(s16x4 lo, s16x4 hi) { return __builtin_shufflevector(lo, hi, 0, 1, 2, 3, 4, 5, 6, 7); }

DI void ssd_store_x(bf16_t* sX, bf16_t* sXw, int row, int xch, uint4 g, float wl) {
  *(uint4*)(sX + row * 72 + xch) = g;
  uint4 u;
  u.x = pack2(bflo(g.x) * wl, bfhi(g.x) * wl);
  u.y = pack2(bflo(g.y) * wl, bfhi(g.y) * wl);
  u.z = pack2(bflo(g.z) * wl, bfhi(g.z) * wl);
  u.w = pack2(bflo(g.w) * wl, bfhi(g.w) * wl);
  *(uint4*)(sXw + row * 72 + xch) = u;
}
DI void ssd_job(const Params& p, int layer, int jobpair, bf16_t* smem_blk) {
  const int tid_full = otid(), jh = tid_full >> 8, tid = tid_full & 255;
  const int lane = tid & 63, wave = tid >> 6, r = lane & 31, h = lane >> 5;
  const int job = jobpair * 2 + jh;
  bf16_t* smem = smem_blk + jh * SSD_LDS_EL;
  const int b = job / 12, dir = (job / 6) & 1, head = job % 6, grp = head / 3;
  bf16_t* sB = smem;
  bf16_t* sC = sB + 64 * 136;
  bf16_t* sX = sC + 64 * 136;
  bf16_t* sXw = sX + 64 * 72;
  bf16_t* sH = sXw + 64 * 72;
  float* sfl = (float*)(sH + 64 * 136);
  const float a = -__expf(p.a_log[layer * 12 + dir * 6 + head]);
  const float dtb = p.dt_bias[layer * 12 + dir * 6 + head];
  for (int i = tid; i < 64 * 136 / 2; i += 256) ((unsigned*)sH)[i] = 0u;
  f32x16 hacc[2];
  hacc[0] = zero16();
  hacc[1] = zero16();
  const int pt = wave >> 1, lt = wave & 1;
  const int lidx = lt * 32 + r;
  const int brow_ = tid >> 4, bch = (tid & 15) * 8;
  const int xrow_ = tid >> 3, xch = (tid & 7) * 8;
  uint4 gB0, gB1, gB2, gB3, gC0, gC1, gC2, gC3, gX0, gX1;
  float dtraw = 0.f;
#define SSD_LOAD(it_)                                                                                  \
  do {                                                                                                 \
    const int sc_ = dir == 0 ? ((it_) < 4 ? 64 + (it_) : (it_) - 4) : 67 - (it_);                      \
    const bf16_t* base_ = p.xbc() + ((size_t)b * TT + sc_ * 64) * 896;                                 \
    if (wave == 0) {                                                                                   \
      const int tok_ = dir == 0 ? lane : 63 - lane;                                                    \
      dtraw = bf2f(p.proj()[((size_t)b * TT + sc_ * 64 + tok_) * NP + C_DT + dir * 6 + head]);         \
    }                                                                                                  \
    const bf16_t* bp_ = base_ + (size_t)brow_ * 896 + 384 + grp * 128 + bch;                            \
    gB0 = *(const uint4*)(bp_); gB1 = *(const uint4*)(bp_ + 16 * 896);                                  \
    gB2 = *(const uint4*)(bp_ + 32 * 896); gB3 = *(const uint4*)(bp_ + 48 * 896);                       \
    gC0 = *(const uint4*)(bp_ + 256); gC1 = *(const uint4*)(bp_ + 16 * 896 + 256);                      \
    gC2 = *(const uint4*)(bp_ + 32 * 896 + 256); gC3 = *(const uint4*)(bp_ + 48 * 896 + 256);           \
    const bf16_t* xp_ = base_ + (size_t)xrow_ * 896 + head * 64 + xch;                                  \
    gX0 = *(const uint4*)(xp_); gX1 = *(const uint4*)(xp_ + 32 * 896);                                  \
  } while (0)
#define SSD_SCAN(par_)                                                                                 \
  do {                                                                                                 \
    float* fl_ = sfl + (par_) * 200;                                                                   \
    const int tok = dir == 0 ? lane : 63 - lane;                                                       \
    const float xx = dtraw + dtb;                                                                      \
    const float dt = xx > 20.f ? xx : __logf(1.f + __expf(xx));                                        \
    float cs = dt * a;                                                                                 \
    _Pragma("unroll") for (int off = 1; off < 64; off <<= 1) {                                         \
      const float o_ = __shfl_up(cs, off);                                                             \
      if (lane >= off) cs += o_;                                                                       \
    }                                                                                                  \
    const float tot = __shfl(cs, 63);                                                                  \
    fl_[tok] = dt;                                                                                     \
    fl_[64 + tok] = cs;                                                                                \
    fl_[128 + tok] = dt * __expf(tot - cs);                                                            \
    if (lane == 0) fl_[192] = tot;                                                                     \
  } while (0)
  SSD_LOAD(0);
  if (wave == 0) SSD_SCAN(0);
  __syncthreads();
  for (int it = 0; it < 68; ++it) {
    const int sc = dir == 0 ? (it < 4 ? 64 + it : it - 4) : 67 - it;
    const size_t r0 = (size_t)b * TT + sc * 64;
    const float* fl = sfl + (it & 1) * 200;
    const float* sdt = fl;
    const float* scs = fl + 64;
    const float* sw = fl + 128;
    *(uint4*)(sB + (brow_ + 0) * 136 + bch) = gB0;  *(uint4*)(sC + (brow_ + 0) * 136 + bch) = gC0;
    *(uint4*)(sB + (brow_ + 16) * 136 + bch) = gB1; *(uint4*)(sC + (brow_ + 16) * 136 + bch) = gC1;
    *(uint4*)(sB + (brow_ + 32) * 136 + bch) = gB2; *(uint4*)(sC + (brow_ + 32) * 136 + bch) = gC2;
    *(uint4*)(sB + (brow_ + 48) * 136 + bch) = gB3; *(uint4*)(sC + (brow_ + 48) * 136 + bch) = gC3;
    ssd_store_x(sX, sXw, xrow_, xch, gX0, sw[xrow_]);
    ssd_store_x(sX, sXw, xrow_ + 32, xch, gX1, sw[xrow_ + 32]);
    { const int itn = it + 1 < 68 ? it + 1 : 67; SSD_LOAD(itn); }
    __syncthreads();
    bf16x8 creg[8];
#pragma unroll
    for (int ks = 0; ks < 8; ++ks) creg[ks] = *(const bf16x8*)(sC + lidx * 136 + ks * 16 + h * 8);
    f32x16 yacc = zero16();
    const float csl = scs[lidx];
#pragma unroll
    for (int st = 0; st < 2; ++st) {
      const bool skip = dir == 0 ? (st > lt) : (st < lt);
      if (!skip) {
        bf16x8 bf_[8];
#pragma unroll
        for (int ks = 0; ks < 8; ++ks) bf_[ks] = *(const bf16x8*)(sB + (st * 32 + r) * 136 + ks * 16 + h * 8);
        const s16x4 x0 = tr4(sX, 72, st * 32 + 4 * h, pt * 32, lane), x1 = tr4(sX, 72, st * 32 + 8 + 4 * h, pt * 32, lane);
        const s16x4 x2 = tr4(sX, 72, st * 32 + 16 + 4 * h, pt * 32, lane), x3 = tr4(sX, 72, st * 32 + 24 + 4 * h, pt * 32, lane);
        __builtin_amdgcn_sched_barrier(0);
        f32x16 sv = zero16();
#pragma unroll
        for (int ks = 0; ks < 8; ++ks) sv = MFMA(bf_[ks], creg[ks], sv);
#pragma unroll
        for (int g = 0; g < 4; ++g) {
          const float4 c4 = *(const float4*)(scs + st * 32 + 8 * g + 4 * h);
          const float4 d4 = *(const float4*)(sdt + st * 32 + 8 * g + 4 * h);
          const float cc[4] = {c4.x, c4.y, c4.z, c4.w};
          const float dd[4] = {d4.x, d4.y, d4.z, d4.w};
#pragma unroll
          for (int e = 0; e < 4; ++e) {
            const int sidx = st * 32 + 8 * g + 4 * h + e;
            const bool valid = dir == 0 ? (sidx <= lidx) : (sidx >= lidx);
            const float arg = valid ? (csl - cc[e]) : 0.f;
            const float dec = valid ? __expf(arg) * dd[e] : 0.f;
            sv[4 * g + e] *= dec;
          }
        }
        yacc = MFMA(cat8(x0, x1), pack8(sv, 0), yacc);
        yacc = MFMA(cat8(x2, x3), pack8(sv, 1), yacc);
      }
    }
    {
      bf16x8 hf_[8];
#pragma unroll
      for (int ks = 0; ks < 8; ++ks) hf_[ks] = *(const bf16x8*)(sH + (pt * 32 + r) * 136 + ks * 16 + h * 8);
      __builtin_amdgcn_sched_barrier(0);
      f32x16 yo = zero16();
#pragma unroll
      for (int ks = 0; ks < 8; ++ks) yo = MFMA(hf_[ks], creg[ks], yo);
      const float el = __expf(csl);
#pragma unroll
      for (int i = 0; i < 16; ++i) yacc[i] += el * yo[i];
    }
    {
      bf16_t* yout = p.yssd() + ((size_t)dir * MT + r0 + lidx) * 384 + head * 64 + pt * 32 + 4 * h;
#pragma unroll
      for (int g = 0; g < 4; ++g) {
        uint2 u;
        u.x = pack2(yacc[4 * g + 0], yacc[4 * g + 1]);
        u.y = pack2(yacc[4 * g + 2], yacc[4 * g + 3]);
        *(uint2*)(yout + 8 * g) = u;
      }
    }
    {
      const float et = __expf(fl[192]);
#pragma unroll
      for (int q = 0; q < 2; ++q)
#pragma unroll
        for (int i = 0; i < 16; ++i) hacc[q][i] *= et;
#pragma unroll
      for (int half = 0; half < 2; ++half) {
        bf16x8 av_[2], bv_[2][2];
#pragma unroll
        for (int k2 = 0; k2 < 2; ++k2) {
          const int ks = half * 2 + k2;
          av_[k2] = cat8(tr4(sXw, 72, ks * 16 + 8 * h, pt * 32, lane), tr4(sXw, 72, ks * 16 + 8 * h + 4, pt * 32, lane));
#pragma unroll
          for (int q = 0; q < 2; ++q) {
            const int nt = (wave & 1) * 2 + q;
            bv_[q][k2] = cat8(tr4(sB, 136, ks * 16 + 8 * h, nt * 32, lane), tr4(sB, 136, ks * 16 + 8 * h + 4, nt * 32, lane));
          }
        }
        __builtin_amdgcn_sched_barrier(0);
#pragma unroll
        for (int k2 = 0; k2 < 2; ++k2)
#pragma unroll
          for (int q = 0; q < 2; ++q) hacc[q] = MFMA(av_[k2], bv_[q][k2], hacc[q]);
        __builtin_amdgcn_sched_barrier(0);
      }
    }
    if (wave == 0 && it + 1 < 68) SSD_SCAN((it + 1) & 1);
    __syncthreads();
#pragma unroll
    for (int q = 0; q < 2; ++q) {
      const int nt = (wave & 1) * 2 + q;
#pragma unroll
      for (int reg = 0; reg < 16; ++reg) sH[(pt * 32 + crow(reg, h)) * 136 + nt * 32 + r] = f2bf(hacc[q][reg]);
    }
  }
#undef SSD_SCAN
#undef SSD_LOAD
  asm volatile("s_waitcnt vmcnt(0)" ::: "memory");
  __syncthreads();
  if (tid_full == 0) {
    __builtin_amdgcn_fence(__ATOMIC_RELEASE, "agent");
    asm volatile("s_waitcnt vmcnt(0)" ::: "memory");
    xb_add(p.bar() + 3700 + layer * 16 + b, 2u);
  }
  __syncthreads();
}

DI unsigned rope_word(unsigned mine, unsigned other, float4 cs, int h) {
  const float m0 = bflo(mine), m1 = bfhi(mine), o0 = bflo(other), o1 = bfhi(other);
  const float r0 = h ? (m0 * cs.x + o0 * cs.y) : (m0 * cs.x - o0 * cs.y);
  const float r1 = h ? (m1 * cs.z + o1 * cs.w) : (m1 * cs.z - o1 * cs.w);
  return pack2(r0, r1);
}
DI void attn_item(const Params& p, int b, int hh, int q0, int k_begin, int nkt, bf16_t* smem) {
  const int tid = otid(), lane = tid & 63, wave = tid >> 6, r = lane & 31, h = lane >> 5;
  const bf16_t* Kg = p.Kc() + ((size_t)(b * 6 + hh) * TT + k_begin) * 96;
  const bf16_t* Vg = p.Vt() + ((size_t)(b * 6 + hh) * 64) * TT + k_begin;
  const int qrow = q0 + wave * 32 + r;
  bf16x8 qreg[6];
  {
    const bf16_t* qp = p.Q() + ((size_t)(b * 6 + hh) * TT + qrow) * 96 + h * 8;
#pragma unroll
    for (int ks = 0; ks < 6; ++ks) qreg[ks] = *(const bf16x8*)(qp + ks * 16);
  }
  if (q0 < LSEQ) {
#pragma unroll
    for (int ax = 0; ax < 2; ++ax) {
      const int pos = ax ? (qrow & 63) : (qrow >> 6);
      const float* rp = p.rope() + pos * 16;
      const uint4 me = __builtin_bit_cast(uint4, qreg[4 + ax]);
      uint4 rr;
      rr.x = rope_word(me.x, __shfl_xor(me.x, 32), *(const float4*)(rp + 0), h);
      rr.y = rope_word(me.y, __shfl_xor(me.y, 32), *(const float4*)(rp + 4), h);
      rr.z = rope_word(me.z, __shfl_xor(me.z, 32), *(const float4*)(rp + 8), h);
      rr.w = rope_word(me.w, __shfl_xor(me.w, 32), *(const float4*)(rp + 12), h);
      qreg[4 + ax] = __builtin_bit_cast(bf16x8, rr);
    }
  }
  bf16_t* sK = smem;
  bf16_t* sV = smem + 2 * 64 * 104;
  uint4 rk0, rk1 = make_uint4(0u, 0u, 0u, 0u), rv;
  const int vrow = tid >> 3, vch = (tid & 7) * 8;
  const int kc1 = tid + 512;
  const int krow0 = tid / 12, kch0 = tid - krow0 * 12, krow1 = kc1 / 12, kch1 = kc1 - krow1 * 12;
#define K_LOAD(t_)                                                         \
  do {                                                                     \
    const bf16_t* kg_ = Kg + (size_t)(t_) * 64 * 96;                       \
    rk0 = *(const uint4*)(kg_ + (size_t)tid * 8);                          \
    if (tid < 256) rk1 = *(const uint4*)(kg_ + (size_t)kc1 * 8);           \
  } while (0)
#define K_STORE(buf_)                                                                      \
  do {                                                                                     \
    *(uint4*)(sK + ((buf_) * 64 + krow0) * 104 + kch0 * 8) = rk0;                          \
    if (tid < 256) *(uint4*)(sK + ((buf_) * 64 + krow1) * 104 + kch1 * 8) = rk1;           \
  } while (0)
#define V_LOAD(t_) rv = *(const uint4*)(Vg + (size_t)vrow * TT + (t_) * 64 + vch)
#define V_STORE(buf_)                                                                      \
  do {                                                                                     \
    bf16_t* vp_ = sV + ((buf_) * 64 + vrow) * 68 + vch;                                    \
    *(uint2*)vp_ = make_uint2(rv.x, rv.y);                                                 \
    *(uint2*)(vp_ + 4) = make_uint2(rv.z, rv.w);                                           \
  } while (0)
#define S_TILE(dst, buf_)                                                                                      \
  do {                                                                                                         \
    bf16x8 kf_[6];                                                                                             \
    const bf16_t* kb_ = sK + ((buf_) * 64 + r) * 104 + h * 8;                                                  \
    _Pragma("unroll") for (int ks = 0; ks < 6; ++ks) kf_[ks] = *(const bf16x8*)(kb_ + ks * 16);                \
    __builtin_amdgcn_sched_barrier(0);                                                                         \
    dst[0] = zero16();                                                                                         \
    _Pragma("unroll") for (int ks = 0; ks < 6; ++ks) dst[0] = MFMA(kf_[ks], qreg[ks], dst[0]);                 \
    __builtin_amdgcn_sched_barrier(0);                                                                         \
    _Pragma("unroll") for (int ks = 0; ks < 6; ++ks) kf_[ks] = *(const bf16x8*)(kb_ + 32 * 104 + ks * 16);     \
    __builtin_amdgcn_sched_barrier(0);                                                                         \
    dst[1] = zero16();                                                                                         \
    _Pragma("unroll") for (int ks = 0; ks < 6; ++ks) dst[1] = MFMA(kf_[ks], qreg[ks], dst[1]);                 \
    __builtin_amdgcn_sched_barrier(0);                                                                         \
  } while (0)
  K_LOAD(0); V_LOAD(0);
  K_STORE(0); V_STORE(0);
  if (nkt > 1) { K_LOAD(1); K_STORE(1); }
  __syncthreads();
  f32x16 o[2], o2, sc[2], negm;
  o[0] = zero16();
  o[1] = zero16();
  o2 = zero16();
  negm = zero16();
  bf16x8 ones;
  {
    const unsigned w = r == 0 ? 0x3F803F80u : 0u;
    uint4 u; u.x = w; u.y = w; u.z = w; u.w = w;
    ones = __builtin_bit_cast(bf16x8, u);
  }
#define S_CHAIN(dst, buf_)                                                                                 \
  do {                                                                                                     \
    bf16x8 kf_[6];                                                                                         \
    const bf16_t* kb_ = sK + ((buf_) * 64 + r) * 104 + h * 8;                                              \
    _Pragma("unroll") for (int ks = 0; ks < 6; ++ks) kf_[ks] = *(const bf16x8*)(kb_ + ks * 16);            \
    __builtin_amdgcn_sched_barrier(0);                                                                     \
    dst[0] = negm;                                                                                         \
    __builtin_amdgcn_s_setprio(1);                                                                         \
    _Pragma("unroll") for (int ks = 0; ks < 6; ++ks) dst[0] = MFMA(kf_[ks], qreg[ks], dst[0]);             \
    __builtin_amdgcn_s_setprio(0);                                                                         \
    __builtin_amdgcn_sched_barrier(0);                                                                     \
    _Pragma("unroll") for (int ks = 0; ks < 6; ++ks) kf_[ks] = *(const bf16x8*)(kb_ + 32 * 104 + ks * 16); \
    __builtin_amdgcn_sched_barrier(0);                                                                     \
    dst[1] = negm;                                                                                         \
    __builtin_amdgcn_s_setprio(1);                                                                         \
    _Pragma("unroll") for (int ks = 0; ks < 6; ++ks) dst[1] = MFMA(kf_[ks], qreg[ks], dst[1]);             \
    __builtin_amdgcn_s_setprio(0);                                                                         \
    __builtin_amdgcn_sched_barrier(0);                                                                     \
  } while (0)
#define ATT_STEP(sc_, sn_, kt_)                                                                            \
  do {                                                                                                     \
    const int buf = (kt_) & 1;                                                                             \
    if ((kt_) + 2 < nkt) K_LOAD((kt_) + 2);                                                                \
    if ((kt_) + 1 < nkt) { V_LOAD((kt_) + 1); S_CHAIN(sn_, buf ^ 1); }                                     \
    bf16x8 vf_[8];                                                                                         \
    _Pragma("unroll") for (int mt = 0; mt < 2; ++mt)                                                       \
    _Pragma("unroll") for (int s2 = 0; s2 < 2; ++s2)                                                       \
    _Pragma("unroll") for (int dt = 0; dt < 2; ++dt) {                                                     \
      const bf16_t* va = sV + (buf * 64 + dt * 32 + r) * 68 + mt * 32 + 16 * s2 + 4 * h;                   \
      vf_[(mt * 2 + s2) * 2 + dt] = join8(*(const uint2*)va, *(const uint2*)(va + 8));                     \
    }                                                                                                      \
    __builtin_amdgcn_sched_barrier(0);                                                                     \
    float mx = sc_[0][0];                                                                                  \
    _Pragma("unroll") for (int i = 1; i < 16; ++i) mx = fmaxf(mx, sc_[0][i]);                              \
    _Pragma("unroll") for (int i = 0; i < 16; ++i) mx = fmaxf(mx, sc_[1][i]);                              \
    mx = fmaxf(mx, __shfl_xor(mx, 32));                                                                    \
    if ((kt_) == 0 || __builtin_amdgcn_ballot_w64(mx > 8.f) != 0ull) {                                     \
      const float delta = ((kt_) == 0 || mx > 8.f) ? mx : 0.f;                                             \
      const float alpha = (kt_) == 0 ? 0.f : __builtin_amdgcn_exp2f(-delta);                               \
      _Pragma("unroll") for (int i = 0; i < 16; ++i) {                                                     \
        o[0][i] *= alpha; o[1][i] *= alpha; o2[i] *= alpha;                                                \
        sc_[0][i] -= delta; sc_[1][i] -= delta; sn_[0][i] -= delta; sn_[1][i] -= delta; negm[i] -= delta;  \
      }                                                                                                    \
    }                                                                                                      \
    _Pragma("unroll") for (int mt = 0; mt < 2; ++mt)                                                       \
    _Pragma("unroll") for (int i = 0; i < 16; ++i) sc_[mt][i] = __builtin_amdgcn_exp2f(sc_[mt][i]);        \
    __builtin_amdgcn_s_setprio(1);                                                                         \
    _Pragma("unroll") for (int mt = 0; mt < 2; ++mt)                                                       \
    _Pragma("unroll") for (int s2 = 0; s2 < 2; ++s2) {                                                     \
      const bf16x8 pf = pack8(sc_[mt], s2);                                                                \
      o[0] = MFMA(vf_[(mt * 2 + s2) * 2 + 0], pf, o[0]);                                                   \
      o[1] = MFMA(vf_[(mt * 2 + s2) * 2 + 1], pf, o[1]);                                                   \
      o2 = MFMA(ones, pf, o2);                                                                             \
    }                                                                                                      \
    __builtin_amdgcn_s_setprio(0);                                                                         \
    if ((kt_) + 2 < nkt) K_STORE(buf);                                                                     \
    if ((kt_) + 1 < nkt) V_STORE(buf ^ 1);                                                                 \
    __syncthreads();                                                                                       \
  } while (0)
  f32x16 sn[2];
  sn[0] = zero16();
  sn[1] = zero16();
  S_CHAIN(sc, 0);
  __syncthreads();
  for (int kt = 0; kt < nkt; kt += 2) {
    ATT_STEP(sc, sn, kt);
    ATT_STEP(sn, sc, kt + 1);
  }
#undef ATT_STEP
#undef S_CHAIN
  float l = __shfl(o2[0], r);
#undef K_LOAD
#undef K_STORE
#undef V_LOAD
#undef V_STORE
#undef S_TILE
  const float inv = 1.f / l;
  bf16_t* op = p.xn() + ((size_t)b * TT + qrow) * DM + 384 + hh * 64 + 4 * h;
#pragma unroll
  for (int dt = 0; dt < 2; ++dt)
#pragma unroll
    for (int g = 0; g < 4; ++g) {
      uint2 u;
      u.x = pack2(o[dt][4 * g + 0] * inv, o[dt][4 * g + 1] * inv);
      u.y = pack2(o[dt][4 * g + 2] * inv, o[dt][4 * g + 3] * inv);
      *(uint2*)(op + dt * 32 + 8 * g) = u;
    }
}

DI void ssd_out_rows(const Params& p, int layer, int r_begin, int nrows) {
  const int tid = otid(), lane = tid & 63, wave = tid >> 6;
  const int grp = lane >> 5, li = lane & 31;
  const int ch = grp * 192 + li * 6;
  float dsk[6], nw[6];
#pragma unroll
  for (int e = 0; e < 6; ++e) {
    dsk[e] = p.ssd_d[layer * 6 + (ch + e) / 64];
    nw[e] = p.ssd_norm_w[layer * 384 + ch + e];
  }
  for (int r = r_begin + wave; r < r_begin + nrows; r += 8) {
    const int b = r / TT, t = r - b * TT;
    if (t >= LSEQ && layer == 1) continue;
    const unsigned* yf = (const unsigned*)(p.yssd() + (size_t)r * 384 + ch);
    const unsigned* yb = (const unsigned*)(p.yssd() + ((size_t)MT + r) * 384 + ch);
    const unsigned* xs = (const unsigned*)(p.xbc() + (size_t)r * 896 + ch);
    const unsigned* zz = (const unsigned*)(p.proj() + (size_t)r * NP + C_Z + ch);
    float g[6];
    float ss = 0.f;
#pragma unroll
    for (int e2 = 0; e2 < 3; ++e2) {
      const unsigned a = yf[e2], bq = yb[e2], x = xs[e2], z = zz[e2];
      const float y0 = bflo(a) + bflo(bq) + bflo(x) * dsk[2 * e2];
      const float y1 = bfhi(a) + bfhi(bq) + bfhi(x) * dsk[2 * e2 + 1];
      g[2 * e2] = y0 * silu(bflo(z));
      g[2 * e2 + 1] = y1 * silu(bfhi(z));
      ss += g[2 * e2] * g[2 * e2] + g[2 * e2 + 1] * g[2 * e2 + 1];
    }
#pragma unroll
    for (int o = 16; o >= 1; o >>= 1) ss += __shfl_xor(ss, o);
    const float rstd = rsqrtf(ss * (1.f / 192.f) + 1e-6f);
    unsigned* dst = (unsigned*)(p.xn() + (size_t)r * DM + ch);
#pragma unroll
    for (int e2 = 0; e2 < 3; ++e2) dst[e2] = pack2(g[2 * e2] * rstd * nw[2 * e2], g[2 * e2 + 1] * rstd * nw[2 * e2 + 1]);
  }
}

DI void phase_mixers(const Params& p, int layer, bf16_t* smem, int rep) {
  if (EN(13) || ONLY == 3) for (int jp = obid(); jp < 96; jp += ogrid()) ssd_job(p, layer, jp, smem);
  if (ONLY == 13) return;
  if (layer == 0) {
    if (ogrid() > 96) { if (obid() >= 96) transpose_layer(p, 1, obid() - 96, ogrid() - 96, (float*)smem); }
    else transpose_layer(p, 1, obid(), ogrid(), (float*)smem);
  }
  volatile int* sitem = (volatile int*)((char*)smem + MISC_OFF + 1024);
  const int ipg = layer == 0 ? 17 : 16;
  const int nper = 12 * ipg;
  unsigned* qbase = p.bar() + 3616 + (layer + 2 * rep) * 8;
  const int xcc = (int)(xb_xcc_id() & 7u);
  for (int k = 0; k < 8; ++k) {
    const int xq = (xcc + k) & 7;
    while (true) {
      __syncthreads();
      if (threadIdx.x == 0) *sitem = (int)xb_add(qbase + xq, 1u);
      __syncthreads();
      const int idx = *sitem;
      if (idx >= nper) break;
      const int gi = idx / ipg, within = idx - gi * ipg;
      const int g = xq + 8 * gi;
      const int b = g / 6, hh = g - b * 6;
      if (within == 16) attn_item(p, b, hh, LSEQ, LSEQ, 4, smem);
      else attn_item(p, b, hh, within * 256, 0, 68, smem);
    }
  }
  {
    unsigned* done = p.bar() + 3700 + layer * 16;
    unsigned* rowq = p.bar() + 3740 + layer * 16;
    const int nchunk = layer == 0 ? 68 : 64;
    for (int bb = 0; bb < NB; ++bb) {
      __syncthreads();
      if (threadIdx.x == 0) {
        XB_SPIN(xb_ld(done + bb) < 12u, p.bar());
        __builtin_amdgcn_fence(__ATOMIC_ACQUIRE, "agent");
        asm volatile("s_waitcnt vmcnt(0)" ::: "memory");
      }
      __syncthreads();
      while (true) {
        if (threadIdx.x == 0) *sitem = (int)xb_add(rowq + bb, 1u);
        __syncthreads();
        const int c = *sitem;
        __syncthreads();
        if (c >= nchunk) break;
        ssd_out_rows(p, layer, bb * TT + c * 64, 64);
      }
    }
  }
}

struct XcdBarrier { unsigned* bar; unsigned x; volatile LAS unsigned* st; };
DI XcdBarrier xcd_barrier_post(unsigned* bar, volatile LAS unsigned* st) {
  XcdBarrier b; b.bar = bar; b.x = xb_xcc_id(); b.st = st;
  if (threadIdx.x == 0) (void)xb_add(&bar[XB_XCNT(b.x)], 1u);
  return b;
}
DI void xcd_barrier_complete(unsigned* bar, unsigned x, unsigned& nloc, unsigned& nx) {
  const unsigned G = gridDim.x * gridDim.y * gridDim.z;
  unsigned sum, cnt, mine, sp = 0u;
  for (;;) {
    sum = 0u; cnt = 0u; mine = 0u;
#pragma unroll
    for (unsigned j = 0; j < 16; ++j) { const unsigned c = xb_ld(&bar[XB_XCNT(j)]); sum += c; cnt += (c > 0u) ? 1u : 0u; mine = (j == x) ? c : mine; }
    if (sum == G) break;
    __builtin_amdgcn_s_sleep(1);
    if ((++sp & 255u) == 0u) { if (xb_ld(&bar[XB_TMO])) break; if (sp > XB_SPIN_CAP) { atomicAdd(&bar[XB_TMO], 1u); break; } }
  }
  nloc = mine > 0u ? mine : 1u; nx = cnt > 0u ? cnt : 1u;
}
DI void xcd_barrier(const XcdBarrier& b) {
  asm volatile("s_waitcnt vmcnt(0)" ::: "memory");
  __syncthreads();
  if (threadIdx.x == 0) {
    unsigned* bar = b.bar;
    __builtin_amdgcn_s_waitcnt(0);
    unsigned nloc = b.st[0], nx = b.st[1];
    if (nloc == 0u) { xcd_barrier_complete(bar, b.x, nloc, nx); b.st[0] = nloc; b.st[1] = nx; }
    const unsigned old = xb_add(&bar[XB_XSUB(b.x)], 1u);
    const unsigned gen = old / nloc;
    if (old + 1u == (gen + 1u) * nloc) {
      __builtin_amdgcn_fence(__ATOMIC_RELEASE, "agent");
      asm volatile("s_waitcnt vmcnt(0)" ::: "memory");
      const unsigned og = xb_add(&bar[XB_TOP], 1u);
      const unsigned tg = og / nx;
      if (og + 1u == (tg + 1u) * nx) xb_add(&bar[XB_TOPGEN], 1u);
      else XB_SPIN(xb_ld(&bar[XB_TOPGEN]) == tg, bar);
      __builtin_amdgcn_fence(__ATOMIC_ACQUIRE, "agent");
      xb_add(&bar[XB_XGEN(b.x)], 1u);
      asm volatile("s_waitcnt vmcnt(0)" ::: "memory");
    } else {
      XB_SPIN(xb_ld(&bar[XB_XGEN(b.x)]) == gen, bar);
      __builtin_amdgcn_fence(__ATOMIC_ACQUIRE, "agent");
      asm volatile("s_waitcnt vmcnt(0)" ::: "memory");
    }
  }
  __syncthreads();
}

DI void run_phase(const Params& p, int ph, bf16_t* smem, int rep) {
  if (ph == 0) { if (EN(10)) phase_prep(p, smem); return; }
  if (ph == NPHASE - 1) { if (EN(11)) phase_final(p); return; }
  const int layer = (ph - 1) / 9, s = (ph - 1) % 9;
  switch (s) {
    case 0: if (EN(0)) phase_norm(p, layer, 1); break;
    case 1: if (EN(1)) phase_gemm_in(p, layer, smem); break;
    case 2: if (EN(2)) phase_tokops(p, layer); if (EN(12)) phase_gemm_qkv(p, layer, smem); break;
    case 3: if (EN(3) || EN(13) || EN(14)) phase_mixers(p, layer, smem, rep); break;
    case 4: break;
    case 5: if (EN(5)) phase_gemm_out(p, layer, smem); break;
    case 6: if (EN(6)) phase_norm(p, layer, 2); break;
    case 7: if (EN(7)) phase_gemm_m1(p, layer, smem); break;
    default: if (EN(8)) phase_gemm_m2(p, layer, smem); break;
  }
}

__global__ void __launch_bounds__(512, 2) fwd_megakernel(Params p, int ph_begin, int ph_end) {
  __shared__ __attribute__((aligned(16))) unsigned char smem_raw[SMEM_BYTES];
  bf16_t* smem = (bf16_t*)smem_raw;
  cg::grid_group grid = cg::this_grid();
  volatile LAS unsigned* xst = (volatile LAS unsigned*)(LAS unsigned char*)(smem_raw + MISC_OFF + 1024 + 32);
  if (threadIdx.x == 0) { xst[0] = 0u; xst[1] = 0u; }
  __syncthreads();
  const XcdBarrier xb = xcd_barrier_post(p.bar(), xst);
  for (int ph = ph_begin; ph < ph_end; ++ph) {
    if (ph >= 1 && ph < NPHASE - 1 && (ph - 1) % 9 == 4) continue;
    run_phase(p, ph, smem, 0);
#if REPEAT_MASK
    if (ph >= 1 && ph < NPHASE - 1 && ((REPEAT_MASK >> ((ph - 1) % 9)) & 1)) {
      xcd_barrier(xb);
      run_phase(p, ph, smem, 1);
    }
#endif
    if (ph + 1 < ph_end) {
      if (ph == 0) grid.sync();
      else xcd_barrier(xb);
    }
  }
}

extern "C" void kernel_launch(void* const* d_in, const int* in_sizes, int n_in, void* d_out, int out_size, void* d_ws,
                              size_t ws_size, hipStream_t stream) {
  static int grid_blocks = 0;
  if (!grid_blocks) {
    int dev = 0, cus = 0, per_cu = 0;
    hipGetDevice(&dev);
    hipDeviceGetAttribute(&cus, hipDeviceAttributeMultiprocessorCount, dev);
    hipOccupancyMaxActiveBlocksPerMultiprocessor(&per_cu, fwd_megakernel, 512, 0);
    if (per_cu > 1) per_cu = 1;
    if (per_cu < 1) per_cu = 1;
    grid_blocks = cus * per_cu;
  }
  Params p{};
  const float** fp = (const float**)&p;
  for (int i = 0; i < 25; ++i) fp[i] = (const float*)d_in[i];
  p.out = (float*)d_out;
  p.ws = (char*)d_ws;
  if (WS_NEED > ws_size) fprintf(stderr, "workspace too small: need %zu have %zu\n", (size_t)WS_NEED, ws_size);
  hipMemsetAsync((char*)d_ws + O_BAR, 0, 16384, stream);
#if MULTI_LAUNCH
  for (int ph = 0; ph < NPHASE; ++ph)
    hipLaunchKernelGGL(fwd_megakernel, dim3(grid_blocks), dim3(512), 0, stream, p, ph, ph + 1);
#else
  int b0 = 0, b1 = NPHASE;
  void* args[] = {&p, &b0, &b1};
  hipError_t e = hipLaunchCooperativeKernel((void*)fwd_megakernel, dim3(grid_blocks), dim3(512), args, 0, stream);
  if (e != hipSuccess) fprintf(stderr, "cooperative launch failed: %s (grid %d)\n", hipGetErrorString(e), grid_blocks);
#endif
}
```

```cpp
#include <hip/hip_runtime.h>
#include <hip/hip_cooperative_groups.h>
#include <cstdio>
#include <cstdint>
namespace cg = cooperative_groups;

#ifndef MULTI_LAUNCH
#define MULTI_LAUNCH 0
#endif
#ifndef ONLY
#define ONLY -1
#endif
#define EN(k) (ONLY < 0 || ONLY == (k))
#ifndef REPEAT_MASK
#define REPEAT_MASK 0
#endif

#define DI __device__ __forceinline__
typedef unsigned short bf16_t;
using bf16x8 = __attribute__((ext_vector_type(8))) short;
using f32x16 = __attribute__((ext_vector_type(16))) float;
typedef __bf16 bfv2 __attribute__((ext_vector_type(2)));
typedef float f32v2 __attribute__((ext_vector_type(2)));
#define MFMA(a, b, c) __builtin_amdgcn_mfma_f32_32x32x16_bf16((a), (b), (c), 0, 0, 0)

constexpr int NB = 16, LSEQ = 4096, CTXL = 256, TT = 4352;
constexpr int MT = NB * TT;
constexpr int DM = 1024, DFF = 4096;
constexpr int NP = 2176;
constexpr int C_Z = 0, C_XBC = 384, C_DT = 1280, C_QA = 1344, C_KVA = 1600, C_KR = 1856, C_POOL = 1888;
constexpr int IN_COLS = 2092;
constexpr int NPHASE = 20;
constexpr int MISC_OFF = 145408;
constexpr int SMEM_BYTES = MISC_OFF + 1024 + 256;
constexpr int NPW = 2304;
constexpr int NQ = 768;
constexpr int SSD_LDS_EL = 36352;

constexpr size_t al256(size_t x) { return (x + 255) & ~(size_t)255; }
constexpr size_t O_WT_IN = 0;
constexpr size_t O_WT_OUT = O_WT_IN + al256((size_t)2 * NPW * 1024 * 2);
constexpr size_t O_WT_M1 = O_WT_OUT + al256((size_t)2 * 1024 * 1024 * 2);
constexpr size_t O_WT_M2 = O_WT_M1 + al256((size_t)2 * 4096 * 1024 * 2);
constexpr size_t O_WT_QB = O_WT_M2 + al256((size_t)2 * 1024 * 4096 * 2);
constexpr size_t O_WT_KVB = O_WT_QB + al256((size_t)2 * NQ * 256 * 2);
constexpr size_t O_MODS = O_WT_KVB + al256((size_t)2 * 768 * 256 * 2);
constexpr size_t O_ROPE = O_MODS + al256((size_t)2 * 17 * 6144 * 4);
constexpr size_t O_CTR = O_ROPE + al256(64 * 8 * 2 * 4);
constexpr size_t O_BAR = O_CTR + 256;
constexpr size_t O_RSS = O_BAR + 16384;
constexpr size_t O_CTXRES = O_RSS + al256((size_t)2 * MT * 4);
constexpr size_t O_XN = O_CTXRES + al256((size_t)NB * CTXL * DM * 4);
constexpr size_t O_YSSD = O_XN + al256((size_t)MT * DM * 2);
constexpr size_t O_BIG = O_YSSD + al256((size_t)2 * MT * 384 * 2);
constexpr size_t O_PROJ = O_BIG;
constexpr size_t O_XBC = O_PROJ + al256((size_t)MT * NP * 2);
constexpr size_t O_Q = O_XBC + al256((size_t)MT * 896 * 2);
constexpr size_t O_K = O_Q + al256((size_t)NB * 6 * TT * 96 * 2);
constexpr size_t O_VT = O_K + al256((size_t)NB * 6 * TT * 96 * 2);
constexpr size_t O_END1 = O_VT + al256((size_t)NB * 6 * 64 * TT * 2);
constexpr size_t O_END2 = O_BIG + (size_t)MT * DFF * 2;
constexpr size_t WS_NEED = O_END1 > O_END2 ? O_END1 : O_END2;

struct Params {
  const float *x, *c, *ctx, *c_ctx, *mod_w, *mod_b, *norm1_w, *norm2_w, *w_in, *conv_w, *conv_b, *dt_bias, *a_log,
      *ssd_d, *ssd_norm_w, *q_a_norm_w, *w_q_b, *kv_a_norm_w, *w_kv_b, *pool_w, *pool_scale, *w_out, *w_mlp1, *w_mlp2,
      *final_norm_w;
  float* out;
  char* ws;
  DI bf16_t* wt_in() const { return (bf16_t*)(ws + O_WT_IN); }
  DI bf16_t* wt_out() const { return (bf16_t*)(ws + O_WT_OUT); }
  DI bf16_t* wt_m1() const { return (bf16_t*)(ws + O_WT_M1); }
  DI bf16_t* wt_m2() const { return (bf16_t*)(ws + O_WT_M2); }
  DI bf16_t* wt_qb() const { return (bf16_t*)(ws + O_WT_QB); }
  DI bf16_t* wt_kvb() const { return (bf16_t*)(ws + O_WT_KVB); }
  DI float* mods() const { return (float*)(ws + O_MODS); }
  DI float* rope() const { return (float*)(ws + O_ROPE); }
  DI int* ctr() const { return (int*)(ws + O_CTR); }
  DI unsigned* bar() const { return (unsigned*)(ws + O_BAR); }
  DI float* rss() const { return (float*)(ws + O_RSS); }
  DI float* ctxres() const { return (float*)(ws + O_CTXRES); }
  DI bf16_t* xn() const { return (bf16_t*)(ws + O_XN); }
  DI bf16_t* yssd() const { return (bf16_t*)(ws + O_YSSD); }
  DI bf16_t* proj() const { return (bf16_t*)(ws + O_PROJ); }
  DI bf16_t* xbc() const { return (bf16_t*)(ws + O_XBC); }
  DI bf16_t* Q() const { return (bf16_t*)(ws + O_Q); }
  DI bf16_t* Kc() const { return (bf16_t*)(ws + O_K); }
  DI bf16_t* Vt() const { return (bf16_t*)(ws + O_VT); }
  DI bf16_t* hidden() const { return (bf16_t*)(ws + O_BIG); }
};

DI unsigned pack2(float a, float b) {
  f32v2 v = {a, b};
  bfv2 r = __builtin_convertvector(v, bfv2);
  return __builtin_bit_cast(unsigned, r);
}
DI bf16_t f2bf(float a) { return (bf16_t)(pack2(a, 0.f) & 0xffffu); }
DI float bf2f(bf16_t v) { return __uint_as_float(((unsigned)v) << 16); }
DI float bflo(unsigned w) { return __uint_as_float(w << 16); }
DI float bfhi(unsigned w) { return __uint_as_float(w & 0xffff0000u); }
DI float silu(float x) { return x / (1.f + __expf(-x)); }
DI int crow(int reg, int h) { return (reg & 3) + 8 * (reg >> 2) + 4 * h; }
DI float wave_sum(float v) {
#pragma unroll
  for (int o = 32; o >= 1; o >>= 1) v += __shfl_xor(v, o);
  return v;
}
DI bf16x8 pack8(const f32x16& x, int s) {
  uint4 u;
  u.x = pack2(x[8 * s + 0], x[8 * s + 1]);
  u.y = pack2(x[8 * s + 2], x[8 * s + 3]);
  u.z = pack2(x[8 * s + 4], x[8 * s + 5]);
  u.w = pack2(x[8 * s + 6], x[8 * s + 7]);
  return __builtin_bit_cast(bf16x8, u);
}
DI bf16x8 join8(uint2 lo, uint2 hi) {
  uint4 u; u.x = lo.x; u.y = lo.y; u.z = hi.x; u.w = hi.y;
  return __builtin_bit_cast(bf16x8, u);
}
DI int ogrid() { return gridDim.x; }
DI int obid() { return blockIdx.x; }
DI int ogrid_op() { int g = gridDim.x; asm volatile("" : "+s"(g)); return g; }
DI int otid() { int t = threadIdx.x; asm volatile("" : "+v"(t)); return t; }
DI unsigned xb_ld(unsigned* p) { return __hip_atomic_load(p, __ATOMIC_RELAXED, __HIP_MEMORY_SCOPE_AGENT); }
DI unsigned xb_add(unsigned* p, unsigned v) { return __hip_atomic_fetch_add(p, v, __ATOMIC_RELAXED, __HIP_MEMORY_SCOPE_AGENT); }
DI unsigned xb_xcc_id() { return (unsigned)__builtin_amdgcn_s_getreg((3 << 11) | 20) & 0xFu; }
#define XB_TMO      128
#define XB_XCNT(j)  (256  + 64 * (j))
#define XB_XSUB(j)  (1280 + 64 * (j))
#define XB_XGEN(j)  (2304 + 64 * (j))
#define XB_TOP      3328
#define XB_TOPGEN   3392
#define XCD_BAR_WORDS 3456
#define XB_SPIN_CAP (1u << 18)
#define XB_SPIN(cond, bar) do { unsigned _sp = 0; while (cond) { __builtin_amdgcn_s_sleep(1); \
    if ((++_sp & 255u) == 0u) { if (xb_ld(&(bar)[XB_TMO])) break; if (_sp > XB_SPIN_CAP) { atomicAdd(&(bar)[XB_TMO], 1u); break; } } } } while (0)
DI f32x16 zero16() { f32x16 z; for (int i = 0; i < 16; ++i) z[i] = 0.f; return z; }

DI float* res_row(const Params& p, int b, int t) {
  return t < LSEQ ? p.out + ((size_t)b * LSEQ + t) * DM : p.ctxres() + ((size_t)b * CTXL + (t - LSEQ)) * DM;
}
DI const float* in_row(const Params& p, int b, int t) {
  return t < LSEQ ? p.x + ((size_t)b * LSEQ + t) * DM : p.ctx + ((size_t)b * CTXL + (t - LSEQ)) * DM;
}

using f32x4 = __attribute__((ext_vector_type(4))) float;
constexpr int GBK = 64, GHALF = 128, GHT = GHALF * GBK;
#define LAS __attribute__((address_space(3)))
DI int lds_byte(int r, int c) {
  const int st = (r >> 4) * 2 + (c >> 5), rr = r & 15, cc = c & 31, ob = rr * 64 + cc * 2;
  return st * 1024 + (ob ^ (((ob >> 9) & 1) << 5));
}
DI void stage_rc(int b, int& R, int& C) {
  const int st = b / 1024, sb = b % 1024, swz = sb ^ (((sb >> 9) & 1) << 5);
  R = (st >> 1) * 16 + swz / 64;
  C = (st & 1) * 32 + (swz % 64) / 2;
}
typedef f32x4 acc_t[2][2][4][2];
DI int perm32(int rho) { const int n = rho >> 4, i = rho & 15; return 8 * (i >> 2) + 4 * n + (i & 3); }

template <bool RMS, class Epi, class UnitFn>
DI void gemm256(const bf16_t* __restrict__ A, int lda, const bf16_t* __restrict__ Bt, int ldb, int K,
                bf16_t* shm, Epi& epi, UnitFn unit) {
  const int tid = otid();
  const int wid = tid >> 6, lane = tid & 63, wr = wid >> 2, wc = wid & 3, fr = lane & 15, fq = lane >> 4;
  float* rs = (float*)((char*)shm + MISC_OFF);
  const int ldst0 = tid * 16;
  const unsigned swave = (unsigned)__builtin_amdgcn_readfirstlane((int)((unsigned)(size_t)(LAS char*)shm + (unsigned)((tid & ~63) * 16)));
  unsigned la0, la1, lb0, lb1;
  {
    int r0_, c0_, r1_, c1_;
    stage_rc(ldst0, r0_, c0_);
    stage_rc(ldst0 + 8192, r1_, c1_);
    la0 = (unsigned)(r0_ * lda + c0_) * 2u; la1 = (unsigned)(r1_ * lda + c1_) * 2u;
    if (Epi::PERM) { r0_ = (r0_ & ~31) | perm32(r0_ & 31); r1_ = (r1_ & ~31) | perm32(r1_ & 31); }
    lb0 = (unsigned)(r0_ * ldb + c0_) * 2u; lb1 = (unsigned)(r1_ * ldb + c1_) * 2u;
  }
#define SA(b, h) (shm + ((b) * 2 + (h)) * GHT)
#define SB(b, h) (shm + (4 + (b) * 2 + (h)) * GHT)
#define GLDS(voff, sbase, m0v)                                                                           \
  asm volatile("s_mov_b32 m0, %2\n\ts_nop 0\n\tglobal_load_lds_dwordx4 %0, %1" ::"v"(voff), "s"(sbase), "s"(m0v) : "memory", "m0")
#define STAGE(PB, BASE, LD, br, kt, L0, L1)                                                               \
  do {                                                                                                    \
    const char* _ub = (const char*)((BASE) + (long)(br) * (LD) + (long)(kt) * GBK);                       \
    const unsigned _m = swave + (unsigned)(PB);                                                           \
    GLDS(L0, _ub, _m);                                                                                    \
    GLDS(L1, _ub, _m + 8192u);                                                                            \
  } while (0)
#define SAB(b, h) ((((b) * 2 + (h)) * GHT) * 2)
#define SBB(b, h) (((4 + (b) * 2 + (h)) * GHT) * 2)
#define STA(P, br, kt) STAGE(P, A, lda, br, kt, la0, la1)
#define STB(P, br, kt) STAGE(P, Bt, ldb, br, kt, lb0, lb1)
#define LDA(dst, b, h)                                                                                    \
  _Pragma("unroll") for (int m = 0; m < 4; ++m) _Pragma("unroll") for (int k = 0; k < 2; ++k)             \
      dst[m][k] = *reinterpret_cast<const bf16x8*>((const char*)SA(b, h) + lds_byte(wr * 64 + m * 16 + fr, k * 32 + fq * 8))
#define LDB(dst, b, h)                                                                                    \
  _Pragma("unroll") for (int n = 0; n < 2; ++n) _Pragma("unroll") for (int k = 0; k < 2; ++k)             \
      dst[n][k] = *reinterpret_cast<const bf16x8*>((const char*)SB(b, h) + lds_byte(wc * 32 + n * 16 + fr, k * 32 + fq * 8))
#define MMA(ai, bj, At_, Bt_)                                                                             \
  do {                                                                                                    \
    __builtin_amdgcn_s_setprio(1);                                                                        \
    _Pragma("unroll") for (int m = 0; m < 4; ++m) _Pragma("unroll") for (int n = 0; n < 2; ++n)           \
        _Pragma("unroll") for (int k = 0; k < 2; ++k) acc[ai][bj][m][n] =                                 \
            __builtin_amdgcn_mfma_f32_16x16x32_bf16(Bt_[n][k], At_[m][k], acc[ai][bj][m][n], 0, 0, 0);   \
    __builtin_amdgcn_s_setprio(0);                                                                        \
  } while (0)
#define WAIT_V(n) asm volatile("s_waitcnt vmcnt(" #n ")" ::: "memory")
#define WAIT_L(n) asm volatile("s_waitcnt lgkmcnt(" #n ")" ::: "memory")
#define BAR __builtin_amdgcn_s_barrier()
#define SCHED __builtin_amdgcn_sched_barrier(0)
#define PROLOGUE(br_, bc_)                                                                                 \
  do {                                                                                                    \
    STB(SBB(0, 0), (bc_), 0); STA(SAB(0, 0), (br_), 0);                                                   \
    STB(SBB(0, 1), (bc_) + GHALF, 0); STA(SAB(0, 1), (br_) + GHALF, 0);                                   \
    STB(SBB(1, 0), (bc_), 1); STA(SAB(1, 0), (br_), 1); STB(SBB(1, 1), (bc_) + GHALF, 1);                 \
  } while (0)
  int brow = 0, bcol = 0;
  if (!unit(0, brow, bcol)) return;
  if (!RMS) PROLOGUE(brow, bcol);
  for (int ui = 0;; ++ui) {
  int nbrow = 0, nbcol = 0;
  const bool more = unit(ui + 1, nbrow, nbcol);
  if (RMS) {
    const int row = tid >> 1, half = tid & 1;
    const bf16_t* ap = A + (size_t)(brow + row) * lda + half * 128;
    float ss = 0.f;
#pragma unroll 4
    for (int i = 0; i < 16; ++i) {
      uint4 v = *(const uint4*)(ap + i * 8);
      float f;
      f = bflo(v.x); ss += f * f; f = bfhi(v.x); ss += f * f;
      f = bflo(v.y); ss += f * f; f = bfhi(v.y); ss += f * f;
      f = bflo(v.z); ss += f * f; f = bfhi(v.z); ss += f * f;
      f = bflo(v.w); ss += f * f; f = bfhi(v.w); ss += f * f;
    }
    ss += __shfl_xor(ss, 1);
    if (half == 0) rs[row] = rsqrtf(ss * (1.f / 256.f) + 1e-6f);
    WAIT_V(0);
    PROLOGUE(brow, bcol);
  }
  acc_t acc;
#pragma unroll
  for (int i0 = 0; i0 < 2; ++i0)
#pragma unroll
    for (int i1 = 0; i1 < 2; ++i1)
#pragma unroll
      for (int i2 = 0; i2 < 4; ++i2)
#pragma unroll
        for (int i3 = 0; i3 < 2; ++i3) acc[i0][i1][i2][i3] = (f32x4){0.f, 0.f, 0.f, 0.f};
  bf16x8 At[4][2], B0[2][2], B1[2][2];
  const int nt = K / GBK;
  if (wr == 1) BAR;
  WAIT_V(10); BAR;
  WAIT_V(6); BAR;
  for (int t = 0; t < nt - 2; t += 2) {
    LDB(B0, 0, 0); SCHED; LDA(At, 0, 0); STA(SAB(1, 1), brow + GHALF, t + 1);
    WAIT_L(8); BAR; WAIT_L(0); MMA(0, 0, At, B0); BAR; SCHED;
    LDB(B1, 0, 1); STB(SBB(0, 0), bcol, t + 2);
    BAR; WAIT_L(0); MMA(0, 1, At, B1); BAR;
    LDA(At, 0, 1); STA(SAB(0, 0), brow, t + 2);
    BAR; WAIT_L(0); MMA(1, 0, At, B0); BAR; SCHED;
    STB(SBB(0, 1), bcol + GHALF, t + 2);
    WAIT_V(6); BAR; MMA(1, 1, At, B1); BAR;
    LDB(B0, 1, 0); SCHED; LDA(At, 1, 0); STA(SAB(0, 1), brow + GHALF, t + 2);
    WAIT_L(8); BAR; WAIT_L(0); MMA(0, 0, At, B0); BAR; SCHED;
    LDB(B1, 1, 1); STB(SBB(1, 0), bcol, t + 3);
    BAR; WAIT_L(0); MMA(0, 1, At, B1); BAR;
    LDA(At, 1, 1); STA(SAB(1, 0), brow, t + 3);
    BAR; WAIT_L(0); MMA(1, 0, At, B0); BAR; SCHED;
    STB(SBB(1, 1), bcol + GHALF, t + 3);
    WAIT_V(6); BAR; MMA(1, 1, At, B1); BAR;
  }
  {
    LDB(B0, 0, 0); LDA(At, 0, 0); STA(SAB(1, 1), brow + GHALF, nt - 1);
    BAR; WAIT_L(0); MMA(0, 0, At, B0); BAR;
    LDB(B1, 0, 1); BAR; WAIT_L(0); MMA(0, 1, At, B1); BAR;
    LDA(At, 0, 1); WAIT_V(4); BAR; WAIT_L(0); MMA(1, 0, At, B0); MMA(1, 1, At, B1); BAR;
  }
  {
    LDB(B0, 1, 0); LDA(At, 1, 0); WAIT_V(2); BAR; WAIT_L(0); MMA(0, 0, At, B0); BAR;
    LDB(B1, 1, 1); WAIT_V(0); BAR; WAIT_L(0); MMA(0, 1, At, B1); BAR;
    LDA(At, 1, 1); BAR; WAIT_L(0); MMA(1, 0, At, B0); MMA(1, 1, At, B1); BAR;
  }
  if (wr == 0) BAR;
  if (!RMS && more) { PROLOGUE(nbrow, nbcol); }
  epi(acc, brow, bcol, wr, wc, fr, fq, rs);
  if (RMS) __syncthreads();
  if (!more) break;
  brow = nbrow; bcol = nbcol;
  }
}

template <bool RMS, class Epi>
DI void gemm256_unit(const bf16_t* __restrict__ A, int lda, const bf16_t* __restrict__ Bt, int ldb, int K, int brow, int bcol,
                bf16_t* shm, Epi& epi) {
  const int tid = otid();
  const int wid = tid >> 6, lane = tid & 63, wr = wid >> 2, wc = wid & 3, fr = lane & 15, fq = lane >> 4;
  float* rs = (float*)((char*)shm + MISC_OFF);
  const int ldst0 = tid * 16;
  const unsigned swave = (unsigned)__builtin_amdgcn_readfirstlane((int)((unsigned)(size_t)(LAS char*)shm + (unsigned)((tid & ~63) * 16)));
  unsigned la0, la1, lb0, lb1;
  {
    int r0_, c0_, r1_, c1_;
    stage_rc(ldst0, r0_, c0_);
    stage_rc(ldst0 + 8192, r1_, c1_);
    la0 = (unsigned)(r0_ * lda + c0_) * 2u; la1 = (unsigned)(r1_ * lda + c1_) * 2u;
    if (Epi::PERM) { r0_ = (r0_ & ~31) | perm32(r0_ & 31); r1_ = (r1_ & ~31) | perm32(r1_ & 31); }
    lb0 = (unsigned)(r0_ * ldb + c0_) * 2u; lb1 = (unsigned)(r1_ * ldb + c1_) * 2u;
  }
  if (RMS) {
    const int row = tid >> 1, half = tid & 1;
    const bf16_t* ap = A + (size_t)(brow + row) * lda + half * 128;
    float ss = 0.f;
#pragma unroll 4
    for (int i = 0; i < 16; ++i) {
      uint4 v = *(const uint4*)(ap + i * 8);
      float f;
      f = bflo(v.x); ss += f * f; f = bfhi(v.x); ss += f * f;
      f = bflo(v.y); ss += f * f; f = bfhi(v.y); ss += f * f;
      f = bflo(v.z); ss += f * f; f = bfhi(v.z); ss += f * f;
      f = bflo(v.w); ss += f * f; f = bfhi(v.w); ss += f * f;
    }
    ss += __shfl_xor(ss, 1);
    if (half == 0) rs[row] = rsqrtf(ss * (1.f / 256.f) + 1e-6f);
    WAIT_V(0);
  }
  acc_t acc;
#pragma unroll
  for (int i0 = 0; i0 < 2; ++i0)
#pragma unroll
    for (int i1 = 0; i1 < 2; ++i1)
#pragma unroll
      for (int i2 = 0; i2 < 4; ++i2)
#pragma unroll
        for (int i3 = 0; i3 < 2; ++i3) acc[i0][i1][i2][i3] = (f32x4){0.f, 0.f, 0.f, 0.f};
  bf16x8 At[4][2], B0[2][2], B1[2][2];
  const int nt = K / GBK;
  STB(SBB(0, 0), bcol, 0); STA(SAB(0, 0), brow, 0);
  STB(SBB(0, 1), bcol + GHALF, 0); STA(SAB(0, 1), brow + GHALF, 0);
  if (wr == 1) BAR;
  WAIT_V(4); BAR;
  STB(SBB(1, 0), bcol, 1); STA(SAB(1, 0), brow, 1); STB(SBB(1, 1), bcol + GHALF, 1);
  WAIT_V(6); BAR;
  for (int t = 0; t < nt - 2; t += 2) {
    LDB(B0, 0, 0); SCHED; LDA(At, 0, 0); STA(SAB(1, 1), brow + GHALF, t + 1);
    WAIT_L(8); BAR; WAIT_L(0); MMA(0, 0, At, B0); BAR; SCHED;
    LDB(B1, 0, 1); STB(SBB(0, 0), bcol, t + 2);
    BAR; WAIT_L(0); MMA(0, 1, At, B1); BAR;
    LDA(At, 0, 1); STA(SAB(0, 0), brow, t + 2);
    BAR; WAIT_L(0); MMA(1, 0, At, B0); BAR; SCHED;
    STB(SBB(0, 1), bcol + GHALF, t + 2);
    WAIT_V(6); BAR; MMA(1, 1, At, B1); BAR;
    LDB(B0, 1, 0); SCHED; LDA(At, 1, 0); STA(SAB(0, 1), brow + GHALF, t + 2);
    WAIT_L(8); BAR; WAIT_L(0); MMA(0, 0, At, B0); BAR; SCHED;
    LDB(B1, 1, 1); STB(SBB(1, 0), bcol, t + 3);
    BAR; WAIT_L(0); MMA(0, 1, At, B1); BAR;
    LDA(At, 1, 1); STA(SAB(1, 0), brow, t + 3);
    BAR; WAIT_L(0); MMA(1, 0, At, B0); BAR; SCHED;
    STB(SBB(1, 1), bcol + GHALF, t + 3);
    WAIT_V(6); BAR; MMA(1, 1, At, B1); BAR;
  }
  {
    LDB(B0, 0, 0); LDA(At, 0, 0); STA(SAB(1, 1), brow + GHALF, nt - 1);
    BAR; WAIT_L(0); MMA(0, 0, At, B0); BAR;
    LDB(B1, 0, 1); BAR; WAIT_L(0); MMA(0, 1, At, B1); BAR;
    LDA(At, 0, 1); WAIT_V(4); BAR; WAIT_L(0); MMA(1, 0, At, B0); MMA(1, 1, At, B1); BAR;
  }
  {
    LDB(B0, 1, 0); LDA(At, 1, 0); WAIT_V(2); BAR; WAIT_L(0); MMA(0, 0, At, B0); BAR;
    LDB(B1, 1, 1); WAIT_V(0); BAR; WAIT_L(0); MMA(0, 1, At, B1); BAR;
    LDA(At, 1, 1); BAR; WAIT_L(0); MMA(1, 0, At, B0); MMA(1, 1, At, B1); BAR;
  }
  if (wr == 0) BAR;
  epi(acc, brow, bcol, wr, wc, fr, fq, rs);
  __syncthreads();
}


DI bool unit_next(int i, int nM, int nN, int& pm, int& pn) {
  const int nwg = nM * nN;
  const long L = (long)i * ogrid() + obid();
  if (L >= nwg) return false;
  int wgid = (int)L;
  {
    const int q = nwg / 8, r = nwg % 8, xcd = wgid % 8, off = wgid / 8;
    wgid = (xcd < r ? xcd * (q + 1) : r * (q + 1) + (xcd - r) * q) + off;
  }
  const int nig = 8 * nN, gid = wgid / nig, fm = gid * 8, gsz = (nM - fm) < 8 ? (nM - fm) : 8;
  pm = fm + ((wgid % nig) % gsz);
  pn = (wgid % nig) / gsz;
  return true;
}

#define EPI_LOOP                                                   \
  _Pragma("unroll") for (int ai = 0; ai < 2; ++ai)                 \
  _Pragma("unroll") for (int m = 0; m < 4; ++m)                    \
  _Pragma("unroll") for (int bj = 0; bj < 2; ++bj)                 \
  _Pragma("unroll") for (int n = 0; n < 2; ++n)
#define EPI_LOOP8                                                  \
  _Pragma("unroll") for (int ai = 0; ai < 2; ++ai)                 \
  _Pragma("unroll") for (int m = 0; m < 4; ++m)                    \
  _Pragma("unroll") for (int bj = 0; bj < 2; ++bj)
struct EpiProj {
  static constexpr bool PERM = true;
  bf16_t* proj; float* rss;
  DI void operator()(const acc_t& acc, int brow, int bcol, int wr, int wc, int fr, int fq, const float* rs) const {
    EPI_LOOP8 {
      const int row = brow + ai * 128 + wr * 64 + m * 16 + fr, col = bcol + bj * 128 + wc * 32 + 8 * fq;
      if (col < NP) {
        const f32x4 v0 = acc[ai][bj][m][0], v1 = acc[ai][bj][m][1];
        uint4 u; u.x = pack2(v0[0], v0[1]); u.y = pack2(v0[2], v0[3]); u.z = pack2(v1[0], v1[1]); u.w = pack2(v1[2], v1[3]);
        *(uint4*)(proj + (size_t)row * NP + col) = u;
      }
    }
    if (bcol + 256 > C_QA && bcol < C_KR) {
#pragma unroll
      for (int ai = 0; ai < 2; ++ai)
#pragma unroll
        for (int m = 0; m < 4; ++m) {
          float sq = 0.f, sk = 0.f;
#pragma unroll
          for (int bj = 0; bj < 2; ++bj) {
            const int col = bcol + bj * 128 + wc * 32 + 8 * fq;
            const f32x4 v0 = acc[ai][bj][m][0], v1 = acc[ai][bj][m][1];
            const float t = v0[0] * v0[0] + v0[1] * v0[1] + v0[2] * v0[2] + v0[3] * v0[3] +
                            v1[0] * v1[0] + v1[1] * v1[1] + v1[2] * v1[2] + v1[3] * v1[3];
            sq += (col >= C_QA && col < C_KVA) ? t : 0.f;
            sk += (col >= C_KVA && col < C_KR) ? t : 0.f;
          }
          sq += __shfl_xor(sq, 16); sq += __shfl_xor(sq, 32);
          sk += __shfl_xor(sk, 16); sk += __shfl_xor(sk, 32);
          if (fq == 0) {
            const int row = brow + ai * 128 + wr * 64 + m * 16 + fr;
            if (sq != 0.f) unsafeAtomicAdd(rss + row, sq);
            if (sk != 0.f) unsafeAtomicAdd(rss + MT + row, sk);
          }
        }
    }
  }
};
struct EpiRelu2 {
  static constexpr bool PERM = true;
  bf16_t* hid;
  DI void operator()(const acc_t& acc, int brow, int bcol, int wr, int wc, int fr, int fq, const float* rs) const {
    EPI_LOOP8 {
      const int row = brow + ai * 128 + wr * 64 + m * 16 + fr, col = bcol + bj * 128 + wc * 32 + 8 * fq;
      const f32x4 v0 = acc[ai][bj][m][0], v1 = acc[ai][bj][m][1];
      const float a0 = fmaxf(v0[0], 0.f), a1 = fmaxf(v0[1], 0.f), a2 = fmaxf(v0[2], 0.f), a3 = fmaxf(v0[3], 0.f);
      const float a4 = fmaxf(v1[0], 0.f), a5 = fmaxf(v1[1], 0.f), a6 = fmaxf(v1[2], 0.f), a7 = fmaxf(v1[3], 0.f);
      uint4 u; u.x = pack2(a0 * a0, a1 * a1); u.y = pack2(a2 * a2, a3 * a3); u.z = pack2(a4 * a4, a5 * a5); u.w = pack2(a6 * a6, a7 * a7);
      *(uint4*)(hid + (size_t)row * DFF + col) = u;
    }
  }
};
struct EpiRes {
  static constexpr bool PERM = true;
  const Params* p; int layer; int gate_off; bool from_input;
  DI void operator()(const acc_t& acc, int brow, int bcol, int wr, int wc, int fr, int fq, const float* rs) const {
    const int b = brow / TT, tb = brow - b * TT;
    const bool isctx = tb >= LSEQ;
    const float* gp = p->mods() + ((size_t)layer * 17 + (isctx ? 16 : b)) * 6144 + gate_off;
    EPI_LOOP {
      const int lr = ai * 128 + wr * 64 + m * 16 + fr, col = bcol + bj * 128 + wc * 32 + 8 * fq + 4 * n;
      const f32x4 v = acc[ai][bj][m][n];
      const float4 g = *(const float4*)(gp + col);
      float* dst = res_row(*p, b, tb + lr) + col;
      const float4 s = from_input ? *(const float4*)(in_row(*p, b, tb + lr) + col) : *(const float4*)dst;
      float4 o; o.x = s.x + g.x * v[0]; o.y = s.y + g.y * v[1]; o.z = s.z + g.z * v[2]; o.w = s.w + g.w * v[3];
      *(float4*)dst = o;
    }
  }
};
struct EpiQ {
  static constexpr bool PERM = true;
  const Params* p;
  DI void operator()(const acc_t& acc, int brow, int bcol, int wr, int wc, int fr, int fq, const float* rs) const {
    float rq[8];
#pragma unroll
    for (int i = 0; i < 8; ++i) rq[i] = rsqrtf(p->rss()[0 + brow + (i >> 2) * 128 + wr * 64 + (i & 3) * 16 + fr] * (1.f / 256.f) + 1e-6f);
    const int b = brow / TT, tb = brow - b * TT;
    EPI_LOOP8 {
      const int lr = ai * 128 + wr * 64 + m * 16 + fr, col = bcol + bj * 128 + wc * 32 + 8 * fq;
      if (col < 576) {
        const int hh = col / 96, d = col - hh * 96;
        const f32x4 v0 = acc[ai][bj][m][0], v1 = acc[ai][bj][m][1];
        const float sc = rq[ai * 4 + m];
        uint4 u; u.x = pack2(v0[0] * sc, v0[1] * sc); u.y = pack2(v0[2] * sc, v0[3] * sc); u.z = pack2(v1[0] * sc, v1[1] * sc); u.w = pack2(v1[2] * sc, v1[3] * sc);
        *(uint4*)(p->Q() + ((size_t)(b * 6 + hh) * TT + tb + lr) * 96 + d) = u;
      }
    }
  }
};
struct EpiKV {
  static constexpr bool PERM = true;
  const Params* p;
  DI void operator()(const acc_t& acc, int brow, int bcol, int wr, int wc, int fr, int fq, const float* rs) const {
    float rq[8];
#pragma unroll
    for (int i = 0; i < 8; ++i) rq[i] = rsqrtf(p->rss()[MT + brow + (i >> 2) * 128 + wr * 64 + (i & 3) * 16 + fr] * (1.f / 256.f) + 1e-6f);
    const int b = brow / TT, tb = brow - b * TT;
    EPI_LOOP8 {
      const int lr = ai * 128 + wr * 64 + m * 16 + fr, col = bcol + bj * 128 + wc * 32 + 8 * fq;
      const int hh = col >> 7, j = col & 127;
      const f32x4 v0 = acc[ai][bj][m][0], v1 = acc[ai][bj][m][1];
      const float sc = rq[ai * 4 + m];
      if (j < 64) {
        uint4 u; u.x = pack2(v0[0] * sc, v0[1] * sc); u.y = pack2(v0[2] * sc, v0[3] * sc); u.z = pack2(v1[0] * sc, v1[1] * sc); u.w = pack2(v1[2] * sc, v1[3] * sc);
        *(uint4*)(p->Kc() + ((size_t)(b * 6 + hh) * TT + tb + lr) * 96 + j) = u;
      } else {
        bf16_t* vp = p->Vt() + ((size_t)(b * 6 + hh) * 64 + (j - 64)) * TT + tb + lr;
        vp[0] = f2bf(v0[0] * sc); vp[TT] = f2bf(v0[1] * sc); vp[2 * TT] = f2bf(v0[2] * sc); vp[3 * TT] = f2bf(v0[3] * sc);
        vp[4 * TT] = f2bf(v1[0] * sc); vp[5 * TT] = f2bf(v1[1] * sc); vp[6 * TT] = f2bf(v1[2] * sc); vp[7 * TT] = f2bf(v1[3] * sc);
      }
    }
  }
};

DI void transpose_tile(const float* __restrict__ W, int N, int k0, int n0, bf16_t* __restrict__ dst, int ldd,
                       int shift_from, int shift_by, const float* rowscale, float gscale, float* tile) {
  const int tid = otid();
  const int lane = tid & 63, wave = tid >> 6;
  float4 v[8];
#pragma unroll
  for (int i = 0; i < 8; ++i) {
    const int k = k0 + wave + 8 * i, n = n0 + lane * 4;
    v[i] = make_float4(0.f, 0.f, 0.f, 0.f);
    if (n < N) {
      v[i] = *(const float4*)(W + (size_t)k * N + n);
      const float sc = (rowscale ? rowscale[k] : 1.f) * gscale;
      v[i].x *= sc; v[i].y *= sc; v[i].z *= sc; v[i].w *= sc;
    }
  }
#pragma unroll
  for (int i = 0; i < 8; ++i) {
    *(float4*)(tile + (wave + 8 * i) * 260 + lane * 4) = v[i];
  }
  __syncthreads();
  {
    const int nn = tid >> 1, kq = (tid & 1) * 32;
    const int n = n0 + nn;
    if (n < N) {
      const int drow = n >= shift_from ? n + shift_by : n;
      bf16_t* dp = dst + (size_t)drow * ldd + k0 + kq;
#pragma unroll
      for (int j = 0; j < 4; ++j) {
        const float* tp = tile + (kq + 8 * j) * 260 + nn;
        uint4 u;
        u.x = pack2(tp[0 * 260], tp[1 * 260]);
        u.y = pack2(tp[2 * 260], tp[3 * 260]);
        u.z = pack2(tp[4 * 260], tp[5 * 260]);
        u.w = pack2(tp[6 * 260], tp[7 * 260]);
        *(uint4*)(dp + 8 * j) = u;
      }
    }
  }
  __syncthreads();
}

DI void transpose_layer(const Params& p, int l, int first, int step, float* tile) {
  const float qscale = 0.10206207261596577f * 1.4426950408889634f;
  for (int v = first; v < 728; v += step) {
    if (v < 144) {
      const int kt = v / 9, nt = v - kt * 9;
      transpose_tile(p.w_in + (size_t)l * 1024 * IN_COLS, IN_COLS, kt * 64, nt * 256, p.wt_in() + (size_t)l * NPW * 1024, 1024, 1292, 52, nullptr, 1.f, tile);
    } else if (v < 192) {
      const int w = v - 144, kt = w >> 2, nt = w & 3;
      transpose_tile(p.w_out + (size_t)l * 1024 * 1024, 1024, kt * 64, nt * 256, p.wt_out() + (size_t)l * 1024 * 1024, 1024, 1 << 30, 0, nullptr, 1.f, tile);
    } else if (v < 448) {
      const int w = v - 192, kt = w >> 4, nt = w & 15;
      transpose_tile(p.w_mlp1 + (size_t)l * 1024 * 4096, 4096, kt * 64, nt * 256, p.wt_m1() + (size_t)l * 4096 * 1024, 1024, 1 << 30, 0, nullptr, 1.f, tile);
    } else if (v < 704) {
      const int w = v - 448, kt = w >> 2, nt = w & 3;
      transpose_tile(p.w_mlp2 + (size_t)l * 4096 * 1024, 1024, kt * 64, nt * 256, p.wt_m2() + (size_t)l * 1024 * 4096, 4096, 1 << 30, 0, nullptr, 1.f, tile);
    } else if (v < 716) {
      const int w = v - 704, kt = w / 3, nt = w - kt * 3;
      transpose_tile(p.w_q_b + (size_t)l * 256 * 576, 576, kt * 64, nt * 256, p.wt_qb() + (size_t)l * NQ * 256, 256, 1 << 30, 0, p.q_a_norm_w + l * 256, qscale, tile);
    } else {
      const int w = v - 716, kt = w / 3, nt = w - kt * 3;
      transpose_tile(p.w_kv_b + (size_t)l * 256 * 768, 768, kt * 64, nt * 256, p.wt_kvb() + (size_t)l * 768 * 256, 256, 1 << 30, 0, p.kv_a_norm_w + l * 256, 1.f, tile);
    }
  }
}

DI void phase_prep(const Params& p, bf16_t* smem) {
  float* tile = (float*)smem;
  const int tid = otid();
  const int gtid = obid() * 512 + tid, gsz = ogrid_op() * 512;
  if (gtid < 16) p.ctr()[gtid] = 0;
  if (gtid < 512) {
    const int pos = gtid >> 3, pair = gtid & 7;
    const float inv = powf(10000.f, -(float)pair / 8.f);
    const float ang = (float)pos * inv;
    p.rope()[gtid * 2] = cosf(ang);
    p.rope()[gtid * 2 + 1] = sinf(ang);
  }
  for (int i = gtid; i < 2 * 212 * 1024; i += gsz) {
    const int l = i / (212 * 1024), rem = i - l * 212 * 1024, rr = rem >> 10, k = rem & 1023;
    const int row = rr < 52 ? 1292 + rr : 2144 + (rr - 52);
    p.wt_in()[((size_t)l * NPW + row) * 1024 + k] = 0;
  }
  for (int i = gtid; i < 2 * 192 * 256; i += gsz) {
    const int l = i / (192 * 256), rem = i - l * 192 * 256;
    p.wt_qb()[(size_t)l * NQ * 256 + 576 * 256 + rem] = 0;
  }
  transpose_layer(p, 0, obid(), ogrid(), tile);
  {
    const int nn = tid & 63, c8 = __builtin_amdgcn_readfirstlane(tid >> 6);
    for (int it = obid(); it < 128; it += ogrid()) {
      const int l = it >> 6, g = (it >> 4) & 3, nblk = it & 15;
      const int n = nblk * 64 + nn;
      const float* wo = p.w_out + (size_t)l * 1024 * 1024 + (size_t)(768 + g * 64) * 1024 + n;
      const float* pw = p.pool_w + ((size_t)l * 4 + g) * 4096 + c8 * 8 * 64;
      const float* ps = p.pool_scale + l * 256 + g * 64;
      float o[8];
#pragma unroll
      for (int e = 0; e < 8; ++e) o[e] = 0.f;
#pragma unroll 8
      for (int d = 0; d < 64; ++d) {
        const float wv = wo[(size_t)d * 1024] * ps[d];
#pragma unroll
        for (int e = 0; e < 8; ++e) o[e] += pw[e * 64 + d] * wv;
      }
      uint4 u;
      u.x = pack2(o[0], o[1]); u.y = pack2(o[2], o[3]); u.z = pack2(o[4], o[5]); u.w = pack2(o[6], o[7]);
      *(uint4*)(p.wt_out() + (size_t)l * 1024 * 1024 + (size_t)n * 1024 + 768 + g * 64 + c8 * 8) = u;
    }
  }
  {
    float* sc = (float*)smem;
    const int lane = tid & 63, wave = tid >> 6;
    bool loaded = false;
    for (int it = ogrid() - 1 - obid(); it < 192; it += ogrid()) {
      const int l = it / 96, cb = it - l * 96;
      if (!loaded) {
        for (int i = tid; i < 17 * 1024; i += 512) {
          const int ci = i >> 10, k = i & 1023;
          const float v = ci < 16 ? p.c[ci * 1024 + k] : p.c_ctx[k];
          sc[i] = silu(v);
        }
        loaded = true;
        __syncthreads();
      }
      float acc[17];
#pragma unroll
      for (int i = 0; i < 17; ++i) acc[i] = 0.f;
      const float* mw = p.mod_w + (size_t)l * 1024 * 6144 + cb * 64 + lane;
      for (int k0 = wave * 128; k0 < wave * 128 + 128; k0 += 16) {
        float wv[16];
#pragma unroll
        for (int j = 0; j < 16; ++j) wv[j] = mw[(size_t)(k0 + j) * 6144];
#pragma unroll
        for (int j = 0; j < 16; ++j)
#pragma unroll
          for (int i = 0; i < 17; ++i) acc[i] += sc[i * 1024 + k0 + j] * wv[j];
      }
      float* sred = (float*)smem + 17 * 1024;
      for (int w = 0; w < 8; ++w) {
        if (wave == w) {
#pragma unroll
          for (int i = 0; i < 17; ++i) {
            if (w == 0) sred[i * 64 + lane] = acc[i];
            else sred[i * 64 + lane] += acc[i];
          }
        }
        __syncthreads();
      }
      for (int i = tid; i < 17 * 64; i += 512) {
        const int ci = i >> 6, cc = i & 63;
        p.mods()[((size_t)l * 17 + ci) * 6144 + cb * 64 + cc] = sred[i] + p.mod_b[l * 6144 + cb * 64 + cc];
      }
      __syncthreads();
    }
  }
}

DI void phase_norm(const Params& p, int layer, int which) {
  const int tid = otid(), lane = tid & 63, wave = tid >> 6;
  if (which == 1) { const int gs_ = ogrid_op() * 512; for (int i = obid() * 512 + tid; i < 2 * MT; i += gs_) p.rss()[i] = 0.f; }
  const float* nwt = (which == 1 ? p.norm1_w : p.norm2_w) + layer * 1024;
  const int chunk = (MT + ogrid() - 1) / ogrid();
  const int r_begin = obid() * chunk, r_end = min(MT, r_begin + chunk);
  float4 fw[4], fs[4];
  int cur_ci = -1;
  for (int r = r_begin + wave; r < r_end; r += 16) {
    const int r2 = r + 8;
    const bool has2 = r2 < r_end;
    const int b = r / TT, t = r - b * TT, b2 = r2 / TT, t2 = r2 - b2 * TT;
    const bool skip1 = t >= LSEQ && layer == 1 && which == 2;
    const bool skip2 = !has2 || (t2 >= LSEQ && layer == 1 && which == 2);
    const float* src1 = (layer == 0 && which == 1) ? in_row(p, b, t) : res_row(p, b, t);
    const float* src2 = (layer == 0 && which == 1) ? in_row(p, has2 ? b2 : b, has2 ? t2 : t) : res_row(p, has2 ? b2 : b, has2 ? t2 : t);
    float4 v1[4], v2[4];
#pragma unroll
    for (int i = 0; i < 4; ++i) {
      v1[i] = *(const float4*)(src1 + i * 256 + lane * 4);
      v2[i] = *(const float4*)(src2 + i * 256 + lane * 4);
    }
#pragma unroll
    for (int half = 0; half < 2; ++half) {
      const bool skip = half ? skip2 : skip1;
      if (skip) continue;
      const int rr = half ? r2 : r, bb = half ? b2 : b, tt = half ? t2 : t;
      const int ci = tt >= LSEQ ? 16 : bb;
      if (ci != cur_ci) {
        cur_ci = ci;
        const float* md = p.mods() + ((size_t)layer * 17 + ci) * 6144 + (which == 1 ? 0 : 3072);
#pragma unroll
        for (int i = 0; i < 4; ++i) {
          const int k = i * 256 + lane * 4;
          const float4 w = *(const float4*)(nwt + k);
          const float4 sc = *(const float4*)(md + 1024 + k);
          fs[i] = *(const float4*)(md + k);
          fw[i] = make_float4(w.x * (1.f + sc.x), w.y * (1.f + sc.y), w.z * (1.f + sc.z), w.w * (1.f + sc.w));
        }
      }
      float ss = 0.f;
#pragma unroll
      for (int i = 0; i < 4; ++i) {
        const float4 v = half ? v2[i] : v1[i];
        ss += v.x * v.x + v.y * v.y + v.z * v.z + v.w * v.w;
      }
      ss = wave_sum(ss);
      const float rstd = rsqrtf(ss * (1.f / 1024.f) + 1e-6f);
#pragma unroll
      for (int i = 0; i < 4; ++i) {
        const float4 v = half ? v2[i] : v1[i];
        uint2 u;
        u.x = pack2(v.x * rstd * fw[i].x + fs[i].x, v.y * rstd * fw[i].y + fs[i].y);
        u.y = pack2(v.z * rstd * fw[i].z + fs[i].z, v.w * rstd * fw[i].w + fs[i].w);
        *(uint2*)(p.xn() + (size_t)rr * DM + i * 256 + lane * 4) = u;
      }
    }
  }
}

DI void phase_final(const Params& p) {
  const int tid = otid(), lane = tid & 63, wave = tid >> 6;
  float4 fw[4];
#pragma unroll
  for (int i = 0; i < 4; ++i) fw[i] = *(const float4*)(p.final_norm_w + i * 256 + lane * 4);
  const int NR = NB * LSEQ;
  for (int r = obid() * 8 + wave; r < NR; r += ogrid() * 16) {
    const int r2 = r + ogrid() * 8;
    const bool has2 = r2 < NR;
    float* row1 = p.out + (size_t)r * DM;
    float* row2 = p.out + (size_t)(has2 ? r2 : r) * DM;
    float4 v1[4], v2[4];
#pragma unroll
    for (int i = 0; i < 4; ++i) {
      v1[i] = *(const float4*)(row1 + i * 256 + lane * 4);
      v2[i] = *(const float4*)(row2 + i * 256 + lane * 4);
    }
#pragma unroll
    for (int half = 0; half < 2; ++half) {
      if (half && !has2) continue;
      float* row = half ? row2 : row1;
      float ss = 0.f;
#pragma unroll
      for (int i = 0; i < 4; ++i) {
        const float4 v = half ? v2[i] : v1[i];
        ss += v.x * v.x + v.y * v.y + v.z * v.z + v.w * v.w;
      }
      ss = wave_sum(ss);
      const float rstd = rsqrtf(ss * (1.f / 1024.f) + 1e-6f);
#pragma unroll
      for (int i = 0; i < 4; ++i) {
        const float4 v = half ? v2[i] : v1[i];
        float4 o;
        o.x = v.x * rstd * fw[i].x; o.y = v.y * rstd * fw[i].y; o.z = v.z * rstd * fw[i].z; o.w = v.w * rstd * fw[i].w;
        *(float4*)(row + i * 256 + lane * 4) = o;
      }
    }
  }
}

DI int map_mtile(int skip_ctx, int i) { return skip_ctx ? (i >> 4) * 17 + (i & 15) : i; }

struct UnitOrder {
  int nM, nN, skip;
  DI bool operator()(int i, int& br, int& bc) const {
    int pm, pn;
    if (!unit_next(i, nM, nN, pm, pn)) return false;
    br = map_mtile(skip, pm) * 256;
    bc = pn * 256;
    return true;
  }
};
DI void phase_gemm_in(const Params& p, int layer, bf16_t* smem) {
  EpiProj epi{p.proj(), p.rss()};
  gemm256<false>(p.xn(), DM, p.wt_in() + (size_t)layer * NPW * 1024, 1024, 1024, smem, epi, UnitOrder{MT / 256, NPW / 256, 0});
}
DI void phase_gemm_qkv(const Params& p, int layer, bf16_t* smem) {
  EpiQ epq{&p};
  EpiKV epk{&p};
  int pm, pn;
  for (int i = 0; unit_next(i, MT / 256, 6, pm, pn); ++i) {
    if (pn < 3) gemm256_unit<false>(p.proj() + C_QA, NP, p.wt_qb() + (size_t)layer * NQ * 256, 256, 256, pm * 256, pn * 256, smem, epq);
    else gemm256_unit<false>(p.proj() + C_KVA, NP, p.wt_kvb() + (size_t)layer * 768 * 256, 256, 256, pm * 256, (pn - 3) * 256, smem, epk);
  }
}
DI void phase_gemm_out(const Params& p, int layer, bf16_t* smem) {
  EpiRes epi{&p, layer, 2048, layer == 0};
  const int skip = layer == 1;
  gemm256<false>(p.xn(), DM, p.wt_out() + (size_t)layer * 1024 * 1024, 1024, 1024, smem, epi, UnitOrder{skip ? NB * 16 : MT / 256, 4, skip});
}
DI void phase_gemm_m1(const Params& p, int layer, bf16_t* smem) {
  EpiRelu2 epi{p.hidden()};
  const int skip = layer == 1;
  gemm256<false>(p.xn(), DM, p.wt_m1() + (size_t)layer * 4096 * 1024, 1024, 1024, smem, epi, UnitOrder{skip ? NB * 16 : MT / 256, 16, skip});
}
DI void phase_gemm_m2(const Params& p, int layer, bf16_t* smem) {
  EpiRes epi{&p, layer, 5120, false};
  const int skip = layer == 1;
  gemm256<false>(p.hidden(), DFF, p.wt_m2() + (size_t)layer * 1024 * 4096, 4096, 4096, smem, epi, UnitOrder{skip ? NB * 16 : MT / 256, 4, skip});
}

DI void phase_tokops(const Params& p, int layer) {
  const int tid = otid();
  const int gtid = obid() * 512 + tid, gsz = ogrid_op() * 512;
  {
    const int nrt = gsz / 112;
    if (gtid < nrt * 112) {
      const int cg8 = (gtid % 112) * 8;
      const float* cw = p.conv_w + (size_t)layer * 4 * 896 + cg8;
      const float* cbp = p.conv_b + layer * 896 + cg8;
      float w[4][8], bias[8];
#pragma unroll
      for (int j = 0; j < 4; ++j)
#pragma unroll
        for (int e = 0; e < 8; ++e) w[j][e] = cw[j * 896 + e];
#pragma unroll
      for (int e = 0; e < 8; ++e) bias[e] = cbp[e];
      for (int run = gtid / 112; run < MT / 8; run += nrt) {
        const int r0 = run * 8;
        const int b = r0 / TT, tb = r0 - b * TT;
        const int seg_lo = tb < LSEQ ? 0 : LSEQ, seg_hi = tb < LSEQ ? LSEQ : TT;
        uint4 raw[11];
#pragma unroll
        for (int i = 0; i < 11; ++i) {
          const int tt = tb - 1 + i;
          if (tt >= seg_lo && tt < seg_hi) raw[i] = *(const uint4*)(p.proj() + ((size_t)b * TT + tt) * NP + C_XBC + cg8);
          else raw[i] = make_uint4(0, 0, 0, 0);
        }
#pragma unroll
        for (int o = 0; o < 8; ++o) {
          float a[8];
#pragma unroll
          for (int e = 0; e < 8; ++e) a[e] = bias[e];
#pragma unroll
          for (int j = 0; j < 4; ++j) {
            const uint4 u = raw[o + j];
            a[0] += w[j][0] * bflo(u.x); a[1] += w[j][1] * bfhi(u.x);
            a[2] += w[j][2] * bflo(u.y); a[3] += w[j][3] * bfhi(u.y);
            a[4] += w[j][4] * bflo(u.z); a[5] += w[j][5] * bfhi(u.z);
            a[6] += w[j][6] * bflo(u.w); a[7] += w[j][7] * bfhi(u.w);
          }
          uint4 ov;
          ov.x = pack2(silu(a[0]), silu(a[1])); ov.y = pack2(silu(a[2]), silu(a[3]));
          ov.z = pack2(silu(a[4]), silu(a[5])); ov.w = pack2(silu(a[6]), silu(a[7]));
          *(uint4*)(p.xbc() + ((size_t)b * TT + tb + o) * 896 + cg8) = ov;
        }
      }
    }
  }
  for (int idx = gtid; idx < MT * 2; idx += gsz) {
    const int r = idx >> 1, axis = idx & 1;
    const int b = r / TT, t = r - b * TT;
    const bf16_t* src = p.proj() + (size_t)r * NP + C_KR + axis * 16;
    const uint4 u1 = *(const uint4*)src, u2 = *(const uint4*)(src + 8);
    uint4 o1 = u1, o2 = u2;
    if (t < LSEQ) {
      const int pos = axis ? (t & 63) : (t >> 6);
      const float4* rp = (const float4*)(p.rope() + pos * 16);
      const float4 c0 = rp[0], c1 = rp[1], c2 = rp[2], c3 = rp[3];
      o1.x = pack2(bflo(u1.x) * c0.x - bflo(u2.x) * c0.y, bfhi(u1.x) * c0.z - bfhi(u2.x) * c0.w);
      o1.y = pack2(bflo(u1.y) * c1.x - bflo(u2.y) * c1.y, bfhi(u1.y) * c1.z - bfhi(u2.y) * c1.w);
      o1.z = pack2(bflo(u1.z) * c2.x - bflo(u2.z) * c2.y, bfhi(u1.z) * c2.z - bfhi(u2.z) * c2.w);
      o1.w = pack2(bflo(u1.w) * c3.x - bflo(u2.w) * c3.y, bfhi(u1.w) * c3.z - bfhi(u2.w) * c3.w);
      o2.x = pack2(bflo(u2.x) * c0.x + bflo(u1.x) * c0.y, bfhi(u2.x) * c0.z + bfhi(u1.x) * c0.w);
      o2.y = pack2(bflo(u2.y) * c1.x + bflo(u1.y) * c1.y, bfhi(u2.y) * c1.z + bfhi(u1.y) * c1.w);
      o2.z = pack2(bflo(u2.z) * c2.x + bflo(u1.z) * c2.y, bfhi(u2.z) * c2.z + bfhi(u1.z) * c2.w);
      o2.w = pack2(bflo(u2.w) * c3.x + bflo(u1.w) * c3.y, bfhi(u2.w) * c3.z + bfhi(u1.w) * c3.w);
    }
#pragma unroll
    for (int hh = 0; hh < 6; ++hh) {
      bf16_t* dst = p.Kc() + ((size_t)(b * 6 + hh) * TT + t) * 96 + 64 + axis * 16;
      *(uint4*)dst = o1;
      *(uint4*)(dst + 8) = o2;
    }
  }
  for (int idx = gtid; idx < (MT / 8) * 32; idx += gsz) {
    const int run = idx >> 5, cgp = idx & 31;
    const int r0 = run * 8;
    const int b = r0 / TT, t0 = r0 - b * TT;
    const int seg_lo = t0 < LSEQ ? 0 : LSEQ, seg_hi = t0 < LSEQ ? LSEQ : TT;
    const int g = cgp >> 3, half = 1 << g;
    const bf16_t* base = p.proj() + (size_t)b * TT * NP + C_POOL + cgp * 8;
    float a[8];
#pragma unroll
    for (int e = 0; e < 8; ++e) a[e] = 0.f;
    for (int tt = max(t0 - half, seg_lo); tt < min(t0 + half, seg_hi); ++tt) {
      const uint4 u = *(const uint4*)(base + (size_t)tt * NP);
      a[0] += bflo(u.x); a[1] += bfhi(u.x); a[2] += bflo(u.y); a[3] += bfhi(u.y);
      a[4] += bflo(u.z); a[5] += bfhi(u.z); a[6] += bflo(u.w); a[7] += bfhi(u.w);
    }
#pragma unroll
    for (int o = 0; o < 8; ++o) {
      const int t = t0 + o;
      const int lo = max(t - half, seg_lo), hi = min(t + half, seg_hi);
      const float inv = 1.f / (float)(hi - lo);
      const uint4 u = *(const uint4*)(base + (size_t)t * NP);
      uint4 ov;
      ov.x = pack2(a[0] * inv - bflo(u.x), a[1] * inv - bfhi(u.x));
      ov.y = pack2(a[2] * inv - bflo(u.y), a[3] * inv - bfhi(u.y));
      ov.z = pack2(a[4] * inv - bflo(u.z), a[5] * inv - bfhi(u.z));
      ov.w = pack2(a[6] * inv - bflo(u.w), a[7] * inv - bfhi(u.w));
      *(uint4*)(p.xn() + ((size_t)b * TT + t) * DM + 768 + cgp * 8) = ov;
      if (o < 7) {
        const int tin = t + half, tout = t - half;
        if (tin < seg_hi) {
          const uint4 w = *(const uint4*)(base + (size_t)tin * NP);
          a[0] += bflo(w.x); a[1] += bfhi(w.x); a[2] += bflo(w.y); a[3] += bfhi(w.y);
          a[4] += bflo(w.z); a[5] += bfhi(w.z); a[6] += bflo(w.w); a[7] += bfhi(w.w);
        }
        if (tout >= seg_lo) {
          const uint4 w = *(const uint4*)(base + (size_t)tout * NP);
          a[0] -= bflo(w.x); a[1] -= bfhi(w.x); a[2] -= bflo(w.y); a[3] -= bfhi(w.y);
          a[4] -= bflo(w.z); a[5] -= bfhi(w.z); a[6] -= bflo(w.w); a[7] -= bfhi(w.w);
        }
      }
    }
  }
}

typedef short s16x4 __attribute__((ext_vector_type(4)));
DI s16x4 tr4(const bf16_t* M, int LD, int krow, int ccol, int lane) {
  const int q = (lane & 15) >> 2, pp = lane & 3, blk = (lane >> 4) & 1;
  return __builtin_amdgcn_ds_read_tr16_b64_v4i16((LAS s16x4*)(LAS bf16_t*)(M + (krow + q) * LD + ccol + 16 * blk + 4 * pp));
}
DI bf16x8 cat8(s16x4 lo, s16x4 hi) { return __builtin_shufflevector(lo, hi, 0, 1, 2, 3, 4, 5, 6, 7); }

DI void ssd_store_x(bf16_t* sX, bf16_t* sXw, int row, int xch, uint4 g, float wl) {
  *(uint4*)(sX + row * 72 + xch) = g;
  uint4 u;
  u.x = pack2(bflo(g.x) * wl, bfhi(g.x) * wl);
  u.y = pack2(bflo(g.y) * wl, bfhi(g.y) * wl);
  u.z = pack2(bflo(g.z) * wl, bfhi(g.z) * wl);
  u.w = pack2(bflo(g.w) * wl, bfhi(g.w) * wl);
  *(uint4*)(sXw + row * 72 + xch) = u;
}
DI void ssd_job(const Params& p, int layer, int jobpair, bf16_t* smem_blk) {
  const int tid_full = otid(), jh = tid_full >> 8, tid = tid_full & 255;
  const int lane = tid & 63, wave = tid >> 6, r = lane & 31, h = lane >> 5;
  const int job = jobpair * 2 + jh;
  bf16_t* smem = smem_blk + jh * SSD_LDS_EL;
  const int b = job / 12, dir = (job / 6) & 1, head = job % 6, grp = head / 3;
  bf16_t* sB = smem;
  bf16_t* sC = sB + 64 * 136;
  bf16_t* sX = sC + 64 * 136;
  bf16_t* sXw = sX + 64 * 72;
  bf16_t* sH = sXw + 64 * 72;
  float* sfl = (float*)(sH + 64 * 136);
  const float a = -__expf(p.a_log[layer * 12 + dir * 6 + head]);
  const float dtb = p.dt_bias[layer * 12 + dir * 6 + head];
  for (int i = tid; i < 64 * 136 / 2; i += 256) ((unsigned*)sH)[i] = 0u;
  f32x16 hacc[2];
  hacc[0] = zero16();
  hacc[1] = zero16();
  const int pt = wave >> 1, lt = wave & 1;
  const int lidx = lt * 32 + r;
  const int brow_ = tid >> 4, bch = (tid & 15) * 8;
  const int xrow_ = tid >> 3, xch = (tid & 7) * 8;
  uint4 gB0, gB1, gB2, gB3, gC0, gC1, gC2, gC3, gX0, gX1;
  float dtraw = 0.f;
#define SSD_LOAD(it_)                                                                                  \
  do {                                                                                                 \
    const int sc_ = dir == 0 ? ((it_) < 4 ? 64 + (it_) : (it_) - 4) : 67 - (it_);                      \
    const bf16_t* base_ = p.xbc() + ((size_t)b * TT + sc_ * 64) * 896;                                 \
    if (wave == 0) {                                                                                   \
      const int tok_ = dir == 0 ? lane : 63 - lane;                                                    \
      dtraw = bf2f(p.proj()[((size_t)b * TT + sc_ * 64 + tok_) * NP + C_DT + dir * 6 + head]);         \
    }                                                                                                  \
    const bf16_t* bp_ = base_ + (size_t)brow_ * 896 + 384 + grp * 128 + bch;                            \
    gB0 = *(const uint4*)(bp_); gB1 = *(const uint4*)(bp_ + 16 * 896);                                  \
    gB2 = *(const uint4*)(bp_ + 32 * 896); gB3 = *(const uint4*)(bp_ + 48 * 896);                       \
    gC0 = *(const uint4*)(bp_ + 256); gC1 = *(const uint4*)(bp_ + 16 * 896 + 256);                      \
    gC2 = *(const uint4*)(bp_ + 32 * 896 + 256); gC3 = *(const uint4*)(bp_ + 48 * 896 + 256);           \
    const bf16_t* xp_ = base_ + (size_t)xrow_ * 896 + head * 64 + xch;                                  \
    gX0 = *(const uint4*)(xp_); gX1 = *(const uint4*)(xp_ + 32 * 896);                                  \
  } while (0)
#define SSD_SCAN(par_)                                                                                 \
  do {                                                                                                 \
    float* fl_ = sfl + (par_) * 200;                                                                   \
    const int tok = dir == 0 ? lane : 63 - lane;                                                       \
    const float xx = dtraw + dtb;                                                                      \
    const float dt = xx > 20.f ? xx : __logf(1.f + __expf(xx));                                        \
    float cs = dt * a;                                                                                 \
    _Pragma("unroll") for (int off = 1; off < 64; off <<= 1) {                                         \
      const float o_ = __shfl_up(cs, off);                                                             \
      if (lane >= off) cs += o_;                                                                       \
    }                                                                                                  \
    const float tot = __shfl(cs, 63);                                                                  \
    fl_[tok] = dt;                                                                                     \
    fl_[64 + tok] = cs;                                                                                \
    fl_[128 + tok] = dt * __expf(tot - cs);                                                            \
    if (lane == 0) fl_[192] = tot;                                                                     \
  } while (0)
  SSD_LOAD(0);
  if (wave == 0) SSD_SCAN(0);
  __syncthreads();
  for (int it = 0; it < 68; ++it) {
    const int sc = dir == 0 ? (it < 4 ? 64 + it : it - 4) : 67 - it;
    const size_t r0 = (size_t)b * TT + sc * 64;
    const float* fl = sfl + (it & 1) * 200;
    const float* sdt = fl;
    const float* scs = fl + 64;
    const float* sw = fl + 128;
    *(uint4*)(sB + (brow_ + 0) * 136 + bch) = gB0;  *(uint4*)(sC + (brow_ + 0) * 136 + bch) = gC0;
    *(uint4*)(sB + (brow_ + 16) * 136 + bch) = gB1; *(uint4*)(sC + (brow_ + 16) * 136 + bch) = gC1;
    *(uint4*)(sB + (brow_ + 32) * 136 + bch) = gB2; *(uint4*)(sC + (brow_ + 32) * 136 + bch) = gC2;
    *(uint4*)(sB + (brow_ + 48) * 136 + bch) = gB3; *(uint4*)(sC + (brow_ + 48) * 136 + bch) = gC3;
    ssd_store_x(sX, sXw, xrow_, xch, gX0, sw[xrow_]);
    ssd_store_x(sX, sXw, xrow_ + 32, xch, gX1, sw[xrow_ + 32]);
    { const int itn = it + 1 < 68 ? it + 1 : 67; SSD_LOAD(itn); }
    __syncthreads();
    bf16x8 creg[8];
#pragma unroll
    for (int ks = 0; ks < 8; ++ks) creg[ks] = *(const bf16x8*)(sC + lidx * 136 + ks * 16 + h * 8);
    f32x16 yacc = zero16();
    const float csl = scs[lidx];
#pragma unroll
    for (int st = 0; st < 2; ++st) {
      const bool skip = dir == 0 ? (st > lt) : (st < lt);
      if (!skip) {
        bf16x8 bf_[8];
#pragma unroll
        for (int ks = 0; ks < 8; ++ks) bf_[ks] = *(const bf16x8*)(sB + (st * 32 + r) * 136 + ks * 16 + h * 8);
        const s16x4 x0 = tr4(sX, 72, st * 32 + 4 * h, pt * 32, lane), x1 = tr4(sX, 72, st * 32 + 8 + 4 * h, pt * 32, lane);
        const s16x4 x2 = tr4(sX, 72, st * 32 + 16 + 4 * h, pt * 32, lane), x3 = tr4(sX, 72, st * 32 + 24 + 4 * h, pt * 32, lane);
        __builtin_amdgcn_sched_barrier(0);
        f32x16 sv = zero16();
#pragma unroll
        for (int ks = 0; ks < 8; ++ks) sv = MFMA(bf_[ks], creg[ks], sv);
#pragma unroll
        for (int g = 0; g < 4; ++g) {
          const float4 c4 = *(const float4*)(scs + st * 32 + 8 * g + 4 * h);
          const float4 d4 = *(const float4*)(sdt + st * 32 + 8 * g + 4 * h);
          const float cc[4] = {c4.x, c4.y, c4.z, c4.w};
          const float dd[4] = {d4.x, d4.y, d4.z, d4.w};
#pragma unroll
          for (int e = 0; e < 4; ++e) {
            const int sidx = st * 32 + 8 * g + 4 * h + e;
            const bool valid = dir == 0 ? (sidx <= lidx) : (sidx >= lidx);
            const float arg = valid ? (csl - cc[e]) : 0.f;
            const float dec = valid ? __expf(arg) * dd[e] : 0.f;
            sv[4 * g + e] *= dec;
          }
        }
        yacc = MFMA(cat8(x0, x1), pack8(sv, 0), yacc);
        yacc = MFMA(cat8(x2, x3), pack8(sv, 1), yacc);
      }
    }
    {
      bf16x8 hf_[8];
#pragma unroll
      for (int ks = 0; ks < 8; ++ks) hf_[ks] = *(const bf16x8*)(sH + (pt * 32 + r) * 136 + ks * 16 + h * 8);
      __builtin_amdgcn_sched_barrier(0);
      f32x16 yo = zero16();
#pragma unroll
      for (int ks = 0; ks < 8; ++ks) yo = MFMA(hf_[ks], creg[ks], yo);
      const float el = __expf(csl);
#pragma unroll
      for (int i = 0; i < 16; ++i) yacc[i] += el * yo[i];
    }
    {
      bf16_t* yout = p.yssd() + ((size_t)dir * MT + r0 + lidx) * 384 + head * 64 + pt * 32 + 4 * h;
#pragma unroll
      for (int g = 0; g < 4; ++g) {
        uint2 u;
        u.x = pack2(yacc[4 * g + 0], yacc[4 * g + 1]);
        u.y = pack2(yacc[4 * g + 2], yacc[4 * g + 3]);
        *(uint2*)(yout + 8 * g) = u;
      }
    }
    {
      const float et = __expf(fl[192]);
#pragma unroll
      for (int q = 0; q < 2; ++q)
#pragma unroll
        for (int i = 0; i < 16; ++i) hacc[q][i] *= et;
#pragma unroll
      for (int half = 0; half < 2; ++half) {
        bf16x8 av_[2], bv_[2][2];
#pragma unroll
        for (int k2 = 0; k2 < 2; ++k2) {
          const int ks = half * 2 + k2;
          av_[k2] = cat8(tr4(sXw, 72, ks * 16 + 8 * h, pt * 32, lane), tr4(sXw, 72, ks * 16 + 8 * h + 4, pt * 32, lane));
#pragma unroll
          for (int q = 0; q < 2; ++q) {
            const int nt = (wave & 1) * 2 + q;
            bv_[q][k2] = cat8(tr4(sB, 136, ks * 16 + 8 * h, nt * 32, lane), tr4(sB, 136, ks * 16 + 8 * h + 4, nt * 32, lane));
          }
        }
        __builtin_amdgcn_sched_barrier(0);
#pragma unroll
        for (int k2 = 0; k2 < 2; ++k2)
#pragma unroll
          for (int q = 0; q < 2; ++q) hacc[q] = MFMA(av_[k2], bv_[q][k2], hacc[q]);
        __builtin_amdgcn_sched_barrier(0);
      }
    }
    if (wave == 0 && it + 1 < 68) SSD_SCAN((it + 1) & 1);
    __syncthreads();
#pragma unroll
    for (int q = 0; q < 2; ++q) {
      const int nt = (wave & 1) * 2 + q;
#pragma unroll
      for (int reg = 0; reg < 16; ++reg) sH[(pt * 32 + crow(reg, h)) * 136 + nt * 32 + r] = f2bf(hacc[q][reg]);
    }
  }
#undef SSD_SCAN
#undef SSD_LOAD
  asm volatile("s_waitcnt vmcnt(0)" ::: "memory");
  __syncthreads();
  if (tid_full == 0) {
    __builtin_amdgcn_fence(__ATOMIC_RELEASE, "agent");
    asm volatile("s_waitcnt vmcnt(0)" ::: "memory");
    xb_add(p.bar() + 3700 + layer * 16 + b, 2u);
  }
  __syncthreads();
}

DI unsigned rope_word(unsigned mine, unsigned other, float4 cs, int h) {
  const float m0 = bflo(mine), m1 = bfhi(mine), o0 = bflo(other), o1 = bfhi(other);
  const float r0 = h ? (m0 * cs.x + o0 * cs.y) : (m0 * cs.x - o0 * cs.y);
  const float r1 = h ? (m1 * cs.z + o1 * cs.w) : (m1 * cs.z - o1 * cs.w);
  return pack2(r0, r1);
}
DI void attn_item(const Params& p, int b, int hh, int q0, int k_begin, int nkt, bf16_t* smem) {
  const int tid = otid(), lane = tid & 63, wave = tid >> 6, r = lane & 31, h = lane >> 5;
  const bf16_t* Kg = p.Kc() + ((size_t)(b * 6 + hh) * TT + k_begin) * 96;
  const bf16_t* Vg = p.Vt() + ((size_t)(b * 6 + hh) * 64) * TT + k_begin;
  const int qrow = q0 + wave * 32 + r;
  bf16x8 qreg[6];
  {
    const bf16_t* qp = p.Q() + ((size_t)(b * 6 + hh) * TT + qrow) * 96 + h * 8;
#pragma unroll
    for (int ks = 0; ks < 6; ++ks) qreg[ks] = *(const bf16x8*)(qp + ks * 16);
  }
  if (q0 < LSEQ) {
#pragma unroll
    for (int ax = 0; ax < 2; ++ax) {
      const int pos = ax ? (qrow & 63) : (qrow >> 6);
      const float* rp = p.rope() + pos * 16;
      const uint4 me = __builtin_bit_cast(uint4, qreg[4 + ax]);
      uint4 rr;
      rr.x = rope_word(me.x, __shfl_xor(me.x, 32), *(const float4*)(rp + 0), h);
      rr.y = rope_word(me.y, __shfl_xor(me.y, 32), *(const float4*)(rp + 4), h);
      rr.z = rope_word(me.z, __shfl_xor(me.z, 32), *(const float4*)(rp + 8), h);
      rr.w = rope_word(me.w, __shfl_xor(me.w, 32), *(const float4*)(rp + 12), h);
      qreg[4 + ax] = __builtin_bit_cast(bf16x8, rr);
    }
  }
  bf16_t* sK = smem;
  bf16_t* sV = smem + 2 * 64 * 104;
  uint4 rk0, rk1 = make_uint4(0u, 0u, 0u, 0u), rv;
  const int vrow = tid >> 3, vch = (tid & 7) * 8;
  const int kc1 = tid + 512;
  const int krow0 = tid / 12, kch0 = tid - krow0 * 12, krow1 = kc1 / 12, kch1 = kc1 - krow1 * 12;
#define K_LOAD(t_)                                                         \
  do {                                                                     \
    const bf16_t* kg_ = Kg + (size_t)(t_) * 64 * 96;                       \
    rk0 = *(const uint4*)(kg_ + (size_t)tid * 8);                          \
    if (tid < 256) rk1 = *(const uint4*)(kg_ + (size_t)kc1 * 8);           \
  } while (0)
#define K_STORE(buf_)                                                                      \
  do {                                                                                     \
    *(uint4*)(sK + ((buf_) * 64 + krow0) * 104 + kch0 * 8) = rk0;                          \
    if (tid < 256) *(uint4*)(sK + ((buf_) * 64 + krow1) * 104 + kch1 * 8) = rk1;           \
  } while (0)
#define V_LOAD(t_) rv = *(const uint4*)(Vg + (size_t)vrow * TT + (t_) * 64 + vch)
#define V_STORE(buf_)                                                                      \
  do {                                                                                     \
    bf16_t* vp_ = sV + ((buf_) * 64 + vrow) * 68 + vch;                                    \
    *(uint2*)vp_ = make_uint2(rv.x, rv.y);                                                 \
    *(uint2*)(vp_ + 4) = make_uint2(rv.z, rv.w);                                           \
  } while (0)
#define S_TILE(dst, buf_)                                                                                      \
  do {                                                                                                         \
    bf16x8 kf_[6];                                                                                             \
    const bf16_t* kb_ = sK + ((buf_) * 64 + r) * 104 + h * 8;                                                  \
    _Pragma("unroll") for (int ks = 0; ks < 6; ++ks) kf_[ks] = *(const bf16x8*)(kb_ + ks * 16);                \
    __builtin_amdgcn_sched_barrier(0);                                                                         \
    dst[0] = zero16();                                                                                         \
    _Pragma("unroll") for (int ks = 0; ks < 6; ++ks) dst[0] = MFMA(kf_[ks], qreg[ks], dst[0]);                 \
    __builtin_amdgcn_sched_barrier(0);                                                                         \
    _Pragma("unroll") for (int ks = 0; ks < 6; ++ks) kf_[ks] = *(const bf16x8*)(kb_ + 32 * 104 + ks * 16);     \
    __builtin_amdgcn_sched_barrier(0);                                                                         \
    dst[1] = zero16();                                                                                         \
    _Pragma("unroll") for (int ks = 0; ks < 6; ++ks) dst[1] = MFMA(kf_[ks], qreg[ks], dst[1]);                 \
    __builtin_amdgcn_sched_barrier(0);                                                                         \
  } while (0)
  K_LOAD(0); V_LOAD(0);
  K_STORE(0); V_STORE(0);
  if (nkt > 1) { K_LOAD(1); K_STORE(1); }
  __syncthreads();
  f32x16 o[2], o2, sc[2], negm;
  o[0] = zero16();
  o[1] = zero16();
  o2 = zero16();
  negm = zero16();
  bf16x8 ones;
  {
    const unsigned w = r == 0 ? 0x3F803F80u : 0u;
    uint4 u; u.x = w; u.y = w; u.z = w; u.w = w;
    ones = __builtin_bit_cast(bf16x8, u);
  }
#define S_CHAIN(dst, buf_)                                                                                 \
  do {                                                                                                     \
    bf16x8 kf_[6];                                                                                         \
    const bf16_t* kb_ = sK + ((buf_) * 64 + r) * 104 + h * 8;                                              \
    _Pragma("unroll") for (int ks = 0; ks < 6; ++ks) kf_[ks] = *(const bf16x8*)(kb_ + ks * 16);            \
    __builtin_amdgcn_sched_barrier(0);                                                                     \
    dst[0] = negm;                                                                                         \
    __builtin_amdgcn_s_setprio(1);                                                                         \
    _Pragma("unroll") for (int ks = 0; ks < 6; ++ks) dst[0] = MFMA(kf_[ks], qreg[ks], dst[0]);             \
    __builtin_amdgcn_s_setprio(0);                                                                         \
    __builtin_amdgcn_sched_barrier(0);                                                                     \
    _Pragma("unroll") for (int ks = 0; ks < 6; ++ks) kf_[ks] = *(const bf16x8*)(kb_ + 32 * 104 + ks * 16); \
    __builtin_amdgcn_sched_barrier(0);                                                                     \
    dst[1] = negm;                                                                                         \
    __builtin_amdgcn_s_setprio(1);                                                                         \
    _Pragma("unroll") for (int ks = 0; ks < 6; ++ks) dst[1] = MFMA(kf_[ks], qreg[ks], dst[1]);             \
    __builtin_amdgcn_s_setprio(0);                                                                         \
    __builtin_amdgcn_sched_barrier(0);                                                                     \
  } while (0)
#define ATT_STEP(sc_, sn_, kt_)                                                                            \
  do {                                                                                                     \
    const int buf = (kt_) & 1;                                                                             \
    if ((kt_) + 2 < nkt) K_LOAD((kt_) + 2);                                                                \
    if ((kt_) + 1 < nkt) { V_LOAD((kt_) + 1); S_CHAIN(sn_, buf ^ 1); }                                     \
    bf16x8 vf_[8];                                                                                         \
    _Pragma("unroll") for (int mt = 0; mt < 2; ++mt)                                                       \
    _Pragma("unroll") for (int s2 = 0; s2 < 2; ++s2)                                                       \
    _Pragma("unroll") for (int dt = 0; dt < 2; ++dt) {                                                     \
      const bf16_t* va = sV + (buf * 64 + dt * 32 + r) * 68 + mt * 32 + 16 * s2 + 4 * h;                   \
      vf_[(mt * 2 + s2) * 2 + dt] = join8(*(const uint2*)va, *(const uint2*)(va + 8));                     \
    }                                                                                                      \
    __builtin_amdgcn_sched_barrier(0);                                                                     \
    float mx = sc_[0][0];                                                                                  \
    _Pragma("unroll") for (int i = 1; i < 16; ++i) mx = fmaxf(mx, sc_[0][i]);                              \
    _Pragma("unroll") for (int i = 0; i < 16; ++i) mx = fmaxf(mx, sc_[1][i]);                              \
    mx = fmaxf(mx, __shfl_xor(mx, 32));                                                                    \
    if ((kt_) == 0 || __builtin_amdgcn_ballot_w64(mx > 8.f) != 0ull) {                                     \
      const float delta = ((kt_) == 0 || mx > 8.f) ? mx : 0.f;                                             \
      const float alpha = (kt_) == 0 ? 0.f : __builtin_amdgcn_exp2f(-delta);                               \
      _Pragma("unroll") for (int i = 0; i < 16; ++i) {                                                     \
        o[0][i] *= alpha; o[1][i] *= alpha; o2[i] *= alpha;                                                \
        sc_[0][i] -= delta; sc_[1][i] -= delta; sn_[0][i] -= delta; sn_[1][i] -= delta; negm[i] -= delta;  \
      }                                                                                                    \
    }                                                                                                      \
    _Pragma("unroll") for (int mt = 0; mt < 2; ++mt)                                                       \
    _Pragma("unroll") for (int i = 0; i < 16; ++i) sc_[mt][i] = __builtin_amdgcn_exp2f(sc_[mt][i]);        \
    __builtin_amdgcn_s_setprio(1);                                                                         \
    _Pragma("unroll") for (int mt = 0; mt < 2; ++mt)                                                       \
    _Pragma("unroll") for (int s2 = 0; s2 < 2; ++s2) {                                                     \
      const bf16x8 pf = pack8(sc_[mt], s2);                                                                \
      o[0] = MFMA(vf_[(mt * 2 + s2) * 2 + 0], pf, o[0]);                                                   \
      o[1] = MFMA(vf_[(mt * 2 + s2) * 2 + 1], pf, o[1]);                                                   \
      o2 = MFMA(ones, pf, o2);                                                                             \
    }                                                                                                      \
    __builtin_amdgcn_s_setprio(0);                                                                         \
    if ((kt_) + 2 < nkt) K_STORE(buf);                                                                     \
    if ((kt_) + 1 < nkt) V_STORE(buf ^ 1);                                                                 \
    __syncthreads();                                                                                       \
  } while (0)
  f32x16 sn[2];
  sn[0] = zero16();
  sn[1] = zero16();
  S_CHAIN(sc, 0);
  __syncthreads();
  for (int kt = 0; kt < nkt; kt += 2) {
    ATT_STEP(sc, sn, kt);
    ATT_STEP(sn, sc, kt + 1);
  }
#undef ATT_STEP
#undef S_CHAIN
  float l = __shfl(o2[0], r);
#undef K_LOAD
#undef K_STORE
#undef V_LOAD
#undef V_STORE
#undef S_TILE
  const float inv = 1.f / l;
  bf16_t* op = p.xn() + ((size_t)b * TT + qrow) * DM + 384 + hh * 64 + 4 * h;
#pragma unroll
  for (int dt = 0; dt < 2; ++dt)
#pragma unroll
    for (int g = 0; g < 4; ++g) {
      uint2 u;
      u.x = pack2(o[dt][4 * g + 0] * inv, o[dt][4 * g + 1] * inv);
      u.y = pack2(o[dt][4 * g + 2] * inv, o[dt][4 * g + 3] * inv);
      *(uint2*)(op + dt * 32 + 8 * g) = u;
    }
}

DI void ssd_out_rows(const Params& p, int layer, int r_begin, int nrows) {
  const int tid = otid(), lane = tid & 63, wave = tid >> 6;
  const int grp = lane >> 5, li = lane & 31;
  const int ch = grp * 192 + li * 6;
  float dsk[6], nw[6];
#pragma unroll
  for (int e = 0; e < 6; ++e) {
    dsk[e] = p.ssd_d[layer * 6 + (ch + e) / 64];
    nw[e] = p.ssd_norm_w[layer * 384 + ch + e];
  }
  for (int r = r_begin + wave; r < r_begin + nrows; r += 8) {
    const int b = r / TT, t = r - b * TT;
    if (t >= LSEQ && layer == 1) continue;
    const unsigned* yf = (const unsigned*)(p.yssd() + (size_t)r * 384 + ch);
    const unsigned* yb = (const unsigned*)(p.yssd() + ((size_t)MT + r) * 384 + ch);
    const unsigned* xs = (const unsigned*)(p.xbc() + (size_t)r * 896 + ch);
    const unsigned* zz = (const unsigned*)(p.proj() + (size_t)r * NP + C_Z + ch);
    float g[6];
    float ss = 0.f;
#pragma unroll
    for (int e2 = 0; e2 < 3; ++e2) {
      const unsigned a = yf[e2], bq = yb[e2], x = xs[e2], z = zz[e2];
      const float y0 = bflo(a) + bflo(bq) + bflo(x) * dsk[2 * e2];
      const float y1 = bfhi(a) + bfhi(bq) + bfhi(x) * dsk[2 * e2 + 1];
      g[2 * e2] = y0 * silu(bflo(z));
      g[2 * e2 + 1] = y1 * silu(bfhi(z));
      ss += g[2 * e2] * g[2 * e2] + g[2 * e2 + 1] * g[2 * e2 + 1];
    }
#pragma unroll
    for (int o = 16; o >= 1; o >>= 1) ss += __shfl_xor(ss, o);
    const float rstd = rsqrtf(ss * (1.f / 192.f) + 1e-6f);
    unsigned* dst = (unsigned*)(p.xn() + (size_t)r * DM + ch);
#pragma unroll
    for (int e2 = 0; e2 < 3; ++e2) dst[e2] = pack2(g[2 * e2] * rstd * nw[2 * e2], g[2 * e2 + 1] * rstd * nw[2 * e2 + 1]);
  }
}

DI void phase_mixers(const Params& p, int layer, bf16_t* smem, int rep) {
  if (EN(13) || ONLY == 3) for (int jp = obid(); jp < 96; jp += ogrid()) ssd_job(p, layer, jp, smem);
  if (ONLY == 13) return;
  if (layer == 0) {
    if (ogrid() > 96) { if (obid() >= 96) transpose_layer(p, 1, obid() - 96, ogrid() - 96, (float*)smem); }
    else transpose_layer(p, 1, obid(), ogrid(), (float*)smem);
  }
  volatile int* sitem = (volatile int*)((char*)smem + MISC_OFF + 1024);
  const int ipg = layer == 0 ? 17 : 16;
  const int nper = 12 * ipg;
  unsigned* qbase = p.bar() + 3616 + (layer + 2 * rep) * 8;
  const int xcc = (int)(xb_xcc_id() & 7u);
  for (int k = 0; k < 8; ++k) {
    const int xq = (xcc + k) & 7;
    while (true) {
      __syncthreads();
      if (threadIdx.x == 0) *sitem = (int)xb_add(qbase + xq, 1u);
      __syncthreads();
      const int idx = *sitem;
      if (idx >= nper) break;
      const int gi = idx / ipg, within = idx - gi * ipg;
      const int g = xq + 8 * gi;
      const int b = g / 6, hh = g - b * 6;
      if (within == 16) attn_item(p, b, hh, LSEQ, LSEQ, 4, smem);
      else attn_item(p, b, hh, within * 256, 0, 68, smem);
    }
  }
  {
    unsigned* done = p.bar() + 3700 + layer * 16;
    unsigned* rowq = p.bar() + 3740 + layer * 16;
    const int nchunk = layer == 0 ? 68 : 64;
    for (int bb = 0; bb < NB; ++bb) {
      __syncthreads();
      if (threadIdx.x == 0) {
        XB_SPIN(xb_ld(done + bb) < 12u, p.bar());
        __builtin_amdgcn_fence(__ATOMIC_ACQUIRE, "agent");
        asm volatile("s_waitcnt vmcnt(0)" ::: "memory");
      }
      __syncthreads();
      while (true) {
        if (threadIdx.x == 0) *sitem = (int)xb_add(rowq + bb, 1u);
        __syncthreads();
        const int c = *sitem;
        __syncthreads();
        if (c >= nchunk) break;
        ssd_out_rows(p, layer, bb * TT + c * 64, 64);
      }
    }
  }
}

struct XcdBarrier { unsigned* bar; unsigned x; volatile LAS unsigned* st; };
DI XcdBarrier xcd_barrier_post(unsigned* bar, volatile LAS unsigned* st) {
  XcdBarrier b; b.bar = bar; b.x = xb_xcc_id(); b.st = st;
  if (threadIdx.x == 0) (void)xb_add(&bar[XB_XCNT(b.x)], 1u);
  return b;
}
DI void xcd_barrier_complete(unsigned* bar, unsigned x, unsigned& nloc, unsigned& nx) {
  const unsigned G = gridDim.x * gridDim.y * gridDim.z;
  unsigned sum, cnt, mine, sp = 0u;
  for (;;) {
    sum = 0u; cnt = 0u; mine = 0u;
#pragma unroll
    for (unsigned j = 0; j < 16; ++j) { const unsigned c = xb_ld(&bar[XB_XCNT(j)]); sum += c; cnt += (c > 0u) ? 1u : 0u; mine = (j == x) ? c : mine; }
    if (sum == G) break;
    __builtin_amdgcn_s_sleep(1);
    if ((++sp & 255u) == 0u) { if (xb_ld(&bar[XB_TMO])) break; if (sp > XB_SPIN_CAP) { atomicAdd(&bar[XB_TMO], 1u); break; } }
  }
  nloc = mine > 0u ? mine : 1u; nx = cnt > 0u ? cnt : 1u;
}
DI void xcd_barrier(const XcdBarrier& b) {
  asm volatile("s_waitcnt vmcnt(0)" ::: "memory");
  __syncthreads();
  if (threadIdx.x == 0) {
    unsigned* bar = b.bar;
    __builtin_amdgcn_s_waitcnt(0);
    unsigned nloc = b.st[0], nx = b.st[1];
    if (nloc == 0u) { xcd_barrier_complete(bar, b.x, nloc, nx); b.st[0] = nloc; b.st[1] = nx; }
    const unsigned old = xb_add(&bar[XB_XSUB(b.x)], 1u);
    const unsigned gen = old / nloc;
    if (old + 1u == (gen + 1u) * nloc) {
      __builtin_amdgcn_fence(__ATOMIC_RELEASE, "agent");
      asm volatile("s_waitcnt vmcnt(0)" ::: "memory");
      const unsigned og = xb_add(&bar[XB_TOP], 1u);
      const unsigned tg = og / nx;
      if (og + 1u == (tg + 1u) * nx) xb_add(&bar[XB_TOPGEN], 1u);
      else XB_SPIN(xb_ld(&bar[XB_TOPGEN]) == tg, bar);
      __builtin_amdgcn_fence(__ATOMIC_ACQUIRE, "agent");
      xb_add(&bar[XB_XGEN(b.x)], 1u);
      asm volatile("s_waitcnt vmcnt(0)" ::: "memory");
    } else {
      XB_SPIN(xb_ld(&bar[XB_XGEN(b.x)]) == gen, bar);
      __builtin_amdgcn_fence(__ATOMIC_ACQUIRE, "agent");
      asm volatile("s_waitcnt vmcnt(0)" ::: "memory");
    }
  }
  __syncthreads();
}

DI void run_phase(const Params& p, int ph, bf16_t* smem, int rep) {
  if (ph == 0) { if (EN(10)) phase_prep(p, smem); return; }
  if (ph == NPHASE - 1) { if (EN(11)) phase_final(p); return; }
  const int layer = (ph - 1) / 9, s = (ph - 1) % 9;
  switch (s) {
    case 0: if (EN(0)) phase_norm(p, layer, 1); break;
    case 1: if (EN(1)) phase_gemm_in(p, layer, smem); break;
    case 2: if (EN(2)) phase_tokops(p, layer); if (EN(12)) phase_gemm_qkv(p, layer, smem); break;
    case 3: if (EN(3) || EN(13) || EN(14)) phase_mixers(p, layer, smem, rep); break;
    case 4: break;
    case 5: if (EN(5)) phase_gemm_out(p, layer, smem); break;
    case 6: if (EN(6)) phase_norm(p, layer, 2); break;
    case 7: if (EN(7)) phase_gemm_m1(p, layer, smem); break;
    default: if (EN(8)) phase_gemm_m2(p, layer, smem); break;
  }
}

__global__ void __launch_bounds__(512, 2) fwd_megakernel(Params p, int ph_begin, int ph_end) {
  __shared__ __attribute__((aligned(16))) unsigned char smem_raw[SMEM_BYTES];
  bf16_t* smem = (bf16_t*)smem_raw;
  cg::grid_group grid = cg::this_grid();
  volatile LAS unsigned* xst = (volatile LAS unsigned*)(LAS unsigned char*)(smem_raw + MISC_OFF + 1024 + 32);
  if (threadIdx.x == 0) { xst[0] = 0u; xst[1] = 0u; }
  __syncthreads();
  const XcdBarrier xb = xcd_barrier_post(p.bar(), xst);
  for (int ph = ph_begin; ph < ph_end; ++ph) {
    if (ph >= 1 && ph < NPHASE - 1 && (ph - 1) % 9 == 4) continue;
    run_phase(p, ph, smem, 0);
#if REPEAT_MASK
    if (ph >= 1 && ph < NPHASE - 1 && ((REPEAT_MASK >> ((ph - 1) % 9)) & 1)) {
      xcd_barrier(xb);
      run_phase(p, ph, smem, 1);
    }
#endif
    if (ph + 1 < ph_end) {
      if (ph == 0) grid.sync();
      else xcd_barrier(xb);
    }
  }
}

extern "C" void kernel_launch(void* const* d_in, const int* in_sizes, int n_in, void* d_out, int out_size, void* d_ws,
                              size_t ws_size, hipStream_t stream) {
  static int grid_blocks = 0;
  if (!grid_blocks) {
    int dev = 0, cus = 0, per_cu = 0;
    hipGetDevice(&dev);
    hipDeviceGetAttribute(&cus, hipDeviceAttributeMultiprocessorCount, dev);
    hipOccupancyMaxActiveBlocksPerMultiprocessor(&per_cu, fwd_megakernel, 512, 0);
    if (per_cu > 1) per_cu = 1;
    if (per_cu < 1) per_cu = 1;
    grid_blocks = cus * per_cu;
  }
  Params p{};
  const float** fp = (const float**)&p;
  for (int i = 0; i < 25; ++i) fp[i] = (const float*)d_in[i];
  p.out = (float*)d_out;
  p.ws = (char*)d_ws;
  if (WS_NEED > ws_size) fprintf(stderr, "workspace too small: need %zu have %zu\n", (size_t)WS_NEED, ws_size);
  hipMemsetAsync((char*)d_ws + O_BAR, 0, 16384, stream);
#if MULTI_LAUNCH
  for (int ph = 0; ph < NPHASE; ++ph)
    hipLaunchKernelGGL(fwd_megakernel, dim3(grid_blocks), dim3(512), 0, stream, p, ph, ph + 1);
#else
  int b0 = 0, b1 = NPHASE;
  void* args[] = {&p, &b0, &b1};
  hipError_t e = hipLaunchCooperativeKernel((void*)fwd_megakernel, dim3(grid_blocks), dim3(512), args, 0, stream);
  if (e != hipSuccess) fprintf(stderr, "cooperative launch failed: %s (grid %d)\n", hipGetErrorString(e), grid_blocks);
#endif
}
```

```cpp
#include <hip/hip_runtime.h>
#include <hip/hip_cooperative_groups.h>
#include <cstdio>
#include <cstdint>
namespace cg = cooperative_groups;

#ifndef MULTI_LAUNCH
#define MULTI_LAUNCH 0
#endif
#ifndef ONLY
#define ONLY -1
#endif
#define EN(k) (ONLY < 0 || ONLY == (k))
#ifndef REPEAT_MASK
#define REPEAT_MASK 0
#endif

#define DI __device__ __forceinline__
typedef unsigned short bf16_t;
using bf16x8 = __attribute__((ext_vector_type(8))) short;
using f32x16 = __attribute__((ext_vector_type(16))) float;
typedef __bf16 bfv2 __attribute__((ext_vector_type(2)));
typedef float f32v2 __attribute__((ext_vector_type(2)));
#define MFMA(a, b, c) __builtin_amdgcn_mfma_f32_32x32x16_bf16((a), (b), (c), 0, 0, 0)

constexpr int NB = 16, LSEQ = 4096, CTXL = 256, TT = 4352;
constexpr int MT = NB * TT;
constexpr int DM = 1024, DFF = 4096;
constexpr int NP = 2176;
constexpr int C_Z = 0, C_XBC = 384, C_DT = 1280, C_QA = 1344, C_KVA = 1600, C_KR = 1856, C_POOL = 1888;
constexpr int IN_COLS = 2092;
constexpr int NPHASE = 20;
constexpr int MISC_OFF = 145408;
constexpr int SMEM_BYTES = MISC_OFF + 1024 + 256;
constexpr int NPW = 2304;
constexpr int NQ = 768;
constexpr int SSD_LDS_EL = 36352;

constexpr size_t al256(size_t x) { return (x + 255) & ~(size_t)255; }
constexpr size_t O_WT_IN = 0;
constexpr size_t O_WT_OUT = O_WT_IN + al256((size_t)2 * NPW * 1024 * 2);
constexpr size_t O_WT_M1 = O_WT_OUT + al256((size_t)2 * 1024 * 1024 * 2);
constexpr size_t O_WT_M2 = O_WT_M1 + al256((size_t)2 * 4096 * 1024 * 2);
constexpr size_t O_WT_QB = O_WT_M2 + al256((size_t)2 * 1024 * 4096 * 2);
constexpr size_t O_WT_KVB = O_WT_QB + al256((size_t)2 * NQ * 256 * 2);
constexpr size_t O_MODS = O_WT_KVB + al256((size_t)2 * 768 * 256 * 2);
constexpr size_t O_ROPE = O_MODS + al256((size_t)2 * 17 * 6144 * 4);
constexpr size_t O_CTR = O_ROPE + al256(64 * 8 * 2 * 4);
constexpr size_t O_BAR = O_CTR + 256;
constexpr size_t O_RSS = O_BAR + 16384;
constexpr size_t O_CTXRES = O_RSS + al256((size_t)2 * MT * 4);
constexpr size_t O_XN = O_CTXRES + al256((size_t)NB * CTXL * DM * 4);
constexpr size_t O_YSSD = O_XN + al256((size_t)MT * DM * 2);
constexpr size_t O_BIG = O_YSSD + al256((size_t)2 * MT * 384 * 2);
constexpr size_t O_PROJ = O_BIG;
constexpr size_t O_XBC = O_PROJ + al256((size_t)MT * NP * 2);
constexpr size_t O_Q = O_XBC + al256((size_t)MT * 896 * 2);
constexpr size_t O_K = O_Q + al256((size_t)NB * 6 * TT * 96 * 2);
constexpr size_t O_VT = O_K + al256((size_t)NB * 6 * TT * 96 * 2);
constexpr size_t O_END1 = O_VT + al256((size_t)NB * 6 * 64 * TT * 2);
constexpr size_t O_END2 = O_BIG + (size_t)MT * DFF * 2;
constexpr size_t WS_NEED = O_END1 > O_END2 ? O_END1 : O_END2;

struct Params {
  const float *x, *c, *ctx, *c_ctx, *mod_w, *mod_b, *norm1_w, *norm2_w, *w_in, *conv_w, *conv_b, *dt_bias, *a_log,
      *ssd_d, *ssd_norm_w, *q_a_norm_w, *w_q_b, *kv_a_norm_w, *w_kv_b, *pool_w, *pool_scale, *w_out, *w_mlp1, *w_mlp2,
      *final_norm_w;
  float* out;
  char* ws;
  DI bf16_t* wt_in() const { return (bf16_t*)(ws + O_WT_IN); }
  DI bf16_t* wt_out() const { return (bf16_t*)(ws + O_WT_OUT); }
  DI bf16_t* wt_m1() const { return (bf16_t*)(ws + O_WT_M1); }
  DI bf16_t* wt_m2() const { return (bf16_t*)(ws + O_WT_M2); }
  DI bf16_t* wt_qb() const { return (bf16_t*)(ws + O_WT_QB); }
  DI bf16_t* wt_kvb() const { return (bf16_t*)(ws + O_WT_KVB); }
  DI float* mods() const { return (float*)(ws + O_MODS); }
  DI float* rope() const { return (float*)(ws + O_ROPE); }
  DI int* ctr() const { return (int*)(ws + O_CTR); }
  DI unsigned* bar() const { return (unsigned*)(ws + O_BAR); }
  DI float* rss() const { return (float*)(ws + O_RSS); }
  DI float* ctxres() const { return (float*)(ws + O_CTXRES); }
  DI bf16_t* xn() const { return (bf16_t*)(ws + O_XN); }
  DI bf16_t* yssd() const { return (bf16_t*)(ws + O_YSSD); }
  DI bf16_t* proj() const { return (bf16_t*)(ws + O_PROJ); }
  DI bf16_t* xbc() const { return (bf16_t*)(ws + O_XBC); }
  DI bf16_t* Q() const { return (bf16_t*)(ws + O_Q); }
  DI bf16_t* Kc() const { return (bf16_t*)(ws + O_K); }
  DI bf16_t* Vt() const { return (bf16_t*)(ws + O_VT); }
  DI bf16_t* hidden() const { return (bf16_t*)(ws + O_BIG); }
};

DI unsigned pack2(float a, float b) {
  f32v2 v = {a, b};
  bfv2 r = __builtin_convertvector(v, bfv2);
  return __builtin_bit_cast(unsigned, r);
}
DI bf16_t f2bf(float a) { return (bf16_t)(pack2(a, 0.f) & 0xffffu); }
DI float bf2f(bf16_t v) { return __uint_as_float(((unsigned)v) << 16); }
DI float bflo(unsigned w) { return __uint_as_float(w << 16); }
DI float bfhi(unsigned w) { return __uint_as_float(w & 0xffff0000u); }
DI float silu(float x) { return x / (1.f + __expf(-x)); }
DI int crow(int reg, int h) { return (reg & 3) + 8 * (reg >> 2) + 4 * h; }
DI float wave_sum(float v) {
#pragma unroll
  for (int o = 32; o >= 1; o >>= 1) v += __shfl_xor(v, o);
  return v;
}
DI bf16x8 pack8(const f32x16& x, int s) {
  uint4 u;
  u.x = pack2(x[8 * s + 0], x[8 * s + 1]);
  u.y = pack2(x[8 * s + 2], x[8 * s + 3]);
  u.z = pack2(x[8 * s + 4], x[8 * s + 5]);
  u.w = pack2(x[8 * s + 6], x[8 * s + 7]);
  return __builtin_bit_cast(bf16x8, u);
}
DI bf16x8 join8(uint2 lo, uint2 hi) {
  uint4 u; u.x = lo.x; u.y = lo.y; u.z = hi.x; u.w = hi.y;
  return __builtin_bit_cast(bf16x8, u);
}
DI int ogrid() { return gridDim.x; }
DI int obid() { return blockIdx.x; }
DI int ogrid_op() { int g = gridDim.x; asm volatile("" : "+s"(g)); return g; }
DI int otid() { int t = threadIdx.x; asm volatile("" : "+v"(t)); return t; }
DI unsigned xb_ld(unsigned* p) { return __hip_atomic_load(p, __ATOMIC_RELAXED, __HIP_MEMORY_SCOPE_AGENT); }
DI unsigned xb_add(unsigned* p, unsigned v) { return __hip_atomic_fetch_add(p, v, __ATOMIC_RELAXED, __HIP_MEMORY_SCOPE_AGENT); }
DI unsigned xb_xcc_id() { return (unsigned)__builtin_amdgcn_s_getreg((3 << 11) | 20) & 0xFu; }
#define XB_TMO      128
#define XB_XCNT(j)  (256  + 64 * (j))
#define XB_XSUB(j)  (1280 + 64 * (j))
#define XB_XGEN(j)  (2304 + 64 * (j))
#define XB_TOP      3328
#define XB_TOPGEN   3392
#define XCD_BAR_WORDS 3456
#define XB_SPIN_CAP (1u << 18)
#define XB_SPIN(cond, bar) do { unsigned _sp = 0; while (cond) { __builtin_amdgcn_s_sleep(1); \
    if ((++_sp & 255u) == 0u) { if (xb_ld(&(bar)[XB_TMO])) break; if (_sp > XB_SPIN_CAP) { atomicAdd(&(bar)[XB_TMO], 1u); break; } } } } while (0)
DI f32x16 zero16() { f32x16 z; for (int i = 0; i < 16; ++i) z[i] = 0.f; return z; }

DI float* res_row(const Params& p, int b, int t) {
  return t < LSEQ ? p.out + ((size_t)b * LSEQ + t) * DM : p.ctxres() + ((size_t)b * CTXL + (t - LSEQ)) * DM;
}
DI const float* in_row(const Params& p, int b, int t) {
  return t < LSEQ ? p.x + ((size_t)b * LSEQ + t) * DM : p.ctx + ((size_t)b * CTXL + (t - LSEQ)) * DM;
}

using f32x4 = __attribute__((ext_vector_type(4))) float;
constexpr int GBK = 64, GHALF = 128, GHT = GHALF * GBK;
#define LAS __attribute__((address_space(3)))
DI int lds_byte(int r, int c) {
  const int st = (r >> 4) * 2 + (c >> 5), rr = r & 15, cc = c & 31, ob = rr * 64 + cc * 2;
  return st * 1024 + (ob ^ (((ob >> 9) & 1) << 5));
}
DI void stage_rc(int b, int& R, int& C) {
  const int st = b / 1024, sb = b % 1024, swz = sb ^ (((sb >> 9) & 1) << 5);
  R = (st >> 1) * 16 + swz / 64;
  C = (st & 1) * 32 + (swz % 64) / 2;
}
typedef f32x4 acc_t[2][2][4][2];
DI int perm32(int rho) { const int n = rho >> 4, i = rho & 15; return 8 * (i >> 2) + 4 * n + (i & 3); }

template <bool RMS, class Epi, class UnitFn>
DI void gemm256(const bf16_t* __restrict__ A, int lda, const bf16_t* __restrict__ Bt, int ldb, int K,
                bf16_t* shm, Epi& epi, UnitFn unit) {
  const int tid = otid();
  const int wid = tid >> 6, lane = tid & 63, wr = wid >> 2, wc = wid & 3, fr = lane & 15, fq = lane >> 4;
  float* rs = (float*)((char*)shm + MISC_OFF);
  const int ldst0 = tid * 16;
  const unsigned swave = (unsigned)__builtin_amdgcn_readfirstlane((int)((unsigned)(size_t)(LAS char*)shm + (unsigned)((tid & ~63) * 16)));
  unsigned la0, la1, lb0, lb1;
  {
    int r0_, c0_, r1_, c1_;
    stage_rc(ldst0, r0_, c0_);
    stage_rc(ldst0 + 8192, r1_, c1_);
    la0 = (unsigned)(r0_ * lda + c0_) * 2u; la1 = (unsigned)(r1_ * lda + c1_) * 2u;
    if (Epi::PERM) { r0_ = (r0_ & ~31) | perm32(r0_ & 31); r1_ = (r1_ & ~31) | perm32(r1_ & 31); }
    lb0 = (unsigned)(r0_ * ldb + c0_) * 2u; lb1 = (unsigned)(r1_ * ldb + c1_) * 2u;
  }
#define SA(b, h) (shm + ((b) * 2 + (h)) * GHT)
#define SB(b, h) (shm + (4 + (b) * 2 + (h)) * GHT)
#define GLDS(voff, sbase, m0v)                                                                           \
  asm volatile("s_mov_b32 m0, %2\n\ts_nop 0\n\tglobal_load_lds_dwordx4 %0, %1" ::"v"(voff), "s"(sbase), "s"(m0v) : "memory", "m0")
#define STAGE(PB, BASE, LD, br, kt, L0, L1)                                                               \
  do {                                                                                                    \
    const char* _ub = (const char*)((BASE) + (long)(br) * (LD) + (long)(kt) * GBK);                       \
    const unsigned _m = swave + (unsigned)(PB);                                                           \
    GLDS(L0, _ub, _m);                                                                                    \
    GLDS(L1, _ub, _m + 8192u);                                                                            \
  } while (0)
#define SAB(b, h) ((((b) * 2 + (h)) * GHT) * 2)
#define SBB(b, h) (((4 + (b) * 2 + (h)) * GHT) * 2)
#define STA(P, br, kt) STAGE(P, A, lda, br, kt, la0, la1)
#define STB(P, br, kt) STAGE(P, Bt, ldb, br, kt, lb0, lb1)
#define LDA(dst, b, h)                                                                                    \
  _Pragma("unroll") for (int m = 0; m < 4; ++m) _Pragma("unroll") for (int k = 0; k < 2; ++k)             \
      dst[m][k] = *reinterpret_cast<const bf16x8*>((const char*)SA(b, h) + lds_byte(wr * 64 + m * 16 + fr, k * 32 + fq * 8))
#define LDB(dst, b, h)                                                                                    \
  _Pragma("unroll") for (int n = 0; n < 2; ++n) _Pragma("unroll") for (int k = 0; k < 2; ++k)             \
      dst[n][k] = *reinterpret_cast<const bf16x8*>((const char*)SB(b, h) + lds_byte(wc * 32 + n * 16 + fr, k * 32 + fq * 8))
#define MMA(ai, bj, At_, Bt_)                                                                             \
  do {                                                                                                    \
    __builtin_amdgcn_s_setprio(1);                                                                        \
    _Pragma("unroll") for (int m = 0; m < 4; ++m) _Pragma("unroll") for (int n = 0; n < 2; ++n)           \
        _Pragma("unroll") for (int k = 0; k < 2; ++k) acc[ai][bj][m][n] =                                 \
            __builtin_amdgcn_mfma_f32_16x16x32_bf16(Bt_[n][k], At_[m][k], acc[ai][bj][m][n], 0, 0, 0);   \
    __builtin_amdgcn_s_setprio(0);                                                                        \
  } while (0)
#define WAIT_V(n) asm volatile("s_waitcnt vmcnt(" #n ")" ::: "memory")
#define WAIT_L(n) asm volatile("s_waitcnt lgkmcnt(" #n ")" ::: "memory")
#define BAR __builtin_amdgcn_s_barrier()
#define SCHED __builtin_amdgcn_sched_barrier(0)
#define PROLOGUE(br_, bc_)                                                                                 \
  do {                                                                                                    \
    STB(SBB(0, 0), (bc_), 0); STA(SAB(0, 0), (br_), 0);                                                   \
    STB(SBB(0, 1), (bc_) + GHALF, 0); STA(SAB(0, 1), (br_) + GHALF, 0);                                   \
    STB(SBB(1, 0), (bc_), 1); STA(SAB(1, 0), (br_), 1); STB(SBB(1, 1), (bc_) + GHALF, 1);                 \
  } while (0)
  int brow = 0, bcol = 0;
  if (!unit(0, brow, bcol)) return;
  if (!RMS) PROLOGUE(brow, bcol);
  for (int ui = 0;; ++ui) {
  int nbrow = 0, nbcol = 0;
  const bool more = unit(ui + 1, nbrow, nbcol);
  if (RMS) {
    const int row = tid >> 1, half = tid & 1;
    const bf16_t* ap = A + (size_t)(brow + row) * lda + half * 128;
    float ss = 0.f;
#pragma unroll 4
    for (int i = 0; i < 16; ++i) {
      uint4 v = *(const uint4*)(ap + i * 8);
      float f;
      f = bflo(v.x); ss += f * f; f = bfhi(v.x); ss += f * f;
      f = bflo(v.y); ss += f * f; f = bfhi(v.y); ss += f * f;
      f = bflo(v.z); ss += f * f; f = bfhi(v.z); ss += f * f;
      f = bflo(v.w); ss += f * f; f = bfhi(v.w); ss += f * f;
    }
    ss += __shfl_xor(ss, 1);
    if (half == 0) rs[row] = rsqrtf(ss * (1.f / 256.f) + 1e-6f);
    WAIT_V(0);
    PROLOGUE(brow, bcol);
  }
  acc_t acc;
#pragma unroll
  for (int i0 = 0; i0 < 2; ++i0)
#pragma unroll
    for (int i1 = 0; i1 < 2; ++i1)
#pragma unroll
      for (int i2 = 0; i2 < 4; ++i2)
#pragma unroll
        for (int i3 = 0; i3 < 2; ++i3) acc[i0][i1][i2][i3] = (f32x4){0.f, 0.f, 0.f, 0.f};
  bf16x8 At[4][2], B0[2][2], B1[2][2];
  const int nt = K / GBK;
  if (wr == 1) BAR;
  WAIT_V(10); BAR;
  WAIT_V(6); BAR;
  for (int t = 0; t < nt - 2; t += 2) {
    LDB(B0, 0, 0); SCHED; LDA(At, 0, 0); STA(SAB(1, 1), brow + GHALF, t + 1);
    WAIT_L(8); BAR; WAIT_L(0); MMA(0, 0, At, B0); BAR; SCHED;
    LDB(B1, 0, 1); STB(SBB(0, 0), bcol, t + 2);
    BAR; WAIT_L(0); MMA(0, 1, At, B1); BAR;
    LDA(At, 0, 1); STA(SAB(0, 0), brow, t + 2);
    BAR; WAIT_L(0); MMA(1, 0, At, B0); BAR; SCHED;
    STB(SBB(0, 1), bcol + GHALF, t + 2);
    WAIT_V(6); BAR; MMA(1, 1, At, B1); BAR;
    LDB(B0, 1, 0); SCHED; LDA(At, 1, 0); STA(SAB(0, 1), brow + GHALF, t + 2);
    WAIT_L(8); BAR; WAIT_L(0); MMA(0, 0, At, B0); BAR; SCHED;
    LDB(B1, 1, 1); STB(SBB(1, 0), bcol, t + 3);
    BAR; WAIT_L(0); MMA(0, 1, At, B1); BAR;
    LDA(At, 1, 1); STA(SAB(1, 0), brow, t + 3);
    BAR; WAIT_L(0); MMA(1, 0, At, B0); BAR; SCHED;
    STB(SBB(1, 1), bcol + GHALF, t + 3);
    WAIT_V(6); BAR; MMA(1, 1, At, B1); BAR;
  }
  {
    LDB(B0, 0, 0); LDA(At, 0, 0); STA(SAB(1, 1), brow + GHALF, nt - 1);
    BAR; WAIT_L(0); MMA(0, 0, At, B0); BAR;
    LDB(B1, 0, 1); BAR; WAIT_L(0); MMA(0, 1, At, B1); BAR;
    LDA(At, 0, 1); WAIT_V(4); BAR; WAIT_L(0); MMA(1, 0, At, B0); MMA(1, 1, At, B1); BAR;
  }
  {
    LDB(B0, 1, 0); LDA(At, 1, 0); WAIT_V(2); BAR; WAIT_L(0); MMA(0, 0, At, B0); BAR;
    LDB(B1, 1, 1); WAIT_V(0); BAR; WAIT_L(0); MMA(0, 1, At, B1); BAR;
    LDA(At, 1, 1); BAR; WAIT_L(0); MMA(1, 0, At, B0); MMA(1, 1, At, B1); BAR;
  }
  if (wr == 0) BAR;
  if (!RMS && more) { PROLOGUE(nbrow, nbcol); }
  epi(acc, brow, bcol, wr, wc, fr, fq, rs);
  if (RMS) __syncthreads();
  if (!more) break;
  brow = nbrow; bcol = nbcol;
  }
}

template <bool RMS, class Epi>
DI void gemm256_unit(const bf16_t* __restrict__ A, int lda, const bf16_t* __restrict__ Bt, int ldb, int K, int brow, int bcol,
                bf16_t* shm, Epi& epi) {
  const int tid = otid();
  const int wid = tid >> 6, lane = tid & 63, wr = wid >> 2, wc = wid & 3, fr = lane & 15, fq = lane >> 4;
  float* rs = (float*)((char*)shm + MISC_OFF);
  const int ldst0 = tid * 16;
  const unsigned swave = (unsigned)__builtin_amdgcn_readfirstlane((int)((unsigned)(size_t)(LAS char*)shm + (unsigned)((tid & ~63) * 16)));
  unsigned la0, la1, lb0, lb1;
  {
    int r0_, c0_, r1_, c1_;
    stage_rc(ldst0, r0_, c0_);
    stage_rc(ldst0 + 8192, r1_, c1_);
    la0 = (unsigned)(r0_ * lda + c0_) * 2u; la1 = (unsigned)(r1_ * lda + c1_) * 2u;
    if (Epi::PERM) { r0_ = (r0_ & ~31) | perm32(r0_ & 31); r1_ = (r1_ & ~31) | perm32(r1_ & 31); }
    lb0 = (unsigned)(r0_ * ldb + c0_) * 2u; lb1 = (unsigned)(r1_ * ldb + c1_) * 2u;
  }
  if (RMS) {
    const int row = tid >> 1, half = tid & 1;
    const bf16_t* ap = A + (size_t)(brow + row) * lda + half * 128;
    float ss = 0.f;
#pragma unroll 4
    for (int i = 0; i < 16; ++i) {
      uint4 v = *(const uint4*)(ap + i * 8);
      float f;
      f = bflo(v.x); ss += f * f; f = bfhi(v.x); ss += f * f;
      f = bflo(v.y); ss += f * f; f = bfhi(v.y); ss += f * f;
      f = bflo(v.z); ss += f * f; f = bfhi(v.z); ss += f * f;
      f = bflo(v.w); ss += f * f; f = bfhi(v.w); ss += f * f;
    }
    ss += __shfl_xor(ss, 1);
    if (half == 0) rs[row] = rsqrtf(ss * (1.f / 256.f) + 1e-6f);
    WAIT_V(0);
  }
  acc_t acc;
#pragma unroll
  for (int i0 = 0; i0 < 2; ++i0)
#pragma unroll
    for (int i1 = 0; i1 < 2; ++i1)
#pragma unroll
      for (int i2 = 0; i2 < 4; ++i2)
#pragma unroll
        for (int i3 = 0; i3 < 2; ++i3) acc[i0][i1][i2][i3] = (f32x4){0.f, 0.f, 0.f, 0.f};
  bf16x8 At[4][2], B0[2][2], B1[2][2];
  const int nt = K / GBK;
  STB(SBB(0, 0), bcol, 0); STA(SAB(0, 0), brow, 0);
  STB(SBB(0, 1), bcol + GHALF, 0); STA(SAB(0, 1), brow + GHALF, 0);
  if (wr == 1) BAR;
  WAIT_V(4); BAR;
  STB(SBB(1, 0), bcol, 1); STA(SAB(1, 0), brow, 1); STB(SBB(1, 1), bcol + GHALF, 1);
  WAIT_V(6); BAR;
  for (int t = 0; t < nt - 2; t += 2) {
    LDB(B0, 0, 0); SCHED; LDA(At, 0, 0); STA(SAB(1, 1), brow + GHALF, t + 1);
    WAIT_L(8); BAR; WAIT_L(0); MMA(0, 0, At, B0); BAR; SCHED;
    LDB(B1, 0, 1); STB(SBB(0, 0), bcol, t + 2);
    BAR; WAIT_L(0); MMA(0, 1, At, B1); BAR;
    LDA(At, 0, 1); STA(SAB(0, 0), brow, t + 2);
    BAR; WAIT_L(0); MMA(1, 0, At, B0); BAR; SCHED;
    STB(SBB(0, 1), bcol + GHALF, t + 2);
    WAIT_V(6); BAR; MMA(1, 1, At, B1); BAR;
    LDB(B0, 1, 0); SCHED; LDA(At, 1, 0); STA(SAB(0, 1), brow + GHALF, t + 2);
    WAIT_L(8); BAR; WAIT_L(0); MMA(0, 0, At, B0); BAR; SCHED;
    LDB(B1, 1, 1); STB(SBB(1, 0), bcol, t + 3);
    BAR; WAIT_L(0); MMA(0, 1, At, B1); BAR;
    LDA(At, 1, 1); STA(SAB(1, 0), brow, t + 3);
    BAR; WAIT_L(0); MMA(1, 0, At, B0); BAR; SCHED;
    STB(SBB(1, 1), bcol + GHALF, t + 3);
    WAIT_V(6); BAR; MMA(1, 1, At, B1); BAR;
  }
  {
    LDB(B0, 0, 0); LDA(At, 0, 0); STA(SAB(1, 1), brow + GHALF, nt - 1);
    BAR; WAIT_L(0); MMA(0, 0, At, B0); BAR;
    LDB(B1, 0, 1); BAR; WAIT_L(0); MMA(0, 1, At, B1); BAR;
    LDA(At, 0, 1); WAIT_V(4); BAR; WAIT_L(0); MMA(1, 0, At, B0); MMA(1, 1, At, B1); BAR;
  }
  {
    LDB(B0, 1, 0); LDA(At, 1, 0); WAIT_V(2); BAR; WAIT_L(0); MMA(0, 0, At, B0); BAR;
    LDB(B1, 1, 1); WAIT_V(0); BAR; WAIT_L(0); MMA(0, 1, At, B1); BAR;
    LDA(At, 1, 1); BAR; WAIT_L(0); MMA(1, 0, At, B0); MMA(1, 1, At, B1); BAR;
  }
  if (wr == 0) BAR;
  epi(acc, brow, bcol, wr, wc, fr, fq, rs);
  __syncthreads();
}


DI bool unit_next(int i, int nM, int nN, int& pm, int& pn) {
  const int nwg = nM * nN;
  const long L = (long)i * ogrid() + obid();
  if (L >= nwg) return false;
  int wgid = (int)L;
  {
    const int q = nwg / 8, r = nwg % 8, xcd = wgid % 8, off = wgid / 8;
    wgid = (xcd < r ? xcd * (q + 1) : r * (q + 1) + (xcd - r) * q) + off;
  }
  const int nig = 8 * nN, gid = wgid / nig, fm = gid * 8, gsz = (nM - fm) < 8 ? (nM - fm) : 8;
  pm = fm + ((wgid % nig) % gsz);
  pn = (wgid % nig) / gsz;
  return true;
}

#define EPI_LOOP                                                   \
  _Pragma("unroll") for (int ai = 0; ai < 2; ++ai)                 \
  _Pragma("unroll") for (int m = 0; m < 4; ++m)                    \
  _Pragma("unroll") for (int bj = 0; bj < 2; ++bj)                 \
  _Pragma("unroll") for (int n = 0; n < 2; ++n)
#define EPI_LOOP8                                                  \
  _Pragma("unroll") for (int ai = 0; ai < 2; ++ai)                 \
  _Pragma("unroll") for (int m = 0; m < 4; ++m)                    \
  _Pragma("unroll") for (int bj = 0; bj < 2; ++bj)
struct EpiProj {
  static constexpr bool PERM = true;
  bf16_t* proj; float* rss;
  DI void operator()(const acc_t& acc, int brow, int bcol, int wr, int wc, int fr, int fq, const float* rs) const {
    EPI_LOOP8 {
      const int row = brow + ai * 128 + wr * 64 + m * 16 + fr, col = bcol + bj * 128 + wc * 32 + 8 * fq;
      if (col < NP) {
        const f32x4 v0 = acc[ai][bj][m][0], v1 = acc[ai][bj][m][1];
        uint4 u; u.x = pack2(v0[0], v0[1]); u.y = pack2(v0[2], v0[3]); u.z = pack2(v1[0], v1[1]); u.w = pack2(v1[2], v1[3]);
        *(uint4*)(proj + (size_t)row * NP + col) = u;
      }
    }
    if (bcol + 256 > C_QA && bcol < C_KR) {
#pragma unroll
      for (int ai = 0; ai < 2; ++ai)
#pragma unroll
        for (int m = 0; m < 4; ++m) {
          float sq = 0.f, sk = 0.f;
#pragma unroll
          for (int bj = 0; bj < 2; ++bj) {
            const int col = bcol + bj * 128 + wc * 32 + 8 * fq;
            const f32x4 v0 = acc[ai][bj][m][0], v1 = acc[ai][bj][m][1];
            const float t = v0[0] * v0[0] + v0[1] * v0[1] + v0[2] * v0[2] + v0[3] * v0[3] +
                            v1[0] * v1[0] + v1[1] * v1[1] + v1[2] * v1[2] + v1[3] * v1[3];
            sq += (col >= C_QA && col < C_KVA) ? t : 0.f;
            sk += (col >= C_KVA && col < C_KR) ? t : 0.f;
          }
          sq += __shfl_xor(sq, 16); sq += __shfl_xor(sq, 32);
          sk += __shfl_xor(sk, 16); sk += __shfl_xor(sk, 32);
          if (fq == 0) {
            const int row = brow + ai * 128 + wr * 64 + m * 16 + fr;
            if (sq != 0.f) unsafeAtomicAdd(rss + row, sq);
            if (sk != 0.f) unsafeAtomicAdd(rss + MT + row, sk);
          }
        }
    }
  }
};
struct EpiRelu2 {
  static constexpr bool PERM = true;
  bf16_t* hid;
  DI void operator()(const acc_t& acc, int brow, int bcol, int wr, int wc, int fr, int fq, const float* rs) const {
    EPI_LOOP8 {
      const int row = brow + ai * 128 + wr * 64 + m * 16 + fr, col = bcol + bj * 128 + wc * 32 + 8 * fq;
      const f32x4 v0 = acc[ai][bj][m][0], v1 = acc[ai][bj][m][1];
      const float a0 = fmaxf(v0[0], 0.f), a1 = fmaxf(v0[1], 0.f), a2 = fmaxf(v0[2], 0.f), a3 = fmaxf(v0[3], 0.f);
      const float a4 = fmaxf(v1[0], 0.f), a5 = fmaxf(v1[1], 0.f), a6 = fmaxf(v1[2], 0.f), a7 = fmaxf(v1[3], 0.f);
      uint4 u; u.x = pack2(a0 * a0, a1 * a1); u.y = pack2(a2 * a2, a3 * a3); u.z = pack2(a4 * a4, a5 * a5); u.w = pack2(a6 * a6, a7 * a7);
      *(uint4*)(hid + (size_t)row * DFF + col) = u;
    }
  }
};
struct EpiRes {
  static constexpr bool PERM = true;
  const Params* p; int layer; int gate_off; bool from_input;
  DI void operator()(const acc_t& acc, int brow, int bcol, int wr, int wc, int fr, int fq, const float* rs) const {
    const int b = brow / TT, tb = brow - b * TT;
    const bool isctx = tb >= LSEQ;
    const float* gp = p->mods() + ((size_t)layer * 17 + (isctx ? 16 : b)) * 6144 + gate_off;
    EPI_LOOP {
      const int lr = ai * 128 + wr * 64 + m * 16 + fr, col = bcol + bj * 128 + wc * 32 + 8 * fq + 4 * n;
      const f32x4 v = acc[ai][bj][m][n];
      const float4 g = *(const float4*)(gp + col);
      float* dst = res_row(*p, b, tb + lr) + col;
      const float4 s = from_input ? *(const float4*)(in_row(*p, b, tb + lr) + col) : *(const float4*)dst;
      float4 o; o.x = s.x + g.x * v[0]; o.y = s.y + g.y * v[1]; o.z = s.z + g.z * v[2]; o.w = s.w + g.w * v[3];
      *(float4*)dst = o;
    }
  }
};
struct EpiQ {
  static constexpr bool PERM = true;
  const Params* p;
  DI void operator()(const acc_t& acc, int brow, int bcol, int wr, int wc, int fr, int fq, const float* rs) const {
    float rq[8];
#pragma unroll
    for (int i = 0; i < 8; ++i) rq[i] = rsqrtf(p->rss()[0 + brow + (i >> 2) * 128 + wr * 64 + (i & 3) * 16 + fr] * (1.f / 256.f) + 1e-6f);
    const int b = brow / TT, tb = brow - b * TT;
    EPI_LOOP8 {
      const int lr = ai * 128 + wr * 64 + m * 16 + fr, col = bcol + bj * 128 + wc * 32 + 8 * fq;
      if (col < 576) {
        const int hh = col / 96, d = col - hh * 96;
        const f32x4 v0 = acc[ai][bj][m][0], v1 = acc[ai][bj][m][1];
        const float sc = rq[ai * 4 + m];
        uint4 u; u.x = pack2(v0[0] * sc, v0[1] * sc); u.y = pack2(v0[2] * sc, v0[3] * sc); u.z = pack2(v1[0] * sc, v1[1] * sc); u.w = pack2(v1[2] * sc, v1[3] * sc);
        *(uint4*)(p->Q() + ((size_t)(b * 6 + hh) * TT + tb + lr) * 96 + d) = u;
      }
    }
  }
};
struct EpiKV {
  static constexpr bool PERM = true;
  const Params* p;
  DI void operator()(const acc_t& acc, int brow, int bcol, int wr, int wc, int fr, int fq, const float* rs) const {
    float rq[8];
#pragma unroll
    for (int i = 0; i < 8; ++i) rq[i] = rsqrtf(p->rss()[MT + brow + (i >> 2) * 128 + wr * 64 + (i & 3) * 16 + fr] * (1.f / 256.f) + 1e-6f);
    const int b = brow / TT, tb = brow - b * TT;
    EPI_LOOP8 {
      const int lr = ai * 128 + wr * 64 + m * 16 + fr, col = bcol + bj * 128 + wc * 32 + 8 * fq;
      const int hh = col >> 7, j = col & 127;
      const f32x4 v0 = acc[ai][bj][m][0], v1 = acc[ai][bj][m][1];
      const float sc = rq[ai * 4 + m];
      if (j < 64) {
        uint4 u; u.x = pack2(v0[0] * sc, v0[1] * sc); u.y = pack2(v0[2] * sc, v0[3] * sc); u.z = pack2(v1[0] * sc, v1[1] * sc); u.w = pack2(v1[2] * sc, v1[3] * sc);
        *(uint4*)(p->Kc() + ((size_t)(b * 6 + hh) * TT + tb + lr) * 96 + j) = u;
      } else {
        uint4 u; u.x = pack2(v0[0] * sc, v0[1] * sc); u.y = pack2(v0[2] * sc, v0[3] * sc); u.z = pack2(v1[0] * sc, v1[1] * sc); u.w = pack2(v1[2] * sc, v1[3] * sc);
        *(uint4*)(p->Vt() + ((size_t)(b * 6 + hh) * TT + tb + lr) * 64 + (j - 64)) = u;
      }
    }
  }
};

DI void transpose_tile(const float* __restrict__ W, int N, int k0, int n0, bf16_t* __restrict__ dst, int ldd,
                       int shift_from, int shift_by, const float* rowscale, float gscale, float* tile) {
  const int tid = otid();
  const int lane = tid & 63, wave = tid >> 6;
  float4 v[8];
#pragma unroll
  for (int i = 0; i < 8; ++i) {
    const int k = k0 + wave + 8 * i, n = n0 + lane * 4;
    v[i] = make_float4(0.f, 0.f, 0.f, 0.f);
    if (n < N) {
      v[i] = *(const float4*)(W + (size_t)k * N + n);
      const float sc = (rowscale ? rowscale[k] : 1.f) * gscale;
      v[i].x *= sc; v[i].y *= sc; v[i].z *= sc; v[i].w *= sc;
    }
  }
#pragma unroll
  for (int i = 0; i < 8; ++i) {
    *(float4*)(tile + (wave + 8 * i) * 260 + lane * 4) = v[i];
  }
  __syncthreads();
  {
    const int nn = tid >> 1, kq = (tid & 1) * 32;
    const int n = n0 + nn;
    if (n < N) {
      const int drow = n >= shift_from ? n + shift_by : n;
      bf16_t* dp = dst + (size_t)drow * ldd + k0 + kq;
#pragma unroll
      for (int j = 0; j < 4; ++j) {
        const float* tp = tile + (kq + 8 * j) * 260 + nn;
        uint4 u;
        u.x = pack2(tp[0 * 260], tp[1 * 260]);
        u.y = pack2(tp[2 * 260], tp[3 * 260]);
        u.z = pack2(tp[4 * 260], tp[5 * 260]);
        u.w = pack2(tp[6 * 260], tp[7 * 260]);
        *(uint4*)(dp + 8 * j) = u;
      }
    }
  }
  __syncthreads();
}

DI void transpose_layer(const Params& p, int l, int first, int step, float* tile) {
  const float qscale = 0.10206207261596577f * 1.4426950408889634f;
  for (int v = first; v < 728; v += step) {
    if (v < 144) {
      const int kt = v / 9, nt = v - kt * 9;
      transpose_tile(p.w_in + (size_t)l * 1024 * IN_COLS, IN_COLS, kt * 64, nt * 256, p.wt_in() + (size_t)l * NPW * 1024, 1024, 1292, 52, nullptr, 1.f, tile);
    } else if (v < 192) {
      const int w = v - 144, kt = w >> 2, nt = w & 3;
      transpose_tile(p.w_out + (size_t)l * 1024 * 1024, 1024, kt * 64, nt * 256, p.wt_out() + (size_t)l * 1024 * 1024, 1024, 1 << 30, 0, nullptr, 1.f, tile);
    } else if (v < 448) {
      const int w = v - 192, kt = w >> 4, nt = w & 15;
      transpose_tile(p.w_mlp1 + (size_t)l * 1024 * 4096, 4096, kt * 64, nt * 256, p.wt_m1() + (size_t)l * 4096 * 1024, 1024, 1 << 30, 0, nullptr, 1.f, tile);
    } else if (v < 704) {
      const int w = v - 448, kt = w >> 2, nt = w & 3;
      transpose_tile(p.w_mlp2 + (size_t)l * 4096 * 1024, 1024, kt * 64, nt * 256, p.wt_m2() + (size_t)l * 1024 * 4096, 4096, 1 << 30, 0, nullptr, 1.f, tile);
    } else if (v < 716) {
      const int w = v - 704, kt = w / 3, nt = w - kt * 3;
      transpose_tile(p.w_q_b + (size_t)l * 256 * 576, 576, kt * 64, nt * 256, p.wt_qb() + (size_t)l * NQ * 256, 256, 1 << 30, 0, p.q_a_norm_w + l * 256, qscale, tile);
    } else {
      const int w = v - 716, kt = w / 3, nt = w - kt * 3;
      transpose_tile(p.w_kv_b + (size_t)l * 256 * 768, 768, kt * 64, nt * 256, p.wt_kvb() + (size_t)l * 768 * 256, 256, 1 << 30, 0, p.kv_a_norm_w + l * 256, 1.f, tile);
    }
  }
}

DI void phase_prep(const Params& p, bf16_t* smem) {
  float* tile = (float*)smem;
  const int tid = otid();
  const int gtid = obid() * 512 + tid, gsz = ogrid_op() * 512;
  if (gtid < 16) p.ctr()[gtid] = 0;
  if (gtid < 512) {
    const int pos = gtid >> 3, pair = gtid & 7;
    const float inv = powf(10000.f, -(float)pair / 8.f);
    const float ang = (float)pos * inv;
    p.rope()[gtid * 2] = cosf(ang);
    p.rope()[gtid * 2 + 1] = sinf(ang);
  }
  for (int i = gtid; i < 2 * 212 * 1024; i += gsz) {
    const int l = i / (212 * 1024), rem = i - l * 212 * 1024, rr = rem >> 10, k = rem & 1023;
    const int row = rr < 52 ? 1292 + rr : 2144 + (rr - 52);
    p.wt_in()[((size_t)l * NPW + row) * 1024 + k] = 0;
  }
  for (int i = gtid; i < 2 * 192 * 256; i += gsz) {
    const int l = i / (192 * 256), rem = i - l * 192 * 256;
    p.wt_qb()[(size_t)l * NQ * 256 + 576 * 256 + rem] = 0;
  }
  transpose_layer(p, 0, obid(), ogrid(), tile);
  {
    const int nn = tid & 63, c8 = __builtin_amdgcn_readfirstlane(tid >> 6);
    for (int it = obid(); it < 128; it += ogrid()) {
      const int l = it >> 6, g = (it >> 4) & 3, nblk = it & 15;
      const int n = nblk * 64 + nn;
      const float* wo = p.w_out + (size_t)l * 1024 * 1024 + (size_t)(768 + g * 64) * 1024 + n;
      const float* pw = p.pool_w + ((size_t)l * 4 + g) * 4096 + c8 * 8 * 64;
      const float* ps = p.pool_scale + l * 256 + g * 64;
      float o[8];
#pragma unroll
      for (int e = 0; e < 8; ++e) o[e] = 0.f;
#pragma unroll 8
      for (int d = 0; d < 64; ++d) {
        const float wv = wo[(size_t)d * 1024] * ps[d];
#pragma unroll
        for (int e = 0; e < 8; ++e) o[e] += pw[e * 64 + d] * wv;
      }
      uint4 u;
      u.x = pack2(o[0], o[1]); u.y = pack2(o[2], o[3]); u.z = pack2(o[4], o[5]); u.w = pack2(o[6], o[7]);
      *(uint4*)(p.wt_out() + (size_t)l * 1024 * 1024 + (size_t)n * 1024 + 768 + g * 64 + c8 * 8) = u;
    }
  }
  {
    float* sc = (float*)smem;
    const int lane = tid & 63, wave = tid >> 6;
    bool loaded = false;
    for (int it = ogrid() - 1 - obid(); it < 192; it += ogrid()) {
      const int l = it / 96, cb = it - l * 96;
      if (!loaded) {
        for (int i = tid; i < 17 * 1024; i += 512) {
          const int ci = i >> 10, k = i & 1023;
          const float v = ci < 16 ? p.c[ci * 1024 + k] : p.c_ctx[k];
          sc[i] = silu(v);
        }
        loaded = true;
        __syncthreads();
      }
      float acc[17];
#pragma unroll
      for (int i = 0; i < 17; ++i) acc[i] = 0.f;
      const float* mw = p.mod_w + (size_t)l * 1024 * 6144 + cb * 64 + lane;
      for (int k0 = wave * 128; k0 < wave * 128 + 128; k0 += 16) {
        float wv[16];
#pragma unroll
        for (int j = 0; j < 16; ++j) wv[j] = mw[(size_t)(k0 + j) * 6144];
#pragma unroll
        for (int j = 0; j < 16; ++j)
#pragma unroll
          for (int i = 0; i < 17; ++i) acc[i] += sc[i * 1024 + k0 + j] * wv[j];
      }
      float* sred = (float*)smem + 17 * 1024;
      for (int w = 0; w < 8; ++w) {
        if (wave == w) {
#pragma unroll
          for (int i = 0; i < 17; ++i) {
            if (w == 0) sred[i * 64 + lane] = acc[i];
            else sred[i * 64 + lane] += acc[i];
          }
        }
        __syncthreads();
      }
      for (int i = tid; i < 17 * 64; i += 512) {
        const int ci = i >> 6, cc = i & 63;
        p.mods()[((size_t)l * 17 + ci) * 6144 + cb * 64 + cc] = sred[i] + p.mod_b[l * 6144 + cb * 64 + cc];
      }
      __syncthreads();
    }
  }
}

DI void phase_norm(const Params& p, int layer, int which) {
  const int tid = otid(), lane = tid & 63, wave = tid >> 6;
  if (which == 1) { const int gs_ = ogrid_op() * 512; for (int i = obid() * 512 + tid; i < 2 * MT; i += gs_) p.rss()[i] = 0.f; }
  const float* nwt = (which == 1 ? p.norm1_w : p.norm2_w) + layer * 1024;
  const int chunk = (MT + ogrid() - 1) / ogrid();
  const int r_begin = obid() * chunk, r_end = min(MT, r_begin + chunk);
  float4 fw[4], fs[4];
  int cur_ci = -1;
  for (int r = r_begin + wave; r < r_end; r += 16) {
    const int r2 = r + 8;
    const bool has2 = r2 < r_end;
    const int b = r / TT, t = r - b * TT, b2 = r2 / TT, t2 = r2 - b2 * TT;
    const bool skip1 = t >= LSEQ && layer == 1 && which == 2;
    const bool skip2 = !has2 || (t2 >= LSEQ && layer == 1 && which == 2);
    const float* src1 = (layer == 0 && which == 1) ? in_row(p, b, t) : res_row(p, b, t);
    const float* src2 = (layer == 0 && which == 1) ? in_row(p, has2 ? b2 : b, has2 ? t2 : t) : res_row(p, has2 ? b2 : b, has2 ? t2 : t);
    float4 v1[4], v2[4];
#pragma unroll
    for (int i = 0; i < 4; ++i) {
      v1[i] = *(const float4*)(src1 + i * 256 + lane * 4);
      v2[i] = *(const float4*)(src2 + i * 256 + lane * 4);
    }
#pragma unroll
    for (int half = 0; half < 2; ++half) {
      const bool skip = half ? skip2 : skip1;
      if (skip) continue;
      const int rr = half ? r2 : r, bb = half ? b2 : b, tt = half ? t2 : t;
      const int ci = tt >= LSEQ ? 16 : bb;
      if (ci != cur_ci) {
        cur_ci = ci;
        const float* md = p.mods() + ((size_t)layer * 17 + ci) * 6144 + (which == 1 ? 0 : 3072);
#pragma unroll
        for (int i = 0; i < 4; ++i) {
          const int k = i * 256 + lane * 4;
          const float4 w = *(const float4*)(nwt + k);
          const float4 sc = *(const float4*)(md + 1024 + k);
          fs[i] = *(const float4*)(md + k);
          fw[i] = make_float4(w.x * (1.f + sc.x), w.y * (1.f + sc.y), w.z * (1.f + sc.z), w.w * (1.f + sc.w));
        }
      }
      float ss = 0.f;
#pragma unroll
      for (int i = 0; i < 4; ++i) {
        const float4 v = half ? v2[i] : v1[i];
        ss += v.x * v.x + v.y * v.y + v.z * v.z + v.w * v.w;
      }
      ss = wave_sum(ss);
      const float rstd = rsqrtf(ss * (1.f / 1024.f) + 1e-6f);
#pragma unroll
      for (int i = 0; i < 4; ++i) {
        const float4 v = half ? v2[i] : v1[i];
        uint2 u;
        u.x = pack2(v.x * rstd * fw[i].x + fs[i].x, v.y * rstd * fw[i].y + fs[i].y);
        u.y = pack2(v.z * rstd * fw[i].z + fs[i].z, v.w * rstd * fw[i].w + fs[i].w);
        *(uint2*)(p.xn() + (size_t)rr * DM + i * 256 + lane * 4) = u;
      }
    }
  }
}

DI void phase_final(const Params& p) {
  const int tid = otid(), lane = tid & 63, wave = tid >> 6;
  float4 fw[4];
#pragma unroll
  for (int i = 0; i < 4; ++i) fw[i] = *(const float4*)(p.final_norm_w + i * 256 + lane * 4);
  const int NR = NB * LSEQ;
  for (int r = obid() * 8 + wave; r < NR; r += ogrid() * 16) {
    const int r2 = r + ogrid() * 8;
    const bool has2 = r2 < NR;
    float* row1 = p.out + (size_t)r * DM;
    float* row2 = p.out + (size_t)(has2 ? r2 : r) * DM;
    float4 v1[4], v2[4];
#pragma unroll
    for (int i = 0; i < 4; ++i) {
      v1[i] = *(const float4*)(row1 + i * 256 + lane * 4);
      v2[i] = *(const float4*)(row2 + i * 256 + lane * 4);
    }
#pragma unroll
    for (int half = 0; half < 2; ++half) {
      if (half && !has2) continue;
      float* row = half ? row2 : row1;
      float ss = 0.f;
#pragma unroll
      for (int i = 0; i < 4; ++i) {
        const float4 v = half ? v2[i] : v1[i];
        ss += v.x * v.x + v.y * v.y + v.z * v.z + v.w * v.w;
      }
      ss = wave_sum(ss);
      const float rstd = rsqrtf(ss * (1.f / 1024.f) + 1e-6f);
#pragma unroll
      for (int i = 0; i < 4; ++i) {
        const float4 v = half ? v2[i] : v1[i];
        float4 o;
        o.x = v.x * rstd * fw[i].x; o.y = v.y * rstd * fw[i].y; o.z = v.z * rstd * fw[i].z; o.w = v.w * rstd * fw[i].w;
        *(float4*)(row + i * 256 + lane * 4) = o;
      }
    }
  }
}

DI int map_mtile(int skip_ctx, int i) { return skip_ctx ? (i >> 4) * 17 + (i & 15) : i; }

struct UnitOrder {
  int nM, nN, skip;
  DI bool operator()(int i, int& br, int& bc) const {
    int pm, pn;
    if (!unit_next(i, nM, nN, pm, pn)) return false;
    br = map_mtile(skip, pm) * 256;
    bc = pn * 256;
    return true;
  }
};
DI void phase_gemm_in(const Params& p, int layer, bf16_t* smem) {
  EpiProj epi{p.proj(), p.rss()};
  gemm256<false>(p.xn(), DM, p.wt_in() + (size_t)layer * NPW * 1024, 1024, 1024, smem, epi, UnitOrder{MT / 256, NPW / 256, 0});
}
DI void phase_gemm_qkv(const Params& p, int layer, bf16_t* smem) {
  EpiQ epq{&p};
  EpiKV epk{&p};
  int pm, pn;
  for (int i = 0; unit_next(i, MT / 256, 6, pm, pn); ++i) {
    if (pn < 3) gemm256_unit<false>(p.proj() + C_QA, NP, p.wt_qb() + (size_t)layer * NQ * 256, 256, 256, pm * 256, pn * 256, smem, epq);
    else gemm256_unit<false>(p.proj() + C_KVA, NP, p.wt_kvb() + (size_t)layer * 768 * 256, 256, 256, pm * 256, (pn - 3) * 256, smem, epk);
  }
}
DI void phase_gemm_out(const Params& p, int layer, bf16_t* smem) {
  EpiRes epi{&p, layer, 2048, layer == 0};
  const int skip = layer == 1;
  gemm256<false>(p.xn(), DM, p.wt_out() + (size_t)layer * 1024 * 1024, 1024, 1024, smem, epi, UnitOrder{skip ? NB * 16 : MT / 256, 4, skip});
}
DI void phase_gemm_m1(const Params& p, int layer, bf16_t* smem) {
  EpiRelu2 epi{p.hidden()};
  const int skip = layer == 1;
  gemm256<false>(p.xn(), DM, p.wt_m1() + (size_t)layer * 4096 * 1024, 1024, 1024, smem, epi, UnitOrder{skip ? NB * 16 : MT / 256, 16, skip});
}
DI void phase_gemm_m2(const Params& p, int layer, bf16_t* smem) {
  EpiRes epi{&p, layer, 5120, false};
  const int skip = layer == 1;
  gemm256<false>(p.hidden(), DFF, p.wt_m2() + (size_t)layer * 1024 * 4096, 4096, 4096, smem, epi, UnitOrder{skip ? NB * 16 : MT / 256, 4, skip});
}

DI void phase_tokops(const Params& p, int layer) {
  const int tid = otid();
  const int gtid = obid() * 512 + tid, gsz = ogrid_op() * 512;
  {
    const int nrt = gsz / 112;
    if (gtid < nrt * 112) {
      const int cg8 = (gtid % 112) * 8;
      const float* cw = p.conv_w + (size_t)layer * 4 * 896 + cg8;
      const float* cbp = p.conv_b + layer * 896 + cg8;
      float w[4][8], bias[8];
#pragma unroll
      for (int j = 0; j < 4; ++j)
#pragma unroll
        for (int e = 0; e < 8; ++e) w[j][e] = cw[j * 896 + e];
#pragma unroll
      for (int e = 0; e < 8; ++e) bias[e] = cbp[e];
      for (int run = gtid / 112; run < MT / 8; run += nrt) {
        const int r0 = run * 8;
        const int b = r0 / TT, tb = r0 - b * TT;
        const int seg_lo = tb < LSEQ ? 0 : LSEQ, seg_hi = tb < LSEQ ? LSEQ : TT;
        uint4 raw[11];
#pragma unroll
        for (int i = 0; i < 11; ++i) {
          const int tt = tb - 1 + i;
          if (tt >= seg_lo && tt < seg_hi) raw[i] = *(const uint4*)(p.proj() + ((size_t)b * TT + tt) * NP + C_XBC + cg8);
          else raw[i] = make_uint4(0, 0, 0, 0);
        }
#pragma unroll
        for (int o = 0; o < 8; ++o) {
          float a[8];
#pragma unroll
          for (int e = 0; e < 8; ++e) a[e] = bias[e];
#pragma unroll
          for (int j = 0; j < 4; ++j) {
            const uint4 u = raw[o + j];
            a[0] += w[j][0] * bflo(u.x); a[1] += w[j][1] * bfhi(u.x);
            a[2] += w[j][2] * bflo(u.y); a[3] += w[j][3] * bfhi(u.y);
            a[4] += w[j][4] * bflo(u.z); a[5] += w[j][5] * bfhi(u.z);
            a[6] += w[j][6] * bflo(u.w); a[7] += w[j][7] * bfhi(u.w);
          }
          uint4 ov;
          ov.x = pack2(silu(a[0]), silu(a[1])); ov.y = pack2(silu(a[2]), silu(a[3]));
          ov.z = pack2(silu(a[4]), silu(a[5])); ov.w = pack2(silu(a[6]), silu(a[7]));
          *(uint4*)(p.xbc() + ((size_t)b * TT + tb + o) * 896 + cg8) = ov;
        }
      }
    }
  }
  for (int idx = gtid; idx < MT * 2; idx += gsz) {
    const int r = idx >> 1, axis = idx & 1;
    const int b = r / TT, t = r - b * TT;
    const bf16_t* src = p.proj() + (size_t)r * NP + C_KR + axis * 16;
    const uint4 u1 = *(const uint4*)src, u2 = *(const uint4*)(src + 8);
    uint4 o1 = u1, o2 = u2;
    if (t < LSEQ) {
      const int pos = axis ? (t & 63) : (t >> 6);
      const float4* rp = (const float4*)(p.rope() + pos * 16);
      const float4 c0 = rp[0], c1 = rp[1], c2 = rp[2], c3 = rp[3];
      o1.x = pack2(bflo(u1.x) * c0.x - bflo(u2.x) * c0.y, bfhi(u1.x) * c0.z - bfhi(u2.x) * c0.w);
      o1.y = pack2(bflo(u1.y) * c1.x - bflo(u2.y) * c1.y, bfhi(u1.y) * c1.z - bfhi(u2.y) * c1.w);
      o1.z = pack2(bflo(u1.z) * c2.x - bflo(u2.z) * c2.y, bfhi(u1.z) * c2.z - bfhi(u2.z) * c2.w);
      o1.w = pack2(bflo(u1.w) * c3.x - bflo(u2.w) * c3.y, bfhi(u1.w) * c3.z - bfhi(u2.w) * c3.w);
      o2.x = pack2(bflo(u2.x) * c0.x + bflo(u1.x) * c0.y, bfhi(u2.x) * c0.z + bfhi(u1.x) * c0.w);
      o2.y = pack2(bflo(u2.y) * c1.x + bflo(u1.y) * c1.y, bfhi(u2.y) * c1.z + bfhi(u1.y) * c1.w);
      o2.z = pack2(bflo(u2.z) * c2.x + bflo(u1.z) * c2.y, bfhi(u2.z) * c2.z + bfhi(u1.z) * c2.w);
      o2.w = pack2(bflo(u2.w) * c3.x + bflo(u1.w) * c3.y, bfhi(u2.w) * c3.z + bfhi(u1.w) * c3.w);
    }
#pragma unroll
    for (int hh = 0; hh < 6; ++hh) {
      bf16_t* dst = p.Kc() + ((size_t)(b * 6 + hh) * TT + t) * 96 + 64 + axis * 16;
      *(uint4*)dst = o1;
      *(uint4*)(dst + 8) = o2;
    }
  }
  for (int idx = gtid; idx < (MT / 8) * 32; idx += gsz) {
    const int run = idx >> 5, cgp = idx & 31;
    const int r0 = run * 8;
    const int b = r0 / TT, t0 = r0 - b * TT;
    const int seg_lo = t0 < LSEQ ? 0 : LSEQ, seg_hi = t0 < LSEQ ? LSEQ : TT;
    const int g = cgp >> 3, half = 1 << g;
    const bf16_t* base = p.proj() + (size_t)b * TT * NP + C_POOL + cgp * 8;
    float a[8];
#pragma unroll
    for (int e = 0; e < 8; ++e) a[e] = 0.f;
    for (int tt = max(t0 - half, seg_lo); tt < min(t0 + half, seg_hi); ++tt) {
      const uint4 u = *(const uint4*)(base + (size_t)tt * NP);
      a[0] += bflo(u.x); a[1] += bfhi(u.x); a[2] += bflo(u.y); a[3] += bfhi(u.y);
      a[4] += bflo(u.z); a[5] += bfhi(u.z); a[6] += bflo(u.w); a[7] += bfhi(u.w);
    }
#pragma unroll
    for (int o = 0; o < 8; ++o) {
      const int t = t0 + o;
      const int lo = max(t - half, seg_lo), hi = min(t + half, seg_hi);
      const float inv = 1.f / (float)(hi - lo);
      const uint4 u = *(const uint4*)(base + (size_t)t * NP);
      uint4 ov;
      ov.x = pack2(a[0] * inv - bflo(u.x), a[1] * inv - bfhi(u.x));
      ov.y = pack2(a[2] * inv - bflo(u.y), a[3] * inv - bfhi(u.y));
      ov.z = pack2(a[4] * inv - bflo(u.z), a[5] * inv - bfhi(u.z));
      ov.w = pack2(a[6] * inv - bflo(u.w), a[7] * inv - bfhi(u.w));
      *(uint4*)(p.xn() + ((size_t)b * TT + t) * DM + 768 + cgp * 8) = ov;
      if (o < 7) {
        const int tin = t + half, tout = t - half;
        if (tin < seg_hi) {
          const uint4 w = *(const uint4*)(base + (size_t)tin * NP);
          a[0] += bflo(w.x); a[1] += bfhi(w.x); a[2] += bflo(w.y); a[3] += bfhi(w.y);
          a[4] += bflo(w.z); a[5] += bfhi(w.z); a[6] += bflo(w.w); a[7] += bfhi(w.w);
        }
        if (tout >= seg_lo) {
          const uint4 w = *(const uint4*)(base + (size_t)tout * NP);
          a[0] -= bflo(w.x); a[1] -= bfhi(w.x); a[2] -= bflo(w.y); a[3] -= bfhi(w.y);
          a[4] -= bflo(w.z); a[5] -= bfhi(w.z); a[6] -= bflo(w.w); a[7] -= bfhi(w.w);
        }
      }
    }
  }
}

typedef short s16x4 __attribute__((ext_vector_type(4)));
DI s16x4 tr4(const bf16_t* M, int LD, int krow, int ccol, int lane) {
  const int q = (lane & 15) >> 2, pp = lane & 3, blk = (lane >> 4) & 1;
  return __builtin_amdgcn_ds_read_tr16_b64_v4i16((LAS s16x4*)(LAS bf16_t*)(M + (krow + q) * LD + ccol + 16 * blk + 4 * pp));
}
DI bf16x8 cat8(s16x4 lo, s16x4 hi) { return __builtin_shufflevector(lo, hi, 0, 1, 2, 3, 4, 5, 6, 7); }

DI void ssd_store_x(bf16_t* sX, bf16_t* sXw, int row, int xch, uint4 g, float wl) {
  *(uint4*)(sX + row * 72 + xch) = g;
  uint4 u;
  u.x = pack2(bflo(g.x) * wl, bfhi(g.x) * wl);
  u.y = pack2(bflo(g.y) * wl, bfhi(g.y) * wl);
  u.z = pack2(bflo(g.z) * wl, bfhi(g.z) * wl);
  u.w = pack2(bflo(g.w) * wl, bfhi(g.w) * wl);
  *(uint4*)(sXw + row * 72 + xch) = u;
}
DI void ssd_job(const Params& p, int layer, int jobpair, bf16_t* smem_blk) {
  const int tid_full = otid(), jh = tid_full >> 8, tid = tid_full & 255;
  const int lane = tid & 63, wave = tid >> 6, r = lane & 31, h = lane >> 5;
  const int job = jobpair * 2 + jh;
  bf16_t* smem = smem_blk + jh * SSD_LDS_EL;
  const int b = job / 12, dir = (job / 6) & 1, head = job % 6, grp = head / 3;
  bf16_t* sB = smem;
  bf16_t* sC = sB + 64 * 136;
  bf16_t* sX = sC + 64 * 136;
  bf16_t* sXw = sX + 64 * 72;
  bf16_t* sH = sXw + 64 * 72;
  float* sfl = (float*)(sH + 64 * 136);
  const float a = -__expf(p.a_log[layer * 12 + dir * 6 + head]);
  const float dtb = p.dt_bias[layer * 12 + dir * 6 + head];
  for (int i = tid; i < 64 * 136 / 2; i += 256) ((unsigned*)sH)[i] = 0u;
  f32x16 hacc[2];
  hacc[0] = zero16();
  hacc[1] = zero16();
  const int pt = wave >> 1, lt = wave & 1;
  const int lidx = lt * 32 + r;
  const int brow_ = tid >> 4, bch = (tid & 15) * 8;
  const int xrow_ = tid >> 3, xch = (tid & 7) * 8;
  uint4 gB0, gB1, gB2, gB3, gC0, gC1, gC2, gC3, gX0, gX1;
  float dtraw = 0.f;
#define SSD_LOAD(it_)                                                                                  \
  do {                                                                                                 \
    const int sc_ = dir == 0 ? ((it_) < 4 ? 64 + (it_) : (it_) - 4) : 67 - (it_);                      \
    const bf16_t* base_ = p.xbc() + ((size_t)b * TT + sc_ * 64) * 896;                                 \
    if (wave == 0) {                                                                                   \
      const int tok_ = dir == 0 ? lane : 63 - lane;                                                    \
      dtraw = bf2f(p.proj()[((size_t)b * TT + sc_ * 64 + tok_) * NP + C_DT + dir * 6 + head]);         \
    }                                                                                                  \
    const bf16_t* bp_ = base_ + (size_t)brow_ * 896 + 384 + grp * 128 + bch;                            \
    gB0 = *(const uint4*)(bp_); gB1 = *(const uint4*)(bp_ + 16 * 896);                                  \
    gB2 = *(const uint4*)(bp_ + 32 * 896); gB3 = *(const uint4*)(bp_ + 48 * 896);                       \
    gC0 = *(const uint4*)(bp_ + 256); gC1 = *(const uint4*)(bp_ + 16 * 896 + 256);                      \
    gC2 = *(const uint4*)(bp_ + 32 * 896 + 256); gC3 = *(const uint4*)(bp_ + 48 * 896 + 256);           \
    const bf16_t* xp_ = base_ + (size_t)xrow_ * 896 + head * 64 + xch;                                  \
    gX0 = *(const uint4*)(xp_); gX1 = *(const uint4*)(xp_ + 32 * 896);                                  \
  } while (0)
#define SSD_SCAN(par_)                                                                                 \
  do {                                                                                                 \
    float* fl_ = sfl + (par_) * 200;                                                                   \
    const int tok = dir == 0 ? lane : 63 - lane;                                                       \
    const float xx = dtraw + dtb;                                                                      \
    const float dt = xx > 20.f ? xx : __logf(1.f + __expf(xx));                                        \
    float cs = dt * a;                                                                                 \
    _Pragma("unroll") for (int off = 1; off < 64; off <<= 1) {                                         \
      const float o_ = __shfl_up(cs, off);                                                             \
      if (lane >= off) cs += o_;                                                                       \
    }                                                                                                  \
    const float tot = __shfl(cs, 63);                                                                  \
    fl_[tok] = dt;                                                                                     \
    fl_[64 + tok] = cs;                                                                                \
    fl_[128 + tok] = dt * __expf(tot - cs);                                                            \
    if (lane == 0) fl_[192] = tot;                                                                     \
  } while (0)
  SSD_LOAD(0);
  if (wave == 0) SSD_SCAN(0);
  __syncthreads();
  for (int it = 0; it < 68; ++it) {
    const int sc = dir == 0 ? (it < 4 ? 64 + it : it - 4) : 67 - it;
    const size_t r0 = (size_t)b * TT + sc * 64;
    const float* fl = sfl + (it & 1) * 200;
    const float* sdt = fl;
    const float* scs = fl + 64;
    const float* sw = fl + 128;
    *(uint4*)(sB + (brow_ + 0) * 136 + bch) = gB0;  *(uint4*)(sC + (brow_ + 0) * 136 + bch) = gC0;
    *(uint4*)(sB + (brow_ + 16) * 136 + bch) = gB1; *(uint4*)(sC + (brow_ + 16) * 136 + bch) = gC1;
    *(uint4*)(sB + (brow_ + 32) * 136 + bch) = gB2; *(uint4*)(sC + (brow_ + 32) * 136 + bch) = gC2;
    *(uint4*)(sB + (brow_ + 48) * 136 + bch) = gB3; *(uint4*)(sC + (brow_ + 48) * 136 + bch) = gC3;
    ssd_store_x(sX, sXw, xrow_, xch, gX0, sw[xrow_]);
    ssd_store_x(sX, sXw, xrow_ + 32, xch, gX1, sw[xrow_ + 32]);
    { const int itn = it + 1 < 68 ? it + 1 : 67; SSD_LOAD(itn); }
    __syncthreads();
    bf16x8 creg[8];
#pragma unroll
    for (int ks = 0; ks < 8; ++ks) creg[ks] = *(const bf16x8*)(sC + lidx * 136 + ks * 16 + h * 8);
    f32x16 yacc = zero16();
    const float csl = scs[lidx];
#pragma unroll
    for (int st = 0; st < 2; ++st) {
      const bool skip = dir == 0 ? (st > lt) : (st < lt);
      if (!skip) {
        bf16x8 bf_[8];
#pragma unroll
        for (int ks = 0; ks < 8; ++ks) bf_[ks] = *(const bf16x8*)(sB + (st * 32 + r) * 136 + ks * 16 + h * 8);
        const s16x4 x0 = tr4(sX, 72, st * 32 + 4 * h, pt * 32, lane), x1 = tr4(sX, 72, st * 32 + 8 + 4 * h, pt * 32, lane);
        const s16x4 x2 = tr4(sX, 72, st * 32 + 16 + 4 * h, pt * 32, lane), x3 = tr4(sX, 72, st * 32 + 24 + 4 * h, pt * 32, lane);
        __builtin_amdgcn_sched_barrier(0);
        f32x16 sv = zero16();
#pragma unroll
        for (int ks = 0; ks < 8; ++ks) sv = MFMA(bf_[ks], creg[ks], sv);
#pragma unroll
        for (int g = 0; g < 4; ++g) {
          const float4 c4 = *(const float4*)(scs + st * 32 + 8 * g + 4 * h);
          const float4 d4 = *(const float4*)(sdt + st * 32 + 8 * g + 4 * h);
          const float cc[4] = {c4.x, c4.y, c4.z, c4.w};
          const float dd[4] = {d4.x, d4.y, d4.z, d4.w};
#pragma unroll
          for (int e = 0; e < 4; ++e) {
            const int sidx = st * 32 + 8 * g + 4 * h + e;
            const bool valid = dir == 0 ? (sidx <= lidx) : (sidx >= lidx);
            const float arg = valid ? (csl - cc[e]) : 0.f;
            const float dec = valid ? __expf(arg) * dd[e] : 0.f;
            sv[4 * g + e] *= dec;
          }
        }
        yacc = MFMA(cat8(x0, x1), pack8(sv, 0), yacc);
        yacc = MFMA(cat8(x2, x3), pack8(sv, 1), yacc);
      }
    }
    {
      bf16x8 hf_[8];
#pragma unroll
      for (int ks = 0; ks < 8; ++ks) hf_[ks] = *(const bf16x8*)(sH + (pt * 32 + r) * 136 + ks * 16 + h * 8);
      __builtin_amdgcn_sched_barrier(0);
      f32x16 yo = zero16();
#pragma unroll
      for (int ks = 0; ks < 8; ++ks) yo = MFMA(hf_[ks], creg[ks], yo);
      const float el = __expf(csl);
#pragma unroll
      for (int i = 0; i < 16; ++i) yacc[i] += el * yo[i];
    }
    {
      bf16_t* yout = p.yssd() + ((size_t)dir * MT + r0 + lidx) * 384 + head * 64 + pt * 32 + 4 * h;
#pragma unroll
      for (int g = 0; g < 4; ++g) {
        uint2 u;
        u.x = pack2(yacc[4 * g + 0], yacc[4 * g + 1]);
        u.y = pack2(yacc[4 * g + 2], yacc[4 * g + 3]);
        *(uint2*)(yout + 8 * g) = u;
      }
    }
    {
      const float et = __expf(fl[192]);
#pragma unroll
      for (int q = 0; q < 2; ++q)
#pragma unroll
        for (int i = 0; i < 16; ++i) hacc[q][i] *= et;
#pragma unroll
      for (int half = 0; half < 2; ++half) {
        bf16x8 av_[2], bv_[2][2];
#pragma unroll
        for (int k2 = 0; k2 < 2; ++k2) {
          const int ks = half * 2 + k2;
          av_[k2] = cat8(tr4(sXw, 72, ks * 16 + 8 * h, pt * 32, lane), tr4(sXw, 72, ks * 16 + 8 * h + 4, pt * 32, lane));
#pragma unroll
          for (int q = 0; q < 2; ++q) {
            const int nt = (wave & 1) * 2 + q;
            bv_[q][k2] = cat8(tr4(sB, 136, ks * 16 + 8 * h, nt * 32, lane), tr4(sB, 136, ks * 16 + 8 * h + 4, nt * 32, lane));
          }
        }
        __builtin_amdgcn_sched_barrier(0);
#pragma unroll
        for (int k2 = 0; k2 < 2; ++k2)
#pragma unroll
          for (int q = 0; q < 2; ++q) hacc[q] = MFMA(av_[k2], bv_[q][k2], hacc[q]);
        __builtin_amdgcn_sched_barrier(0);
      }
    }
    if (wave == 0 && it + 1 < 68) SSD_SCAN((it + 1) & 1);
    __syncthreads();
#pragma unroll
    for (int q = 0; q < 2; ++q) {
      const int nt = (wave & 1) * 2 + q;
#pragma unroll
      for (int reg = 0; reg < 16; ++reg) sH[(pt * 32 + crow(reg, h)) * 136 + nt * 32 + r] = f2bf(hacc[q][reg]);
    }
  }
#undef SSD_SCAN
#undef SSD_LOAD
  asm volatile("s_waitcnt vmcnt(0)" ::: "memory");
  __syncthreads();
  if (tid_full == 0) {
    __builtin_amdgcn_fence(__ATOMIC_RELEASE, "agent");
    asm volatile("s_waitcnt vmcnt(0)" ::: "memory");
    xb_add(p.bar() + 3700 + layer * 16 + b, 2u);
  }
  __syncthreads();
}

DI unsigned rope_word(unsigned mine, unsigned other, float4 cs, int h) {
  const float m0 = bflo(mine), m1 = bfhi(mine), o0 = bflo(other), o1 = bfhi(other);
  const float r0 = h ? (m0 * cs.x + o0 * cs.y) : (m0 * cs.x - o0 * cs.y);
  const float r1 = h ? (m1 * cs.z + o1 * cs.w) : (m1 * cs.z - o1 * cs.w);
  return pack2(r0, r1);
}
DI void attn_item(const Params& p, int b, int hh, int q0, int k_begin, int nkt, bf16_t* smem) {
  const int tid = otid(), lane = tid & 63, wave = tid >> 6, r = lane & 31, h = lane >> 5;
  const bf16_t* Kg = p.Kc() + ((size_t)(b * 6 + hh) * TT + k_begin) * 96;
  const bf16_t* Vg = p.Vt() + ((size_t)(b * 6 + hh) * TT + k_begin) * 64;
  const int qrow = q0 + wave * 32 + r;
  bf16x8 qreg[6];
  {
    const bf16_t* qp = p.Q() + ((size_t)(b * 6 + hh) * TT + qrow) * 96 + h * 8;
#pragma unroll
    for (int ks = 0; ks < 6; ++ks) qreg[ks] = *(const bf16x8*)(qp + ks * 16);
  }
  if (q0 < LSEQ) {
#pragma unroll
    for (int ax = 0; ax < 2; ++ax) {
      const int pos = ax ? (qrow & 63) : (qrow >> 6);
      const float* rp = p.rope() + pos * 16;
      const uint4 me = __builtin_bit_cast(uint4, qreg[4 + ax]);
      uint4 rr;
      rr.x = rope_word(me.x, __shfl_xor(me.x, 32), *(const float4*)(rp + 0), h);
      rr.y = rope_word(me.y, __shfl_xor(me.y, 32), *(const float4*)(rp + 4), h);
      rr.z = rope_word(me.z, __shfl_xor(me.z, 32), *(const float4*)(rp + 8), h);
      rr.w = rope_word(me.w, __shfl_xor(me.w, 32), *(const float4*)(rp + 12), h);
      qreg[4 + ax] = __builtin_bit_cast(bf16x8, rr);
    }
  }
  bf16_t* sK = smem;
  bf16_t* sV = smem + 2 * 64 * 104;
  uint4 rk0, rk1 = make_uint4(0u, 0u, 0u, 0u), rv;
  const int vrow = tid >> 3, vch = (tid & 7) * 8;
  const int kc1 = tid + 512;
  const int krow0 = tid / 12, kch0 = tid - krow0 * 12, krow1 = kc1 / 12, kch1 = kc1 - krow1 * 12;
#define K_LOAD(t_)                                                         \
  do {                                                                     \
    const bf16_t* kg_ = Kg + (size_t)(t_) * 64 * 96;                       \
    rk0 = *(const uint4*)(kg_ + (size_t)tid * 8);                          \
    if (tid < 256) rk1 = *(const uint4*)(kg_ + (size_t)kc1 * 8);           \
  } while (0)
#define K_STORE(buf_)                                                                      \
  do {                                                                                     \
    *(uint4*)(sK + ((buf_) * 64 + krow0) * 104 + kch0 * 8) = rk0;                          \
    if (tid < 256) *(uint4*)(sK + ((buf_) * 64 + krow1) * 104 + kch1 * 8) = rk1;           \
  } while (0)
#define V_LOAD(t_) rv = *(const uint4*)(Vg + (size_t)(t_) * 64 * 64 + (size_t)tid * 8)
#define V_STORE(buf_)                                                                      \
  do {                                                                                     \
    *(uint4*)(sV + ((buf_) * 64 + vrow) * 72 + vch) = rv;                                  \
  } while (0)
#define S_TILE(dst, buf_)                                                                                      \
  do {                                                                                                         \
    bf16x8 kf_[6];                                                                                             \
    const bf16_t* kb_ = sK + ((buf_) * 64 + r) * 104 + h * 8;                                                  \
    _Pragma("unroll") for (int ks = 0; ks < 6; ++ks) kf_[ks] = *(const bf16x8*)(kb_ + ks * 16);                \
    __builtin_amdgcn_sched_barrier(0);                                                                         \
    dst[0] = zero16();                                                                                         \
    _Pragma("unroll") for (int ks = 0; ks < 6; ++ks) dst[0] = MFMA(kf_[ks], qreg[ks], dst[0]);                 \
    __builtin_amdgcn_sched_barrier(0);                                                                         \
    _Pragma("unroll") for (int ks = 0; ks < 6; ++ks) kf_[ks] = *(const bf16x8*)(kb_ + 32 * 104 + ks * 16);     \
    __builtin_amdgcn_sched_barrier(0);                                                                         \
    dst[1] = zero16();                                                                                         \
    _Pragma("unroll") for (int ks = 0; ks < 6; ++ks) dst[1] = MFMA(kf_[ks], qreg[ks], dst[1]);                 \
    __builtin_amdgcn_sched_barrier(0);                                                                         \
  } while (0)
  K_LOAD(0); V_LOAD(0);
  K_STORE(0); V_STORE(0);
  if (nkt > 1) { K_LOAD(1); K_STORE(1); }
  __syncthreads();
  f32x16 o[2], o2, sc[2], negm;
  o[0] = zero16();
  o[1] = zero16();
  o2 = zero16();
  negm = zero16();
  bf16x8 ones;
  {
    const unsigned w = r == 0 ? 0x3F803F80u : 0u;
    uint4 u; u.x = w; u.y = w; u.z = w; u.w = w;
    ones = __builtin_bit_cast(bf16x8, u);
  }
#define S_CHAIN(dst, buf_)                                                                                 \
  do {                                                                                                     \
    bf16x8 kf_[6];                                                                                         \
    const bf16_t* kb_ = sK + ((buf_) * 64 + r) * 104 + h * 8;                                              \
    _Pragma("unroll") for (int ks = 0; ks < 6; ++ks) kf_[ks] = *(const bf16x8*)(kb_ + ks * 16);            \
    __builtin_amdgcn_sched_barrier(0);                                                                     \
    dst[0] = negm;                                                                                         \
    __builtin_amdgcn_s_setprio(1);                                                                         \
    _Pragma("unroll") for (int ks = 0; ks < 6; ++ks) dst[0] = MFMA(kf_[ks], qreg[ks], dst[0]);             \
    __builtin_amdgcn_s_setprio(0);                                                                         \
    __builtin_amdgcn_sched_barrier(0);                                                                     \
    _Pragma("unroll") for (int ks = 0; ks < 6; ++ks) kf_[ks] = *(const bf16x8*)(kb_ + 32 * 104 + ks * 16); \
    __builtin_amdgcn_sched_barrier(0);                                                                     \
    dst[1] = negm;                                                                                         \
    __builtin_amdgcn_s_setprio(1);                                                                         \
    _Pragma("unroll") for (int ks = 0; ks < 6; ++ks) dst[1] = MFMA(kf_[ks], qreg[ks], dst[1]);             \
    __builtin_amdgcn_s_setprio(0);                                                                         \
    __builtin_amdgcn_sched_barrier(0);                                                                     \
  } while (0)
#define ATT_STEP(sc_, sn_, kt_)                                                                            \
  do {                                                                                                     \
    const int buf = (kt_) & 1;                                                                             \
    if ((kt_) + 2 < nkt) K_LOAD((kt_) + 2);                                                                \
    if ((kt_) + 1 < nkt) { V_LOAD((kt_) + 1); S_CHAIN(sn_, buf ^ 1); }                                     \
    bf16x8 vf_[8];                                                                                         \
    _Pragma("unroll") for (int mt = 0; mt < 2; ++mt)                                                       \
    _Pragma("unroll") for (int s2 = 0; s2 < 2; ++s2)                                                       \
    _Pragma("unroll") for (int dt = 0; dt < 2; ++dt) {                                                     \
      const bf16_t* vt_ = sV + buf * 64 * 72;                                                              \
      vf_[(mt * 2 + s2) * 2 + dt] = cat8(tr4(vt_, 72, mt * 32 + 16 * s2 + 4 * h, dt * 32, lane),           \
                                         tr4(vt_, 72, mt * 32 + 16 * s2 + 8 + 4 * h, dt * 32, lane));      \
    }                                                                                                      \
    __builtin_amdgcn_sched_barrier(0);                                                                     \
    float mx = sc_[0][0];                                                                                  \
    _Pragma("unroll") for (int i = 1; i < 16; ++i) mx = fmaxf(mx, sc_[0][i]);                              \
    _Pragma("unroll") for (int i = 0; i < 16; ++i) mx = fmaxf(mx, sc_[1][i]);                              \
    mx = fmaxf(mx, __shfl_xor(mx, 32));                                                                    \
    if ((kt_) == 0 || __builtin_amdgcn_ballot_w64(mx > 8.f) != 0ull) {                                     \
      const float delta = ((kt_) == 0 || mx > 8.f) ? mx : 0.f;                                             \
      const float alpha = (kt_) == 0 ? 0.f : __builtin_amdgcn_exp2f(-delta);                               \
      _Pragma("unroll") for (int i = 0; i < 16; ++i) {                                                     \
        o[0][i] *= alpha; o[1][i] *= alpha; o2[i] *= alpha;                                                \
        sc_[0][i] -= delta; sc_[1][i] -= delta; sn_[0][i] -= delta; sn_[1][i] -= delta; negm[i] -= delta;  \
      }                                                                                                    \
    }                                                                                                      \
    _Pragma("unroll") for (int mt = 0; mt < 2; ++mt)                                                       \
    _Pragma("unroll") for (int i = 0; i < 16; ++i) sc_[mt][i] = __builtin_amdgcn_exp2f(sc_[mt][i]);        \
    __builtin_amdgcn_s_setprio(1);                                                                         \
    _Pragma("unroll") for (int mt = 0; mt < 2; ++mt)                                                       \
    _Pragma("unroll") for (int s2 = 0; s2 < 2; ++s2) {                                                     \
      const bf16x8 pf = pack8(sc_[mt], s2);                                                                \
      o[0] = MFMA(vf_[(mt * 2 + s2) * 2 + 0], pf, o[0]);                                                   \
      o[1] = MFMA(vf_[(mt * 2 + s2) * 2 + 1], pf, o[1]);                                                   \
      o2 = MFMA(ones, pf, o2);                                                                             \
    }                                                                                                      \
    __builtin_amdgcn_s_setprio(0);                                                                         \
    if ((kt_) + 2 < nkt) K_STORE(buf);                                                                     \
    if ((kt_) + 1 < nkt) V_STORE(buf ^ 1);                                                                 \
    __syncthreads();                                                                                       \
  } while (0)
  f32x16 sn[2];
  sn[0] = zero16();
  sn[1] = zero16();
  S_CHAIN(sc, 0);
  __syncthreads();
  for (int kt = 0; kt < nkt; kt += 2) {
    ATT_STEP(sc, sn, kt);
    ATT_STEP(sn, sc, kt + 1);
  }
#undef ATT_STEP
#undef S_CHAIN
  float l = __shfl(o2[0], r);
#undef K_LOAD
#undef K_STORE
#undef V_LOAD
#undef V_STORE
#undef S_TILE
  const float inv = 1.f / l;
  bf16_t* op = p.xn() + ((size_t)b * TT + qrow) * DM + 384 + hh * 64 + 4 * h;
#pragma unroll
  for (int dt = 0; dt < 2; ++dt)
#pragma unroll
    for (int g = 0; g < 4; ++g) {
      uint2 u;
      u.x = pack2(o[dt][4 * g + 0] * inv, o[dt][4 * g + 1] * inv);
      u.y = pack2(o[dt][4 * g + 2] * inv, o[dt][4 * g + 3] * inv);
      *(uint2*)(op + dt * 32 + 8 * g) = u;
    }
}

DI void ssd_out_rows(const Params& p, int layer, int r_begin, int nrows) {
  const int tid = otid(), lane = tid & 63, wave = tid >> 6;
  const int grp = lane >> 5, li = lane & 31;
  const int ch = grp * 192 + li * 6;
  float dsk[6], nw[6];
#pragma unroll
  for (int e = 0; e < 6; ++e) {
    dsk[e] = p.ssd_d[layer * 6 + (ch + e) / 64];
    nw[e] = p.ssd_norm_w[layer * 384 + ch + e];
  }
  for (int r = r_begin + wave; r < r_begin + nrows; r += 8) {
    const int b = r / TT, t = r - b * TT;
    if (t >= LSEQ && layer == 1) continue;
    const unsigned* yf = (const unsigned*)(p.yssd() + (size_t)r * 384 + ch);
    const unsigned* yb = (const unsigned*)(p.yssd() + ((size_t)MT + r) * 384 + ch);
    const unsigned* xs = (const unsigned*)(p.xbc() + (size_t)r * 896 + ch);
    const unsigned* zz = (const unsigned*)(p.proj() + (size_t)r * NP + C_Z + ch);
    float g[6];
    float ss = 0.f;
#pragma unroll
    for (int e2 = 0; e2 < 3; ++e2) {
      const unsigned a = yf[e2], bq = yb[e2], x = xs[e2], z = zz[e2];
      const float y0 = bflo(a) + bflo(bq) + bflo(x) * dsk[2 * e2];
      const float y1 = bfhi(a) + bfhi(bq) + bfhi(x) * dsk[2 * e2 + 1];
      g[2 * e2] = y0 * silu(bflo(z));
      g[2 * e2 + 1] = y1 * silu(bfhi(z));
      ss += g[2 * e2] * g[2 * e2] + g[2 * e2 + 1] * g[2 * e2 + 1];
    }
#pragma unroll
    for (int o = 16; o >= 1; o >>= 1) ss += __shfl_xor(ss, o);
    const float rstd = rsqrtf(ss * (1.f / 192.f) + 1e-6f);
    unsigned* dst = (unsigned*)(p.xn() + (size_t)r * DM + ch);
#pragma unroll
    for (int e2 = 0; e2 < 3; ++e2) dst[e2] = pack2(g[2 * e2] * rstd * nw[2 * e2], g[2 * e2 + 1] * rstd * nw[2 * e2 + 1]);
  }
}

DI void phase_mixers(const Params& p, int layer, bf16_t* smem, int rep) {
  if (EN(13) || ONLY == 3) for (int jp = obid(); jp < 96; jp += ogrid()) ssd_job(p, layer, jp, smem);
  if (ONLY == 13) return;
  if (layer == 0) {
    if (ogrid() > 96) { if (obid() >= 96) transpose_layer(p, 1, obid() - 96, ogrid() - 96, (float*)smem); }
    else transpose_layer(p, 1, obid(), ogrid(), (float*)smem);
  }
  volatile int* sitem = (volatile int*)((char*)smem + MISC_OFF + 1024);
  const int ipg = layer == 0 ? 17 : 16;
  const int nper = 12 * ipg;
  unsigned* qbase = p.bar() + 3616 + (layer + 2 * rep) * 8;
  const int xcc = (int)(xb_xcc_id() & 7u);
  for (int k = 0; k < 8; ++k) {
    const int xq = (xcc + k) & 7;
    while (true) {
      __syncthreads();
      if (threadIdx.x == 0) *sitem = (int)xb_add(qbase + xq, 1u);
      __syncthreads();
      const int idx = *sitem;
      if (idx >= nper) break;
      const int gi = idx / ipg, within = idx - gi * ipg;
      const int g = xq + 8 * gi;
      const int b = g / 6, hh = g - b * 6;
      if (within == 16) attn_item(p, b, hh, LSEQ, LSEQ, 4, smem);
      else attn_item(p, b, hh, within * 256, 0, 68, smem);
    }
  }
  {
    unsigned* done = p.bar() + 3700 + layer * 16;
    unsigned* rowq = p.bar() + 3740 + layer * 16;
    const int nchunk = layer == 0 ? 68 : 64;
    for (int bb = 0; bb < NB; ++bb) {
      __syncthreads();
      if (threadIdx.x == 0) {
        XB_SPIN(xb_ld(done + bb) < 12u, p.bar());
        __builtin_amdgcn_fence(__ATOMIC_ACQUIRE, "agent");
        asm volatile("s_waitcnt vmcnt(0)" ::: "memory");
      }
      __syncthreads();
      while (true) {
        if (threadIdx.x == 0) *sitem = (int)xb_add(rowq + bb, 1u);
        __syncthreads();
        const int c = *sitem;
        __syncthreads();
        if (c >= nchunk) break;
        ssd_out_rows(p, layer, bb * TT + c * 64, 64);
      }
    }
  }
}

struct XcdBarrier { unsigned* bar; unsigned x; volatile LAS unsigned* st; };
DI XcdBarrier xcd_barrier_post(unsigned* bar, volatile LAS unsigned* st) {
  XcdBarrier b; b.bar = bar; b.x = xb_xcc_id(); b.st = st;
  if (threadIdx.x == 0) (void)xb_add(&bar[XB_XCNT(b.x)], 1u);
  return b;
}
DI void xcd_barrier_complete(unsigned* bar, unsigned x, unsigned& nloc, unsigned& nx) {
  const unsigned G = gridDim.x * gridDim.y * gridDim.z;
  unsigned sum, cnt, mine, sp = 0u;
  for (;;) {
    sum = 0u; cnt = 0u; mine = 0u;
#pragma unroll
    for (unsigned j = 0; j < 16; ++j) { const unsigned c = xb_ld(&bar[XB_XCNT(j)]); sum += c; cnt += (c > 0u) ? 1u : 0u; mine = (j == x) ? c : mine; }
    if (sum == G) break;
    __builtin_amdgcn_s_sleep(1);
    if ((++sp & 255u) == 0u) { if (xb_ld(&bar[XB_TMO])) break; if (sp > XB_SPIN_CAP) { atomicAdd(&bar[XB_TMO], 1u); break; } }
  }
  nloc = mine > 0u ? mine : 1u; nx = cnt > 0u ? cnt : 1u;
}
DI void xcd_barrier(const XcdBarrier& b) {
  asm volatile("s_waitcnt vmcnt(0)" ::: "memory");
  __syncthreads();
  if (threadIdx.x == 0) {
    unsigned* bar = b.bar;
    __builtin_amdgcn_s_waitcnt(0);
    unsigned nloc = b.st[0], nx = b.st[1];
    if (nloc == 0u) { xcd_barrier_complete(bar, b.x, nloc, nx); b.st[0] = nloc; b.st[1] = nx; }
    const unsigned old = xb_add(&bar[XB_XSUB(b.x)], 1u);
    const unsigned gen = old / nloc;
    if (old + 1u == (gen + 1u) * nloc) {
      __builtin_amdgcn_fence(__ATOMIC_RELEASE, "agent");
      asm volatile("s_waitcnt vmcnt(0)" ::: "memory");
      const unsigned og = xb_add(&bar[XB_TOP], 1u);
      const unsigned tg = og / nx;
      if (og + 1u == (tg + 1u) * nx) xb_add(&bar[XB_TOPGEN], 1u);
      else XB_SPIN(xb_ld(&bar[XB_TOPGEN]) == tg, bar);
      __builtin_amdgcn_fence(__ATOMIC_ACQUIRE, "agent");
      xb_add(&bar[XB_XGEN(b.x)], 1u);
      asm volatile("s_waitcnt vmcnt(0)" ::: "memory");
    } else {
      XB_SPIN(xb_ld(&bar[XB_XGEN(b.x)]) == gen, bar);
      __builtin_amdgcn_fence(__ATOMIC_ACQUIRE, "agent");
      asm volatile("s_waitcnt vmcnt(0)" ::: "memory");
    }
  }
  __syncthreads();
}

DI void run_phase(const Params& p, int ph, bf16_t* smem, int rep) {
  if (ph == 0) { if (EN(10)) phase_prep(p, smem); return; }
  if (ph == NPHASE - 1) { if (EN(11)) phase_final(p); return; }
  const int layer = (ph - 1) / 9, s = (ph - 1) % 9;
  switch (s) {
    case 0: if (EN(0)) phase_norm(p, layer, 1); break;
    case 1: if (EN(1)) phase_gemm_in(p, layer, smem); break;
    case 2: if (EN(2)) phase_tokops(p, layer); if (EN(12)) phase_gemm_qkv(p, layer, smem); break;
    case 3: if (EN(3) || EN(13) || EN(14)) phase_mixers(p, layer, smem, rep); break;
    case 4: break;
    case 5: if (EN(5)) phase_gemm_out(p, layer, smem); break;
    case 6: if (EN(6)) phase_norm(p, layer, 2); break;
    case 7: if (EN(7)) phase_gemm_m1(p, layer, smem); break;
    default: if (EN(8)) phase_gemm_m2(p, layer, smem); break;
  }
}

__global__ void __launch_bounds__(512, 2) fwd_megakernel(Params p, int ph_begin, int ph_end) {
  __shared__ __attribute__((aligned(16))) unsigned char smem_raw[SMEM_BYTES];
  bf16_t* smem = (bf16_t*)smem_raw;
  cg::grid_group grid = cg::this_grid();
  volatile LAS unsigned* xst = (volatile LAS unsigned*)(LAS unsigned char*)(smem_raw + MISC_OFF + 1024 + 32);
  if (threadIdx.x == 0) { xst[0] = 0u; xst[1] = 0u; }
  __syncthreads();
  const XcdBarrier xb = xcd_barrier_post(p.bar(), xst);
  for (int ph = ph_begin; ph < ph_end; ++ph) {
    if (ph >= 1 && ph < NPHASE - 1 && (ph - 1) % 9 == 4) continue;
    run_phase(p, ph, smem, 0);
#if REPEAT_MASK
    if (ph >= 1 && ph < NPHASE - 1 && ((REPEAT_MASK >> ((ph - 1) % 9)) & 1)) {
      xcd_barrier(xb);
      run_phase(p, ph, smem, 1);
    }
#endif
    if (ph + 1 < ph_end) {
      if (ph == 0) grid.sync();
      else xcd_barrier(xb);
    }
  }
}

extern "C" void kernel_launch(void* const* d_in, const int* in_sizes, int n_in, void* d_out, int out_size, void* d_ws,
                              size_t ws_size, hipStream_t stream) {
  static int grid_blocks = 0;
  if (!grid_blocks) {
    int dev = 0, cus = 0, per_cu = 0;
    hipGetDevice(&dev);
    hipDeviceGetAttribute(&cus, hipDeviceAttributeMultiprocessorCount, dev);
    hipOccupancyMaxActiveBlocksPerMultiprocessor(&per_cu, fwd_megakernel, 512, 0);
    if (per_cu > 1) per_cu = 1;
    if (per_cu < 1) per_cu = 1;
    grid_blocks = cus * per_cu;
  }
  Params p{};
  const float** fp = (const float**)&p;
  for (int i = 0; i < 25; ++i) fp[i] = (const float*)d_in[i];
  p.out = (float*)d_out;
  p.ws = (char*)d_ws;
  if (WS_NEED > ws_size) fprintf(stderr, "workspace too small: need %zu have %zu\n", (size_t)WS_NEED, ws_size);
  hipMemsetAsync((char*)d_ws + O_BAR, 0, 16384, stream);
#if MULTI_LAUNCH
  for (int ph = 0; ph < NPHASE; ++ph)
    hipLaunchKernelGGL(fwd_megakernel, dim3(grid_blocks), dim3(512), 0, stream, p, ph, ph + 1);
#else
  int b0 = 0, b1 = NPHASE;
  void* args[] = {&p, &b0, &b1};
  hipError_t e = hipLaunchCooperativeKernel((void*)fwd_megakernel, dim3(grid_blocks), dim3(512), args, 0, stream);
  if (e != hipSuccess) fprintf(stderr, "cooperative launch failed: %s (grid %d)\n", hipGetErrorString(e), grid_blocks);
#endif
}
```

```cpp
#include <hip/hip_runtime.h>
#include <hip/hip_cooperative_groups.h>
#include <cstdio>
#include <cstdint>
namespace cg = cooperative_groups;

#ifndef MULTI_LAUNCH
#define MULTI_LAUNCH 0
#endif
#ifndef ONLY
#define ONLY -1
#endif
#define EN(k) (ONLY < 0 || ONLY == (k))
#ifndef REPEAT_MASK
#define REPEAT_MASK 0
#endif

#define DI __device__ __forceinline__
typedef unsigned short bf16_t;
using bf16x8 = __attribute__((ext_vector_type(8))) short;
using f32x16 = __attribute__((ext_vector_type(16))) float;
typedef __bf16 bfv2 __attribute__((ext_vector_type(2)));
typedef float f32v2 __attribute__((ext_vector_type(2)));
#define MFMA(a, b, c) __builtin_amdgcn_mfma_f32_32x32x16_bf16((a), (b), (c), 0, 0, 0)

constexpr int NB = 16, LSEQ = 4096, CTXL = 256, TT = 4352;
constexpr int MT = NB * TT;
constexpr int DM = 1024, DFF = 4096;
constexpr int NP = 2176;
constexpr int C_Z = 0, C_XBC = 384, C_DT = 1280, C_QA = 1344, C_KVA = 1600, C_KR = 1856, C_POOL = 1888;
constexpr int IN_COLS = 2092;
constexpr int NPHASE = 20;
constexpr int MISC_OFF = 145408;
constexpr int SMEM_BYTES = MISC_OFF + 1024 + 256;
constexpr int NPW = 2304;
constexpr int NQ = 768;
constexpr int SSD_LDS_EL = 36352;

constexpr size_t al256(size_t x) { return (x + 255) & ~(size_t)255; }
constexpr size_t O_WT_IN = 0;
constexpr size_t O_WT_OUT = O_WT_IN + al256((size_t)2 * NPW * 1024 * 2);
constexpr size_t O_WT_M1 = O_WT_OUT + al256((size_t)2 * 1024 * 1024 * 2);
constexpr size_t O_WT_M2 = O_WT_M1 + al256((size_t)2 * 4096 * 1024 * 2);
constexpr size_t O_WT_QB = O_WT_M2 + al256((size_t)2 * 1024 * 4096 * 2);
constexpr size_t O_WT_KVB = O_WT_QB + al256((size_t)2 * NQ * 256 * 2);
constexpr size_t O_MODS = O_WT_KVB + al256((size_t)2 * 768 * 256 * 2);
constexpr size_t O_ROPE = O_MODS + al256((size_t)2 * 17 * 6144 * 4);
constexpr size_t O_CTR = O_ROPE + al256(64 * 8 * 2 * 4);
constexpr size_t O_BAR = O_CTR + 256;
constexpr size_t O_RSS = O_BAR + 16384;
constexpr size_t O_CTXRES = O_RSS + al256((size_t)2 * MT * 4);
constexpr size_t O_XN = O_CTXRES + al256((size_t)NB * CTXL * DM * 4);
constexpr size_t O_YSSD = O_XN + al256((size_t)MT * DM * 2);
constexpr size_t O_BIG = O_YSSD + al256((size_t)2 * MT * 384 * 2);
constexpr size_t O_PROJ = O_BIG;
constexpr size_t O_XBC = O_PROJ + al256((size_t)MT * NP * 2);
constexpr size_t O_Q = O_XBC + al256((size_t)MT * 896 * 2);
constexpr size_t O_K = O_Q + al256((size_t)NB * 6 * TT * 96 * 2);
constexpr size_t O_VT = O_K + al256((size_t)NB * 6 * TT * 96 * 2);
constexpr size_t O_END1 = O_VT + al256((size_t)NB * 6 * 64 * TT * 2);
constexpr size_t O_END2 = O_BIG + (size_t)MT * DFF * 2;
constexpr size_t WS_NEED = O_END1 > O_END2 ? O_END1 : O_END2;

struct Params {
  const float *x, *c, *ctx, *c_ctx, *mod_w, *mod_b, *norm1_w, *norm2_w, *w_in, *conv_w, *conv_b, *dt_bias, *a_log,
      *ssd_d, *ssd_norm_w, *q_a_norm_w, *w_q_b, *kv_a_norm_w, *w_kv_b, *pool_w, *pool_scale, *w_out, *w_mlp1, *w_mlp2,
      *final_norm_w;
  float* out;
  char* ws;
  DI bf16_t* wt_in() const { return (bf16_t*)(ws + O_WT_IN); }
  DI bf16_t* wt_out() const { return (bf16_t*)(ws + O_WT_OUT); }
  DI bf16_t* wt_m1() const { return (bf16_t*)(ws + O_WT_M1); }
  DI bf16_t* wt_m2() const { return (bf16_t*)(ws + O_WT_M2); }
  DI bf16_t* wt_qb() const { return (bf16_t*)(ws + O_WT_QB); }
  DI bf16_t* wt_kvb() const { return (bf16_t*)(ws + O_WT_KVB); }
  DI float* mods() const { return (float*)(ws + O_MODS); }
  DI float* rope() const { return (float*)(ws + O_ROPE); }
  DI int* ctr() const { return (int*)(ws + O_CTR); }
  DI unsigned* bar() const { return (unsigned*)(ws + O_BAR); }
  DI float* rss() const { return (float*)(ws + O_RSS); }
  DI float* ctxres() const { return (float*)(ws + O_CTXRES); }
  DI bf16_t* xn() const { return (bf16_t*)(ws + O_XN); }
  DI bf16_t* yssd() const { return (bf16_t*)(ws + O_YSSD); }
  DI bf16_t* proj() const { return (bf16_t*)(ws + O_PROJ); }
  DI bf16_t* xbc() const { return (bf16_t*)(ws + O_XBC); }
  DI bf16_t* Q() const { return (bf16_t*)(ws + O_Q); }
  DI bf16_t* Kc() const { return (bf16_t*)(ws + O_K); }
  DI bf16_t* Vt() const { return (bf16_t*)(ws + O_VT); }
  DI bf16_t* hidden() const { return (bf16_t*)(ws + O_BIG); }
};

DI unsigned pack2(float a, float b) {
  f32v2 v = {a, b};
  bfv2 r = __builtin_convertvector(v, bfv2);
  return __builtin_bit_cast(unsigned, r);
}
DI bf16_t f2bf(float a) { return (bf16_t)(pack2(a, 0.f) & 0xffffu); }
DI float bf2f(bf16_t v) { return __uint_as_float(((unsigned)v) << 16); }
DI float bflo(unsigned w) { return __uint_as_float(w << 16); }
DI float bfhi(unsigned w) { return __uint_as_float(w & 0xffff0000u); }
DI float silu(float x) { return x / (1.f + __expf(-x)); }
DI int crow(int reg, int h) { return (reg & 3) + 8 * (reg >> 2) + 4 * h; }
DI float wave_sum(float v) {
#pragma unroll
  for (int o = 32; o >= 1; o >>= 1) v += __shfl_xor(v, o);
  return v;
}
DI bf16x8 pack8(const f32x16& x, int s) {
  uint4 u;
  u.x = pack2(x[8 * s + 0], x[8 * s + 1]);
  u.y = pack2(x[8 * s + 2], x[8 * s + 3]);
  u.z = pack2(x[8 * s + 4], x[8 * s + 5]);
  u.w = pack2(x[8 * s + 6], x[8 * s + 7]);
  return __builtin_bit_cast(bf16x8, u);
}
DI bf16x8 join8(uint2 lo, uint2 hi) {
  uint4 u; u.x = lo.x; u.y = lo.y; u.z = hi.x; u.w = hi.y;
  return __builtin_bit_cast(bf16x8, u);
}
DI int ogrid() { return gridDim.x; }
DI int obid() { return blockIdx.x; }
DI int ogrid_op() { int g = gridDim.x; asm volatile("" : "+s"(g)); return g; }
DI int otid() { int t = threadIdx.x; asm volatile("" : "+v"(t)); return t; }
DI unsigned xb_ld(unsigned* p) { return __hip_atomic_load(p, __ATOMIC_RELAXED, __HIP_MEMORY_SCOPE_AGENT); }
DI unsigned xb_add(unsigned* p, unsigned v) { return __hip_atomic_fetch_add(p, v, __ATOMIC_RELAXED, __HIP_MEMORY_SCOPE_AGENT); }
DI unsigned xb_xcc_id() { return (unsigned)__builtin_amdgcn_s_getreg((3 << 11) | 20) & 0xFu; }
#define XB_TMO      128
#define XB_XCNT(j)  (256  + 64 * (j))
#define XB_XSUB(j)  (1280 + 64 * (j))
#define XB_XGEN(j)  (2304 + 64 * (j))
#define XB_TOP      3328
#define XB_TOPGEN   3392
#define XCD_BAR_WORDS 3456
#define XB_SPIN_CAP (1u << 18)
#define XB_SPIN(cond, bar) do { unsigned _sp = 0; while (cond) { __builtin_amdgcn_s_sleep(1); \
    if ((++_sp & 255u) == 0u) { if (xb_ld(&(bar)[XB_TMO])) break; if (_sp > XB_SPIN_CAP) { atomicAdd(&(bar)[XB_TMO], 1u); break; } } } } while (0)
DI f32x16 zero16() { f32x16 z; for (int i = 0; i < 16; ++i) z[i] = 0.f; return z; }

DI float* res_row(const Params& p, int b, int t) {
  return t < LSEQ ? p.out + ((size_t)b * LSEQ + t) * DM : p.ctxres() + ((size_t)b * CTXL + (t - LSEQ)) * DM;
}
DI const float* in_row(const Params& p, int b, int t) {
  return t < LSEQ ? p.x + ((size_t)b * LSEQ + t) * DM : p.ctx + ((size_t)b * CTXL + (t - LSEQ)) * DM;
}

using f32x4 = __attribute__((ext_vector_type(4))) float;
constexpr int GBK = 64, GHALF = 128, GHT = GHALF * GBK;
#define LAS __attribute__((address_space(3)))
DI int lds_byte(int r, int c) {
  const int st = (r >> 4) * 2 + (c >> 5), rr = r & 15, cc = c & 31, ob = rr * 64 + cc * 2;
  return st * 1024 + (ob ^ (((ob >> 9) & 1) << 5));
}
DI void stage_rc(int b, int& R, int& C) {
  const int st = b / 1024, sb = b % 1024, swz = sb ^ (((sb >> 9) & 1) << 5);
  R = (st >> 1) * 16 + swz / 64;
  C = (st & 1) * 32 + (swz % 64) / 2;
}
typedef f32x4 acc_t[2][2][4][2];
DI int perm32(int rho) { const int n = rho >> 4, i = rho & 15; return 8 * (i >> 2) + 4 * n + (i & 3); }

template <bool RMS, class Epi, class UnitFn>
DI void gemm256(const bf16_t* __restrict__ A, int lda, const bf16_t* __restrict__ Bt, int ldb, int K,
                bf16_t* shm, Epi& epi, UnitFn unit) {
  const int tid = otid();
  const int wid = tid >> 6, lane = tid & 63, wr = wid >> 2, wc = wid & 3, fr = lane & 15, fq = lane >> 4;
  float* rs = (float*)((char*)shm + MISC_OFF);
  const int ldst0 = tid * 16;
  const unsigned swave = (unsigned)__builtin_amdgcn_readfirstlane((int)((unsigned)(size_t)(LAS char*)shm + (unsigned)((tid & ~63) * 16)));
  unsigned la0, la1, lb0, lb1;
  {
    int r0_, c0_, r1_, c1_;
    stage_rc(ldst0, r0_, c0_);
    stage_rc(ldst0 + 8192, r1_, c1_);
    la0 = (unsigned)(r0_ * lda + c0_) * 2u; la1 = (unsigned)(r1_ * lda + c1_) * 2u;
    if (Epi::PERM) { r0_ = (r0_ & ~31) | perm32(r0_ & 31); r1_ = (r1_ & ~31) | perm32(r1_ & 31); }
    lb0 = (unsigned)(r0_ * ldb + c0_) * 2u; lb1 = (unsigned)(r1_ * ldb + c1_) * 2u;
  }
#define SA(b, h) (shm + ((b) * 2 + (h)) * GHT)
#define SB(b, h) (shm + (4 + (b) * 2 + (h)) * GHT)
#define GLDS(voff, sbase, m0v)                                                                           \
  asm volatile("s_mov_b32 m0, %2\n\ts_nop 0\n\tglobal_load_lds_dwordx4 %0, %1" ::"v"(voff), "s"(sbase), "s"(m0v) : "memory", "m0")
#define STAGE(PB, BASE, LD, br, kt, L0, L1)                                                               \
  do {                                                                                                    \
    const char* _ub = (const char*)((BASE) + (long)(br) * (LD) + (long)(kt) * GBK);                       \
    const unsigned _m = swave + (unsigned)(PB);                                                           \
    GLDS(L0, _ub, _m);                                                                                    \
    GLDS(L1, _ub, _m + 8192u);                                                                            \
  } while (0)
#define SAB(b, h) ((((b) * 2 + (h)) * GHT) * 2)
#define SBB(b, h) (((4 + (b) * 2 + (h)) * GHT) * 2)
#define STA(P, br, kt) STAGE(P, A, lda, br, kt, la0, la1)
#define STB(P, br, kt) STAGE(P, Bt, ldb, br, kt, lb0, lb1)
#define LDA(dst, b, h)                                                                                    \
  _Pragma("unroll") for (int m = 0; m < 4; ++m) _Pragma("unroll") for (int k = 0; k < 2; ++k)             \
      dst[m][k] = *reinterpret_cast<const bf16x8*>((const char*)SA(b, h) + lds_byte(wr * 64 + m * 16 + fr, k * 32 + fq * 8))
#define LDB(dst, b, h)                                                                                    \
  _Pragma("unroll") for (int n = 0; n < 2; ++n) _Pragma("unroll") for (int k = 0; k < 2; ++k)             \
      dst[n][k] = *reinterpret_cast<const bf16x8*>((const char*)SB(b, h) + lds_byte(wc * 32 + n * 16 + fr, k * 32 + fq * 8))
#define MMA(ai, bj, At_, Bt_)                                                                             \
  do {                                                                                                    \
    __builtin_amdgcn_s_setprio(1);                                                                        \
    _Pragma("unroll") for (int m = 0; m < 4; ++m) _Pragma("unroll") for (int n = 0; n < 2; ++n)           \
        _Pragma("unroll") for (int k = 0; k < 2; ++k) acc[ai][bj][m][n] =                                 \
            __builtin_amdgcn_mfma_f32_16x16x32_bf16(Bt_[n][k], At_[m][k], acc[ai][bj][m][n], 0, 0, 0);   \
    __builtin_amdgcn_s_setprio(0);                                                                        \
  } while (0)
#define WAIT_V(n) asm volatile("s_waitcnt vmcnt(" #n ")" ::: "memory")
#define WAIT_L(n) asm volatile("s_waitcnt lgkmcnt(" #n ")" ::: "memory")
#define BAR __builtin_amdgcn_s_barrier()
#define SCHED __builtin_amdgcn_sched_barrier(0)
#define PROLOGUE(br_, bc_)                                                                                 \
  do {                                                                                                    \
    STB(SBB(0, 0), (bc_), 0); STA(SAB(0, 0), (br_), 0);                                                   \
    STB(SBB(0, 1), (bc_) + GHALF, 0); STA(SAB(0, 1), (br_) + GHALF, 0);                                   \
    STB(SBB(1, 0), (bc_), 1); STA(SAB(1, 0), (br_), 1); STB(SBB(1, 1), (bc_) + GHALF, 1);                 \
  } while (0)
  int brow = 0, bcol = 0;
  if (!unit(0, brow, bcol)) return;
  if (!RMS) PROLOGUE(brow, bcol);
  for (int ui = 0;; ++ui) {
  int nbrow = 0, nbcol = 0;
  const bool more = unit(ui + 1, nbrow, nbcol);
  if (RMS) {
    const int row = tid >> 1, half = tid & 1;
    const bf16_t* ap = A + (size_t)(brow + row) * lda + half * 128;
    float ss = 0.f;
#pragma unroll 4
    for (int i = 0; i < 16; ++i) {
      uint4 v = *(const uint4*)(ap + i * 8);
      float f;
      f = bflo(v.x); ss += f * f; f = bfhi(v.x); ss += f * f;
      f = bflo(v.y); ss += f * f; f = bfhi(v.y); ss += f * f;
      f = bflo(v.z); ss += f * f; f = bfhi(v.z); ss += f * f;
      f = bflo(v.w); ss += f * f; f = bfhi(v.w); ss += f * f;
    }
    ss += __shfl_xor(ss, 1);
    if (half == 0) rs[row] = rsqrtf(ss * (1.f / 256.f) + 1e-6f);
    WAIT_V(0);
    PROLOGUE(brow, bcol);
  }
  acc_t acc;
#pragma unroll
  for (int i0 = 0; i0 < 2; ++i0)
#pragma unroll
    for (int i1 = 0; i1 < 2; ++i1)
#pragma unroll
      for (int i2 = 0; i2 < 4; ++i2)
#pragma unroll
        for (int i3 = 0; i3 < 2; ++i3) acc[i0][i1][i2][i3] = (f32x4){0.f, 0.f, 0.f, 0.f};
  bf16x8 At[4][2], B0[2][2], B1[2][2];
  const int nt = K / GBK;
  if (wr == 1) BAR;
  WAIT_V(10); BAR;
  WAIT_V(6); BAR;
  for (int t = 0; t < nt - 2; t += 2) {
    LDB(B0, 0, 0); SCHED; LDA(At, 0, 0); STA(SAB(1, 1), brow + GHALF, t + 1);
    WAIT_L(8); BAR; WAIT_L(0); MMA(0, 0, At, B0); BAR; SCHED;
    LDB(B1, 0, 1); STB(SBB(0, 0), bcol, t + 2);
    BAR; WAIT_L(0); MMA(0, 1, At, B1); BAR;
    LDA(At, 0, 1); STA(SAB(0, 0), brow, t + 2);
    BAR; WAIT_L(0); MMA(1, 0, At, B0); BAR; SCHED;
    STB(SBB(0, 1), bcol + GHALF, t + 2);
    WAIT_V(6); BAR; MMA(1, 1, At, B1); BAR;
    LDB(B0, 1, 0); SCHED; LDA(At, 1, 0); STA(SAB(0, 1), brow + GHALF, t + 2);
    WAIT_L(8); BAR; WAIT_L(0); MMA(0, 0, At, B0); BAR; SCHED;
    LDB(B1, 1, 1); STB(SBB(1, 0), bcol, t + 3);
    BAR; WAIT_L(0); MMA(0, 1, At, B1); BAR;
    LDA(At, 1, 1); STA(SAB(1, 0), brow, t + 3);
    BAR; WAIT_L(0); MMA(1, 0, At, B0); BAR; SCHED;
    STB(SBB(1, 1), bcol + GHALF, t + 3);
    WAIT_V(6); BAR; MMA(1, 1, At, B1); BAR;
  }
  {
    LDB(B0, 0, 0); LDA(At, 0, 0); STA(SAB(1, 1), brow + GHALF, nt - 1);
    BAR; WAIT_L(0); MMA(0, 0, At, B0); BAR;
    LDB(B1, 0, 1); BAR; WAIT_L(0); MMA(0, 1, At, B1); BAR;
    LDA(At, 0, 1); WAIT_V(4); BAR; WAIT_L(0); MMA(1, 0, At, B0); MMA(1, 1, At, B1); BAR;
  }
  {
    LDB(B0, 1, 0); LDA(At, 1, 0); WAIT_V(2); BAR; WAIT_L(0); MMA(0, 0, At, B0); BAR;
    LDB(B1, 1, 1); WAIT_V(0); BAR; WAIT_L(0); MMA(0, 1, At, B1); BAR;
    LDA(At, 1, 1); BAR; WAIT_L(0); MMA(1, 0, At, B0); MMA(1, 1, At, B1); BAR;
  }
  if (wr == 0) BAR;
  if (!RMS && more) { PROLOGUE(nbrow, nbcol); }
  epi(acc, brow, bcol, wr, wc, fr, fq, rs);
  if (RMS) __syncthreads();
  if (!more) break;
  brow = nbrow; bcol = nbcol;
  }
}

template <bool RMS, class Epi>
DI void gemm256_unit(const bf16_t* __restrict__ A, int lda, const bf16_t* __restrict__ Bt, int ldb, int K, int brow, int bcol,
                bf16_t* shm, Epi& epi) {
  const int tid = otid();
  const int wid = tid >> 6, lane = tid & 63, wr = wid >> 2, wc = wid & 3, fr = lane & 15, fq = lane >> 4;
  float* rs = (float*)((char*)shm + MISC_OFF);
  const int ldst0 = tid * 16;
  const unsigned swave = (unsigned)__builtin_amdgcn_readfirstlane((int)((unsigned)(size_t)(LAS char*)shm + (unsigned)((tid & ~63) * 16)));
  unsigned la0, la1, lb0, lb1;
  {
    int r0_, c0_, r1_, c1_;
    stage_rc(ldst0, r0_, c0_);
    stage_rc(ldst0 + 8192, r1_, c1_);
    la0 = (unsigned)(r0_ * lda + c0_) * 2u; la1 = (unsigned)(r1_ * lda + c1_) * 2u;
    if (Epi::PERM) { r0_ = (r0_ & ~31) | perm32(r0_ & 31); r1_ = (r1_ & ~31) | perm32(r1_ & 31); }
    lb0 = (unsigned)(r0_ * ldb + c0_) * 2u; lb1 = (unsigned)(r1_ * ldb + c1_) * 2u;
  }
  if (RMS) {
    const int row = tid >> 1, half = tid & 1;
    const bf16_t* ap = A + (size_t)(brow + row) * lda + half * 128;
    float ss = 0.f;
#pragma unroll 4
    for (int i = 0; i < 16; ++i) {
      uint4 v = *(const uint4*)(ap + i * 8);
      float f;
      f = bflo(v.x); ss += f * f; f = bfhi(v.x); ss += f * f;
      f = bflo(v.y); ss += f * f; f = bfhi(v.y); ss += f * f;
      f = bflo(v.z); ss += f * f; f = bfhi(v.z); ss += f * f;
      f = bflo(v.w); ss += f * f; f = bfhi(v.w); ss += f * f;
    }
    ss += __shfl_xor(ss, 1);
    if (half == 0) rs[row] = rsqrtf(ss * (1.f / 256.f) + 1e-6f);
    WAIT_V(0);
  }
  acc_t acc;
#pragma unroll
  for (int i0 = 0; i0 < 2; ++i0)
#pragma unroll
    for (int i1 = 0; i1 < 2; ++i1)
#pragma unroll
      for (int i2 = 0; i2 < 4; ++i2)
#pragma unroll
        for (int i3 = 0; i3 < 2; ++i3) acc[i0][i1][i2][i3] = (f32x4){0.f, 0.f, 0.f, 0.f};
  bf16x8 At[4][2], B0[2][2], B1[2][2];
  const int nt = K / GBK;
  STB(SBB(0, 0), bcol, 0); STA(SAB(0, 0), brow, 0);
  STB(SBB(0, 1), bcol + GHALF, 0); STA(SAB(0, 1), brow + GHALF, 0);
  if (wr == 1) BAR;
  WAIT_V(4); BAR;
  STB(SBB(1, 0), bcol, 1); STA(SAB(1, 0), brow, 1); STB(SBB(1, 1), bcol + GHALF, 1);
  WAIT_V(6); BAR;
  for (int t = 0; t < nt - 2; t += 2) {
    LDB(B0, 0, 0); SCHED; LDA(At, 0, 0); STA(SAB(1, 1), brow + GHALF, t + 1);
    WAIT_L(8); BAR; WAIT_L(0); MMA(0, 0, At, B0); BAR; SCHED;
    LDB(B1, 0, 1); STB(SBB(0, 0), bcol, t + 2);
    BAR; WAIT_L(0); MMA(0, 1, At, B1); BAR;
    LDA(At, 0, 1); STA(SAB(0, 0), brow, t + 2);
    BAR; WAIT_L(0); MMA(1, 0, At, B0); BAR; SCHED;
    STB(SBB(0, 1), bcol + GHALF, t + 2);
    WAIT_V(6); BAR; MMA(1, 1, At, B1); BAR;
    LDB(B0, 1, 0); SCHED; LDA(At, 1, 0); STA(SAB(0, 1), brow + GHALF, t + 2);
    WAIT_L(8); BAR; WAIT_L(0); MMA(0, 0, At, B0); BAR; SCHED;
    LDB(B1, 1, 1); STB(SBB(1, 0), bcol, t + 3);
    BAR; WAIT_L(0); MMA(0, 1, At, B1); BAR;
    LDA(At, 1, 1); STA(SAB(1, 0), brow, t + 3);
    BAR; WAIT_L(0); MMA(1, 0, At, B0); BAR; SCHED;
    STB(SBB(1, 1), bcol + GHALF, t + 3);
    WAIT_V(6); BAR; MMA(1, 1, At, B1); BAR;
  }
  {
    LDB(B0, 0, 0); LDA(At, 0, 0); STA(SAB(1, 1), brow + GHALF, nt - 1);
    BAR; WAIT_L(0); MMA(0, 0, At, B0); BAR;
    LDB(B1, 0, 1); BAR; WAIT_L(0); MMA(0, 1, At, B1); BAR;
    LDA(At, 0, 1); WAIT_V(4); BAR; WAIT_L(0); MMA(1, 0, At, B0); MMA(1, 1, At, B1); BAR;
  }
  {
    LDB(B0, 1, 0); LDA(At, 1, 0); WAIT_V(2); BAR; WAIT_L(0); MMA(0, 0, At, B0); BAR;
    LDB(B1, 1, 1); WAIT_V(0); BAR; WAIT_L(0); MMA(0, 1, At, B1); BAR;
    LDA(At, 1, 1); BAR; WAIT_L(0); MMA(1, 0, At, B0); MMA(1, 1, At, B1); BAR;
  }
  if (wr == 0) BAR;
  epi(acc, brow, bcol, wr, wc, fr, fq, rs);
  __syncthreads();
}


DI bool unit_next(int i, int nM, int nN, int& pm, int& pn) {
  const int nwg = nM * nN;
  const long L = (long)i * ogrid() + obid();
  if (L >= nwg) return false;
  int wgid = (int)L;
  {
    const int q = nwg / 8, r = nwg % 8, xcd = wgid % 8, off = wgid / 8;
    wgid = (xcd < r ? xcd * (q + 1) : r * (q + 1) + (xcd - r) * q) + off;
  }
  const int nig = 8 * nN, gid = wgid / nig, fm = gid * 8, gsz = (nM - fm) < 8 ? (nM - fm) : 8;
  pm = fm + ((wgid % nig) % gsz);
  pn = (wgid % nig) / gsz;
  return true;
}

#define EPI_LOOP                                                   \
  _Pragma("unroll") for (int ai = 0; ai < 2; ++ai)                 \
  _Pragma("unroll") for (int m = 0; m < 4; ++m)                    \
  _Pragma("unroll") for (int bj = 0; bj < 2; ++bj)                 \
  _Pragma("unroll") for (int n = 0; n < 2; ++n)
#define EPI_LOOP8                                                  \
  _Pragma("unroll") for (int ai = 0; ai < 2; ++ai)                 \
  _Pragma("unroll") for (int m = 0; m < 4; ++m)                    \
  _Pragma("unroll") for (int bj = 0; bj < 2; ++bj)
struct EpiProj {
  static constexpr bool PERM = true;
  bf16_t* proj; float* rss;
  DI void operator()(const acc_t& acc, int brow, int bcol, int wr, int wc, int fr, int fq, const float* rs) const {
    EPI_LOOP8 {
      const int row = brow + ai * 128 + wr * 64 + m * 16 + fr, col = bcol + bj * 128 + wc * 32 + 8 * fq;
      if (col < NP) {
        const f32x4 v0 = acc[ai][bj][m][0], v1 = acc[ai][bj][m][1];
        uint4 u; u.x = pack2(v0[0], v0[1]); u.y = pack2(v0[2], v0[3]); u.z = pack2(v1[0], v1[1]); u.w = pack2(v1[2], v1[3]);
        *(uint4*)(proj + (size_t)row * NP + col) = u;
      }
    }
    if (bcol + 256 > C_QA && bcol < C_KR) {
#pragma unroll
      for (int ai = 0; ai < 2; ++ai)
#pragma unroll
        for (int m = 0; m < 4; ++m) {
          float sq = 0.f, sk = 0.f;
#pragma unroll
          for (int bj = 0; bj < 2; ++bj) {
            const int col = bcol + bj * 128 + wc * 32 + 8 * fq;
            const f32x4 v0 = acc[ai][bj][m][0], v1 = acc[ai][bj][m][1];
            const float t = v0[0] * v0[0] + v0[1] * v0[1] + v0[2] * v0[2] + v0[3] * v0[3] +
                            v1[0] * v1[0] + v1[1] * v1[1] + v1[2] * v1[2] + v1[3] * v1[3];
            sq += (col >= C_QA && col < C_KVA) ? t : 0.f;
            sk += (col >= C_KVA && col < C_KR) ? t : 0.f;
          }
          sq += __shfl_xor(sq, 16); sq += __shfl_xor(sq, 32);
          sk += __shfl_xor(sk, 16); sk += __shfl_xor(sk, 32);
          if (fq == 0) {
            const int row = brow + ai * 128 + wr * 64 + m * 16 + fr;
            if (sq != 0.f) unsafeAtomicAdd(rss + row, sq);
            if (sk != 0.f) unsafeAtomicAdd(rss + MT + row, sk);
          }
        }
    }
  }
};
struct EpiRelu2 {
  static constexpr bool PERM = true;
  bf16_t* hid;
  DI void operator()(const acc_t& acc, int brow, int bcol, int wr, int wc, int fr, int fq, const float* rs) const {
    EPI_LOOP8 {
      const int row = brow + ai * 128 + wr * 64 + m * 16 + fr, col = bcol + bj * 128 + wc * 32 + 8 * fq;
      const f32x4 v0 = acc[ai][bj][m][0], v1 = acc[ai][bj][m][1];
      const float a0 = fmaxf(v0[0], 0.f), a1 = fmaxf(v0[1], 0.f), a2 = fmaxf(v0[2], 0.f), a3 = fmaxf(v0[3], 0.f);
      const float a4 = fmaxf(v1[0], 0.f), a5 = fmaxf(v1[1], 0.f), a6 = fmaxf(v1[2], 0.f), a7 = fmaxf(v1[3], 0.f);
      uint4 u; u.x = pack2(a0 * a0, a1 * a1); u.y = pack2(a2 * a2, a3 * a3); u.z = pack2(a4 * a4, a5 * a5); u.w = pack2(a6 * a6, a7 * a7);
      *(uint4*)(hid + (size_t)row * DFF + col) = u;
    }
  }
};
struct EpiRes {
  static constexpr bool PERM = true;
  const Params* p; int layer; int gate_off; bool from_input;
  DI void operator()(const acc_t& acc, int brow, int bcol, int wr, int wc, int fr, int fq, const float* rs) const {
    const int b = brow / TT, tb = brow - b * TT;
    const bool isctx = tb >= LSEQ;
    const float* gp = p->mods() + ((size_t)layer * 17 + (isctx ? 16 : b)) * 6144 + gate_off;
    EPI_LOOP {
      const int lr = ai * 128 + wr * 64 + m * 16 + fr, col = bcol + bj * 128 + wc * 32 + 8 * fq + 4 * n;
      const f32x4 v = acc[ai][bj][m][n];
      const float4 g = *(const float4*)(gp + col);
      float* dst = res_row(*p, b, tb + lr) + col;
      const float4 s = from_input ? *(const float4*)(in_row(*p, b, tb + lr) + col) : *(const float4*)dst;
      float4 o; o.x = s.x + g.x * v[0]; o.y = s.y + g.y * v[1]; o.z = s.z + g.z * v[2]; o.w = s.w + g.w * v[3];
      *(float4*)dst = o;
    }
  }
};
struct EpiQ {
  static constexpr bool PERM = true;
  const Params* p;
  DI void operator()(const acc_t& acc, int brow, int bcol, int wr, int wc, int fr, int fq, const float* rs) const {
    float rq[8];
#pragma unroll
    for (int i = 0; i < 8; ++i) rq[i] = rsqrtf(p->rss()[0 + brow + (i >> 2) * 128 + wr * 64 + (i & 3) * 16 + fr] * (1.f / 256.f) + 1e-6f);
    const int b = brow / TT, tb = brow - b * TT;
    EPI_LOOP8 {
      const int lr = ai * 128 + wr * 64 + m * 16 + fr, col = bcol + bj * 128 + wc * 32 + 8 * fq;
      if (col < 576) {
        const int hh = col / 96, d = col - hh * 96;
        const f32x4 v0 = acc[ai][bj][m][0], v1 = acc[ai][bj][m][1];
        const float sc = rq[ai * 4 + m];
        uint4 u; u.x = pack2(v0[0] * sc, v0[1] * sc); u.y = pack2(v0[2] * sc, v0[3] * sc); u.z = pack2(v1[0] * sc, v1[1] * sc); u.w = pack2(v1[2] * sc, v1[3] * sc);
        *(uint4*)(p->Q() + ((size_t)(b * 6 + hh) * TT + tb + lr) * 96 + d) = u;
      }
    }
  }
};
struct EpiKV {
  static constexpr bool PERM = true;
  const Params* p;
  DI void operator()(const acc_t& acc, int brow, int bcol, int wr, int wc, int fr, int fq, const float* rs) const {
    float rq[8];
#pragma unroll
    for (int i = 0; i < 8; ++i) rq[i] = rsqrtf(p->rss()[MT + brow + (i >> 2) * 128 + wr * 64 + (i & 3) * 16 + fr] * (1.f / 256.f) + 1e-6f);
    const int b = brow / TT, tb = brow - b * TT;
    EPI_LOOP8 {
      const int lr = ai * 128 + wr * 64 + m * 16 + fr, col = bcol + bj * 128 + wc * 32 + 8 * fq;
      const int hh = col >> 7, j = col & 127;
      const f32x4 v0 = acc[ai][bj][m][0], v1 = acc[ai][bj][m][1];
      const float sc = rq[ai * 4 + m];
      if (j < 64) {
        uint4 u; u.x = pack2(v0[0] * sc, v0[1] * sc); u.y = pack2(v0[2] * sc, v0[3] * sc); u.z = pack2(v1[0] * sc, v1[1] * sc); u.w = pack2(v1[2] * sc, v1[3] * sc);
        *(uint4*)(p->Kc() + ((size_t)(b * 6 + hh) * TT + tb + lr) * 96 + j) = u;
      } else {
        uint4 u; u.x = pack2(v0[0] * sc, v0[1] * sc); u.y = pack2(v0[2] * sc, v0[3] * sc); u.z = pack2(v1[0] * sc, v1[1] * sc); u.w = pack2(v1[2] * sc, v1[3] * sc);
        *(uint4*)(p->Vt() + ((size_t)(b * 6 + hh) * TT + tb + lr) * 64 + (j - 64)) = u;
      }
    }
  }
};

DI void transpose_tile(const float* __restrict__ W, int N, int k0, int n0, bf16_t* __restrict__ dst, int ldd,
                       int shift_from, int shift_by, const float* rowscale, float gscale, float* tile) {
  const int tid = otid();
  const int lane = tid & 63, wave = tid >> 6;
  float4 v[8];
#pragma unroll
  for (int i = 0; i < 8; ++i) {
    const int k = k0 + wave + 8 * i, n = n0 + lane * 4;
    v[i] = make_float4(0.f, 0.f, 0.f, 0.f);
    if (n < N) {
      v[i] = *(const float4*)(W + (size_t)k * N + n);
      const float sc = (rowscale ? rowscale[k] : 1.f) * gscale;
      v[i].x *= sc; v[i].y *= sc; v[i].z *= sc; v[i].w *= sc;
    }
  }
#pragma unroll
  for (int i = 0; i < 8; ++i) {
    *(float4*)(tile + (wave + 8 * i) * 260 + lane * 4) = v[i];
  }
  __syncthreads();
  {
    const int nn = tid >> 1, kq = (tid & 1) * 32;
    const int n = n0 + nn;
    if (n < N) {
      const int drow = n >= shift_from ? n + shift_by : n;
      bf16_t* dp = dst + (size_t)drow * ldd + k0 + kq;
#pragma unroll
      for (int j = 0; j < 4; ++j) {
        const float* tp = tile + (kq + 8 * j) * 260 + nn;
        uint4 u;
        u.x = pack2(tp[0 * 260], tp[1 * 260]);
        u.y = pack2(tp[2 * 260], tp[3 * 260]);
        u.z = pack2(tp[4 * 260], tp[5 * 260]);
        u.w = pack2(tp[6 * 260], tp[7 * 260]);
        *(uint4*)(dp + 8 * j) = u;
      }
    }
  }
  __syncthreads();
}

DI void transpose_layer(const Params& p, int l, int first, int step, float* tile) {
  const float qscale = 0.10206207261596577f * 1.4426950408889634f;
  for (int v = first; v < 728; v += step) {
    if (v < 144) {
      const int kt = v / 9, nt = v - kt * 9;
      transpose_tile(p.w_in + (size_t)l * 1024 * IN_COLS, IN_COLS, kt * 64, nt * 256, p.wt_in() + (size_t)l * NPW * 1024, 1024, 1292, 52, nullptr, 1.f, tile);
    } else if (v < 192) {
      const int w = v - 144, kt = w >> 2, nt = w & 3;
      transpose_tile(p.w_out + (size_t)l * 1024 * 1024, 1024, kt * 64, nt * 256, p.wt_out() + (size_t)l * 1024 * 1024, 1024, 1 << 30, 0, nullptr, 1.f, tile);
    } else if (v < 448) {
      const int w = v - 192, kt = w >> 4, nt = w & 15;
      transpose_tile(p.w_mlp1 + (size_t)l * 1024 * 4096, 4096, kt * 64, nt * 256, p.wt_m1() + (size_t)l * 4096 * 1024, 1024, 1 << 30, 0, nullptr, 1.f, tile);
    } else if (v < 704) {
      const int w = v - 448, kt = w >> 2, nt = w & 3;
      transpose_tile(p.w_mlp2 + (size_t)l * 4096 * 1024, 1024, kt * 64, nt * 256, p.wt_m2() + (size_t)l * 1024 * 4096, 4096, 1 << 30, 0, nullptr, 1.f, tile);
    } else if (v < 716) {
      const int w = v - 704, kt = w / 3, nt = w - kt * 3;
      transpose_tile(p.w_q_b + (size_t)l * 256 * 576, 576, kt * 64, nt * 256, p.wt_qb() + (size_t)l * NQ * 256, 256, 1 << 30, 0, p.q_a_norm_w + l * 256, qscale, tile);
    } else {
      const int w = v - 716, kt = w / 3, nt = w - kt * 3;
      transpose_tile(p.w_kv_b + (size_t)l * 256 * 768, 768, kt * 64, nt * 256, p.wt_kvb() + (size_t)l * 768 * 256, 256, 1 << 30, 0, p.kv_a_norm_w + l * 256, 1.f, tile);
    }
  }
}

DI void phase_prep(const Params& p, bf16_t* smem) {
  float* tile = (float*)smem;
  const int tid = otid();
  const int gtid = obid() * 512 + tid, gsz = ogrid_op() * 512;
  if (gtid < 16) p.ctr()[gtid] = 0;
  if (gtid < 512) {
    const int pos = gtid >> 3, pair = gtid & 7;
    const float inv = powf(10000.f, -(float)pair / 8.f);
    const float ang = (float)pos * inv;
    p.rope()[gtid * 2] = cosf(ang);
    p.rope()[gtid * 2 + 1] = sinf(ang);
  }
  for (int i = gtid; i < 2 * 212 * 1024; i += gsz) {
    const int l = i / (212 * 1024), rem = i - l * 212 * 1024, rr = rem >> 10, k = rem & 1023;
    const int row = rr < 52 ? 1292 + rr : 2144 + (rr - 52);
    p.wt_in()[((size_t)l * NPW + row) * 1024 + k] = 0;
  }
  for (int i = gtid; i < 2 * 192 * 256; i += gsz) {
    const int l = i / (192 * 256), rem = i - l * 192 * 256;
    p.wt_qb()[(size_t)l * NQ * 256 + 576 * 256 + rem] = 0;
  }
  transpose_layer(p, 0, obid(), ogrid(), tile);
  {
    const int nn = tid & 63, c8 = __builtin_amdgcn_readfirstlane(tid >> 6);
    for (int it = obid(); it < 128; it += ogrid()) {
      const int l = it >> 6, g = (it >> 4) & 3, nblk = it & 15;
      const int n = nblk * 64 + nn;
      const float* wo = p.w_out + (size_t)l * 1024 * 1024 + (size_t)(768 + g * 64) * 1024 + n;
      const float* pw = p.pool_w + ((size_t)l * 4 + g) * 4096 + c8 * 8 * 64;
      const float* ps = p.pool_scale + l * 256 + g * 64;
      float o[8];
#pragma unroll
      for (int e = 0; e < 8; ++e) o[e] = 0.f;
#pragma unroll 8
      for (int d = 0; d < 64; ++d) {
        const float wv = wo[(size_t)d * 1024] * ps[d];
#pragma unroll
        for (int e = 0; e < 8; ++e) o[e] += pw[e * 64 + d] * wv;
      }
      uint4 u;
      u.x = pack2(o[0], o[1]); u.y = pack2(o[2], o[3]); u.z = pack2(o[4], o[5]); u.w = pack2(o[6], o[7]);
      *(uint4*)(p.wt_out() + (size_t)l * 1024 * 1024 + (size_t)n * 1024 + 768 + g * 64 + c8 * 8) = u;
    }
  }
  {
    float* sc = (float*)smem;
    const int lane = tid & 63, wave = tid >> 6;
    bool loaded = false;
    for (int it = ogrid() - 1 - obid(); it < 192; it += ogrid()) {
      const int l = it / 96, cb = it - l * 96;
      if (!loaded) {
        for (int i = tid; i < 17 * 1024; i += 512) {
          const int ci = i >> 10, k = i & 1023;
          const float v = ci < 16 ? p.c[ci * 1024 + k] : p.c_ctx[k];
          sc[i] = silu(v);
        }
        loaded = true;
        __syncthreads();
      }
      float acc[17];
#pragma unroll
      for (int i = 0; i < 17; ++i) acc[i] = 0.f;
      const float* mw = p.mod_w + (size_t)l * 1024 * 6144 + cb * 64 + lane;
      for (int k0 = wave * 128; k0 < wave * 128 + 128; k0 += 16) {
        float wv[16];
#pragma unroll
        for (int j = 0; j < 16; ++j) wv[j] = mw[(size_t)(k0 + j) * 6144];
#pragma unroll
        for (int j = 0; j < 16; ++j)
#pragma unroll
          for (int i = 0; i < 17; ++i) acc[i] += sc[i * 1024 + k0 + j] * wv[j];
      }
      float* sred = (float*)smem + 17 * 1024;
      for (int w = 0; w < 8; ++w) {
        if (wave == w) {
#pragma unroll
          for (int i = 0; i < 17; ++i) {
            if (w == 0) sred[i * 64 + lane] = acc[i];
            else sred[i * 64 + lane] += acc[i];
          }
        }
        __syncthreads();
      }
      for (int i = tid; i < 17 * 64; i += 512) {
        const int ci = i >> 6, cc = i & 63;
        p.mods()[((size_t)l * 17 + ci) * 6144 + cb * 64 + cc] = sred[i] + p.mod_b[l * 6144 + cb * 64 + cc];
      }
      __syncthreads();
    }
  }
}

DI void phase_norm(const Params& p, int layer, int which) {
  const int tid = otid(), lane = tid & 63, wave = tid >> 6;
  if (which == 1) { const int gs_ = ogrid_op() * 512; for (int i = obid() * 512 + tid; i < 2 * MT; i += gs_) p.rss()[i] = 0.f; }
  const float* nwt = (which == 1 ? p.norm1_w : p.norm2_w) + layer * 1024;
  const int chunk = (MT + ogrid() - 1) / ogrid();
  const int r_begin = obid() * chunk, r_end = min(MT, r_begin + chunk);
  float4 fw[4], fs[4];
  int cur_ci = -1;
  for (int r = r_begin + wave; r < r_end; r += 16) {
    const int r2 = r + 8;
    const bool has2 = r2 < r_end;
    const int b = r / TT, t = r - b * TT, b2 = r2 / TT, t2 = r2 - b2 * TT;
    const bool skip1 = t >= LSEQ && layer == 1 && which == 2;
    const bool skip2 = !has2 || (t2 >= LSEQ && layer == 1 && which == 2);
    const float* src1 = (layer == 0 && which == 1) ? in_row(p, b, t) : res_row(p, b, t);
    const float* src2 = (layer == 0 && which == 1) ? in_row(p, has2 ? b2 : b, has2 ? t2 : t) : res_row(p, has2 ? b2 : b, has2 ? t2 : t);
    float4 v1[4], v2[4];
#pragma unroll
    for (int i = 0; i < 4; ++i) {
      v1[i] = *(const float4*)(src1 + i * 256 + lane * 4);
      v2[i] = *(const float4*)(src2 + i * 256 + lane * 4);
    }
#pragma unroll
    for (int half = 0; half < 2; ++half) {
      const bool skip = half ? skip2 : skip1;
      if (skip) continue;
      const int rr = half ? r2 : r, bb = half ? b2 : b, tt = half ? t2 : t;
      const int ci = tt >= LSEQ ? 16 : bb;
      if (ci != cur_ci) {
        cur_ci = ci;
        const float* md = p.mods() + ((size_t)layer * 17 + ci) * 6144 + (which == 1 ? 0 : 3072);
#pragma unroll
        for (int i = 0; i < 4; ++i) {
          const int k = i * 256 + lane * 4;
          const float4 w = *(const float4*)(nwt + k);
          const float4 sc = *(const float4*)(md + 1024 + k);
          fs[i] = *(const float4*)(md + k);
          fw[i] = make_float4(w.x * (1.f + sc.x), w.y * (1.f + sc.y), w.z * (1.f + sc.z), w.w * (1.f + sc.w));
        }
      }
      float ss = 0.f;
#pragma unroll
      for (int i = 0; i < 4; ++i) {
        const float4 v = half ? v2[i] : v1[i];
        ss += v.x * v.x + v.y * v.y + v.z * v.z + v.w * v.w;
      }
      ss = wave_sum(ss);
      const float rstd = rsqrtf(ss * (1.f / 1024.f) + 1e-6f);
#pragma unroll
      for (int i = 0; i < 4; ++i) {
        const float4 v = half ? v2[i] : v1[i];
        uint2 u;
        u.x = pack2(v.x * rstd * fw[i].x + fs[i].x, v.y * rstd * fw[i].y + fs[i].y);
        u.y = pack2(v.z * rstd * fw[i].z + fs[i].z, v.w * rstd * fw[i].w + fs[i].w);
        *(uint2*)(p.xn() + (size_t)rr * DM + i * 256 + lane * 4) = u;
      }
    }
  }
}

DI void phase_final(const Params& p) {
  const int tid = otid(), lane = tid & 63, wave = tid >> 6;
  float4 fw[4];
#pragma unroll
  for (int i = 0; i < 4; ++i) fw[i] = *(const float4*)(p.final_norm_w + i * 256 + lane * 4);
  const int NR = NB * LSEQ;
  for (int r = obid() * 8 + wave; r < NR; r += ogrid() * 16) {
    const int r2 = r + ogrid() * 8;
    const bool has2 = r2 < NR;
    float* row1 = p.out + (size_t)r * DM;
    float* row2 = p.out + (size_t)(has2 ? r2 : r) * DM;
    float4 v1[4], v2[4];
#pragma unroll
    for (int i = 0; i < 4; ++i) {
      v1[i] = *(const float4*)(row1 + i * 256 + lane * 4);
      v2[i] = *(const float4*)(row2 + i * 256 + lane * 4);
    }
#pragma unroll
    for (int half = 0; half < 2; ++half) {
      if (half && !has2) continue;
      float* row = half ? row2 : row1;
      float ss = 0.f;
#pragma unroll
      for (int i = 0; i < 4; ++i) {
        const float4 v = half ? v2[i] : v1[i];
        ss += v.x * v.x + v.y * v.y + v.z * v.z + v.w * v.w;
      }
      ss = wave_sum(ss);
      const float rstd = rsqrtf(ss * (1.f / 1024.f) + 1e-6f);
#pragma unroll
      for (int i = 0; i < 4; ++i) {
        const float4 v = half ? v2[i] : v1[i];
        float4 o;
        o.x = v.x * rstd * fw[i].x; o.y = v.y * rstd * fw[i].y; o.z = v.z * rstd * fw[i].z; o.w = v.w * rstd * fw[i].w;
        *(float4*)(row + i * 256 + lane * 4) = o;
      }
    }
  }
}

DI int map_mtile(int skip_ctx, int i) { return skip_ctx ? (i >> 4) * 17 + (i & 15) : i; }

struct UnitOrder {
  int nM, nN, skip;
  DI bool operator()(int i, int& br, int& bc) const {
    int pm, pn;
    if (!unit_next(i, nM, nN, pm, pn)) return false;
    br = map_mtile(skip, pm) * 256;
    bc = pn * 256;
    return true;
  }
};
DI void phase_gemm_in(const Params& p, int layer, bf16_t* smem) {
  EpiProj epi{p.proj(), p.rss()};
  gemm256<false>(p.xn(), DM, p.wt_in() + (size_t)layer * NPW * 1024, 1024, 1024, smem, epi, UnitOrder{MT / 256, NPW / 256, 0});
}
DI void phase_gemm_qkv(const Params& p, int layer, bf16_t* smem) {
  EpiQ epq{&p};
  EpiKV epk{&p};
  int pm, pn;
  for (int i = 0; unit_next(i, MT / 256, 6, pm, pn); ++i) {
    if (pn < 3) gemm256_unit<false>(p.proj() + C_QA, NP, p.wt_qb() + (size_t)layer * NQ * 256, 256, 256, pm * 256, pn * 256, smem, epq);
    else gemm256_unit<false>(p.proj() + C_KVA, NP, p.wt_kvb() + (size_t)layer * 768 * 256, 256, 256, pm * 256, (pn - 3) * 256, smem, epk);
  }
}
DI void phase_gemm_out(const Params& p, int layer, bf16_t* smem) {
  EpiRes epi{&p, layer, 2048, layer == 0};
  const int skip = layer == 1;
  gemm256<false>(p.xn(), DM, p.wt_out() + (size_t)layer * 1024 * 1024, 1024, 1024, smem, epi, UnitOrder{skip ? NB * 16 : MT / 256, 4, skip});
}
DI void phase_gemm_m1(const Params& p, int layer, bf16_t* smem) {
  EpiRelu2 epi{p.hidden()};
  const int skip = layer == 1;
  gemm256<false>(p.xn(), DM, p.wt_m1() + (size_t)layer * 4096 * 1024, 1024, 1024, smem, epi, UnitOrder{skip ? NB * 16 : MT / 256, 16, skip});
}
DI void phase_gemm_m2(const Params& p, int layer, bf16_t* smem) {
  EpiRes epi{&p, layer, 5120, false};
  const int skip = layer == 1;
  gemm256<false>(p.hidden(), DFF, p.wt_m2() + (size_t)layer * 1024 * 4096, 4096, 4096, smem, epi, UnitOrder{skip ? NB * 16 : MT / 256, 4, skip});
}

DI void phase_tokops(const Params& p, int layer) {
  const int tid = otid();
  const int gtid = obid() * 512 + tid, gsz = ogrid_op() * 512;
  {
    const int nrt = gsz / 112;
    if (gtid < nrt * 112) {
      const int cg8 = (gtid % 112) * 8;
      const float* cw = p.conv_w + (size_t)layer * 4 * 896 + cg8;
      const float* cbp = p.conv_b + layer * 896 + cg8;
      float w[4][8], bias[8];
#pragma unroll
      for (int j = 0; j < 4; ++j)
#pragma unroll
        for (int e = 0; e < 8; ++e) w[j][e] = cw[j * 896 + e];
#pragma unroll
      for (int e = 0; e < 8; ++e) bias[e] = cbp[e];
      for (int run = gtid / 112; run < MT / 8; run += nrt) {
        const int r0 = run * 8;
        const int b = r0 / TT, tb = r0 - b * TT;
        const int seg_lo = tb < LSEQ ? 0 : LSEQ, seg_hi = tb < LSEQ ? LSEQ : TT;
        uint4 raw[11];
#pragma unroll
        for (int i = 0; i < 11; ++i) {
          const int tt = tb - 1 + i;
          if (tt >= seg_lo && tt < seg_hi) raw[i] = *(const uint4*)(p.proj() + ((size_t)b * TT + tt) * NP + C_XBC + cg8);
          else raw[i] = make_uint4(0, 0, 0, 0);
        }
#pragma unroll
        for (int o = 0; o < 8; ++o) {
          float a[8];
#pragma unroll
          for (int e = 0; e < 8; ++e) a[e] = bias[e];
#pragma unroll
          for (int j = 0; j < 4; ++j) {
            const uint4 u = raw[o + j];
            a[0] += w[j][0] * bflo(u.x); a[1] += w[j][1] * bfhi(u.x);
            a[2] += w[j][2] * bflo(u.y); a[3] += w[j][3] * bfhi(u.y);
            a[4] += w[j][4] * bflo(u.z); a[5] += w[j][5] * bfhi(u.z);
            a[6] += w[j][6] * bflo(u.w); a[7] += w[j][7] * bfhi(u.w);
          }
          uint4 ov;
          ov.x = pack2(silu(a[0]), silu(a[1])); ov.y = pack2(silu(a[2]), silu(a[3]));
          ov.z = pack2(silu(a[4]), silu(a[5])); ov.w = pack2(silu(a[6]), silu(a[7]));
          *(uint4*)(p.xbc() + ((size_t)b * TT + tb + o) * 896 + cg8) = ov;
        }
      }
    }
  }
  for (int idx = gtid; idx < MT * 2; idx += gsz) {
    const int r = idx >> 1, axis = idx & 1;
    const int b = r / TT, t = r - b * TT;
    const bf16_t* src = p.proj() + (size_t)r * NP + C_KR + axis * 16;
    const uint4 u1 = *(const uint4*)src, u2 = *(const uint4*)(src + 8);
    uint4 o1 = u1, o2 = u2;
    if (t < LSEQ) {
      const int pos = axis ? (t & 63) : (t >> 6);
      const float4* rp = (const float4*)(p.rope() + pos * 16);
      const float4 c0 = rp[0], c1 = rp[1], c2 = rp[2], c3 = rp[3];
      o1.x = pack2(bflo(u1.x) * c0.x - bflo(u2.x) * c0.y, bfhi(u1.x) * c0.z - bfhi(u2.x) * c0.w);
      o1.y = pack2(bflo(u1.y) * c1.x - bflo(u2.y) * c1.y, bfhi(u1.y) * c1.z - bfhi(u2.y) * c1.w);
      o1.z = pack2(bflo(u1.z) * c2.x - bflo(u2.z) * c2.y, bfhi(u1.z) * c2.z - bfhi(u2.z) * c2.w);
      o1.w = pack2(bflo(u1.w) * c3.x - bflo(u2.w) * c3.y, bfhi(u1.w) * c3.z - bfhi(u2.w) * c3.w);
      o2.x = pack2(bflo(u2.x) * c0.x + bflo(u1.x) * c0.y, bfhi(u2.x) * c0.z + bfhi(u1.x) * c0.w);
      o2.y = pack2(bflo(u2.y) * c1.x + bflo(u1.y) * c1.y, bfhi(u2.y) * c1.z + bfhi(u1.y) * c1.w);
      o2.z = pack2(bflo(u2.z) * c2.x + bflo(u1.z) * c2.y, bfhi(u2.z) * c2.z + bfhi(u1.z) * c2.w);
      o2.w = pack2(bflo(u2.w) * c3.x + bflo(u1.w) * c3.y, bfhi(u2.w) * c3.z + bfhi(u1.w) * c3.w);
    }
#pragma unroll
    for (int hh = 0; hh < 6; ++hh) {
      bf16_t* dst = p.Kc() + ((size_t)(b * 6 + hh) * TT + t) * 96 + 64 + axis * 16;
      *(uint4*)dst = o1;
      *(uint4*)(dst + 8) = o2;
    }
  }
  for (int idx = gtid; idx < (MT / 8) * 32; idx += gsz) {
    const int run = idx >> 5, cgp = idx & 31;
    const int r0 = run * 8;
    const int b = r0 / TT, t0 = r0 - b * TT;
    const int seg_lo = t0 < LSEQ ? 0 : LSEQ, seg_hi = t0 < LSEQ ? LSEQ : TT;
    const int g = cgp >> 3, half = 1 << g;
    const bf16_t* base = p.proj() + (size_t)b * TT * NP + C_POOL + cgp * 8;
    float a[8];
#pragma unroll
    for (int e = 0; e < 8; ++e) a[e] = 0.f;
    for (int tt = max(t0 - half, seg_lo); tt < min(t0 + half, seg_hi); ++tt) {
      const uint4 u = *(const uint4*)(base + (size_t)tt * NP);
      a[0] += bflo(u.x); a[1] += bfhi(u.x); a[2] += bflo(u.y); a[3] += bfhi(u.y);
      a[4] += bflo(u.z); a[5] += bfhi(u.z); a[6] += bflo(u.w); a[7] += bfhi(u.w);
    }
#pragma unroll
    for (int o = 0; o < 8; ++o) {
      const int t = t0 + o;
      const int lo = max(t - half, seg_lo), hi = min(t + half, seg_hi);
      const float inv = 1.f / (float)(hi - lo);
      const uint4 u = *(const uint4*)(base + (size_t)t * NP);
      uint4 ov;
      ov.x = pack2(a[0] * inv - bflo(u.x), a[1] * inv - bfhi(u.x));
      ov.y = pack2(a[2] * inv - bflo(u.y), a[3] * inv - bfhi(u.y));
      ov.z = pack2(a[4] * inv - bflo(u.z), a[5] * inv - bfhi(u.z));
      ov.w = pack2(a[6] * inv - bflo(u.w), a[7] * inv - bfhi(u.w));
      *(uint4*)(p.xn() + ((size_t)b * TT + t) * DM + 768 + cgp * 8) = ov;
      if (o < 7) {
        const int tin = t + half, tout = t - half;
        if (tin < seg_hi) {
          const uint4 w = *(const uint4*)(base + (size_t)tin * NP);
          a[0] += bflo(w.x); a[1] += bfhi(w.x); a[2] += bflo(w.y); a[3] += bfhi(w.y);
          a[4] += bflo(w.z); a[5] += bfhi(w.z); a[6] += bflo(w.w); a[7] += bfhi(w.w);
        }
        if (tout >= seg_lo) {
          const uint4 w = *(const uint4*)(base + (size_t)tout * NP);
          a[0] -= bflo(w.x); a[1] -= bfhi(w.x); a[2] -= bflo(w.y); a[3] -= bfhi(w.y);
          a[4] -= bflo(w.z); a[5] -= bfhi(w.z); a[6] -= bflo(w.w); a[7] -= bfhi(w.w);
        }
      }
    }
  }
}

typedef short s16x4 __attribute__((ext_vector_type(4)));
DI s16x4 tr4(const bf16_t* M, int LD, int krow, int ccol, int lane) {
  const int q = (lane & 15) >> 2, pp = lane & 3, blk = (lane >> 4) & 1;
  return __builtin_amdgcn_ds_read_tr16_b64_v4i16((LAS s16x4*)(LAS bf16_t*)(M + (krow + q) * LD + ccol + 16 * blk + 4 * pp));
}
DI bf16x8 cat8(s16x4 lo, s16x4 hi) { return __builtin_shufflevector(lo, hi, 0, 1, 2, 3, 4, 5, 6, 7); }

DI void ssd_store_x(bf16_t* sX, bf16_t* sXw, int row, int xch, uint4 g, float wl) {
  *(uint4*)(sX + row * 72 + xch) = g;
  uint4 u;
  u.x = pack2(bflo(g.x) * wl, bfhi(g.x) * wl);
  u.y = pack2(bflo(g.y) * wl, bfhi(g.y) * wl);
  u.z = pack2(bflo(g.z) * wl, bfhi(g.z) * wl);
  u.w = pack2(bflo(g.w) * wl, bfhi(g.w) * wl);
  *(uint4*)(sXw + row * 72 + xch) = u;
}
DI void ssd_job(const Params& p, int layer, int jobpair, bf16_t* smem_blk) {
  const int tid_full = otid(), jh = tid_full >> 8, tid = tid_full & 255;
  const int lane = tid & 63, wave = tid >> 6, r = lane & 31, h = lane >> 5;
  const int job = jobpair * 2 + jh;
  bf16_t* smem = smem_blk + jh * SSD_LDS_EL;
  const int b = job / 12, dir = (job / 6) & 1, head = job % 6, grp = head / 3;
  bf16_t* sB = smem;
  bf16_t* sC = sB + 64 * 136;
  bf16_t* sX = sC + 64 * 136;
  bf16_t* sXw = sX + 64 * 72;
  bf16_t* sH = sXw + 64 * 72;
  float* sfl = (float*)(sH + 64 * 136);
  const float a = -__expf(p.a_log[layer * 12 + dir * 6 + head]);
  const float dtb = p.dt_bias[layer * 12 + dir * 6 + head];
  for (int i = tid; i < 64 * 136 / 2; i += 256) ((unsigned*)sH)[i] = 0u;
  f32x16 hacc[2];
  hacc[0] = zero16();
  hacc[1] = zero16();
  const int pt = wave >> 1, lt = wave & 1;
  const int lidx = lt * 32 + r;
  const int brow_ = tid >> 4, bch = (tid & 15) * 8;
  const int xrow_ = tid >> 3, xch = (tid & 7) * 8;
  uint4 gB0, gB1, gB2, gB3, gC0, gC1, gC2, gC3, gX0, gX1;
  float dtraw = 0.f;
#define SSD_LOAD(it_)                                                                                  \
  do {                                                                                                 \
    const int sc_ = dir == 0 ? ((it_) < 4 ? 64 + (it_) : (it_) - 4) : 67 - (it_);                      \
    const bf16_t* base_ = p.xbc() + ((size_t)b * TT + sc_ * 64) * 896;                                 \
    if (wave == 0) {                                                                                   \
      const int tok_ = dir == 0 ? lane : 63 - lane;                                                    \
      dtraw = bf2f(p.proj()[((size_t)b * TT + sc_ * 64 + tok_) * NP + C_DT + dir * 6 + head]);         \
    }                                                                                                  \
    const bf16_t* bp_ = base_ + (size_t)brow_ * 896 + 384 + grp * 128 + bch;                            \
    gB0 = *(const uint4*)(bp_); gB1 = *(const uint4*)(bp_ + 16 * 896);                                  \
    gB2 = *(const uint4*)(bp_ + 32 * 896); gB3 = *(const uint4*)(bp_ + 48 * 896);                       \
    gC0 = *(const uint4*)(bp_ + 256); gC1 = *(const uint4*)(bp_ + 16 * 896 + 256);                      \
    gC2 = *(const uint4*)(bp_ + 32 * 896 + 256); gC3 = *(const uint4*)(bp_ + 48 * 896 + 256);           \
    const bf16_t* xp_ = base_ + (size_t)xrow_ * 896 + head * 64 + xch;                                  \
    gX0 = *(const uint4*)(xp_); gX1 = *(const uint4*)(xp_ + 32 * 896);                                  \
  } while (0)
#define SSD_SCAN(par_)                                                                                 \
  do {                                                                                                 \
    float* fl_ = sfl + (par_) * 200;                                                                   \
    const int tok = dir == 0 ? lane : 63 - lane;                                                       \
    const float xx = dtraw + dtb;                                                                      \
    const float dt = xx > 20.f ? xx : __logf(1.f + __expf(xx));                                        \
    float cs = dt * a;                                                                                 \
    _Pragma("unroll") for (int off = 1; off < 64; off <<= 1) {                                         \
      const float o_ = __shfl_up(cs, off);                                                             \
      if (lane >= off) cs += o_;                                                                       \
    }                                                                                                  \
    const float tot = __shfl(cs, 63);                                                                  \
    fl_[tok] = dt;                                                                                     \
    fl_[64 + tok] = cs;                                                                                \
    fl_[128 + tok] = dt * __expf(tot - cs);                                                            \
    if (lane == 0) fl_[192] = tot;                                                                     \
  } while (0)
  SSD_LOAD(0);
  if (wave == 0) SSD_SCAN(0);
  __syncthreads();
  for (int it = 0; it < 68; ++it) {
    const int sc = dir == 0 ? (it < 4 ? 64 + it : it - 4) : 67 - it;
    const size_t r0 = (size_t)b * TT + sc * 64;
    const float* fl = sfl + (it & 1) * 200;
    const float* sdt = fl;
    const float* scs = fl + 64;
    const float* sw = fl + 128;
    *(uint4*)(sB + (brow_ + 0) * 136 + bch) = gB0;  *(uint4*)(sC + (brow_ + 0) * 136 + bch) = gC0;
    *(uint4*)(sB + (brow_ + 16) * 136 + bch) = gB1; *(uint4*)(sC + (brow_ + 16) * 136 + bch) = gC1;
    *(uint4*)(sB + (brow_ + 32) * 136 + bch) = gB2; *(uint4*)(sC + (brow_ + 32) * 136 + bch) = gC2;
    *(uint4*)(sB + (brow_ + 48) * 136 + bch) = gB3; *(uint4*)(sC + (brow_ + 48) * 136 + bch) = gC3;
    ssd_store_x(sX, sXw, xrow_, xch, gX0, sw[xrow_]);
    ssd_store_x(sX, sXw, xrow_ + 32, xch, gX1, sw[xrow_ + 32]);
    { const int itn = it + 1 < 68 ? it + 1 : 67; SSD_LOAD(itn); }
    __syncthreads();
    bf16x8 creg[8];
#pragma unroll
    for (int ks = 0; ks < 8; ++ks) creg[ks] = *(const bf16x8*)(sC + lidx * 136 + ks * 16 + h * 8);
    f32x16 yacc = zero16();
    const float csl = scs[lidx];
#pragma unroll
    for (int st = 0; st < 2; ++st) {
      const bool skip = dir == 0 ? (st > lt) : (st < lt);
      if (!skip) {
        bf16x8 bf_[8];
#pragma unroll
        for (int ks = 0; ks < 8; ++ks) bf_[ks] = *(const bf16x8*)(sB + (st * 32 + r) * 136 + ks * 16 + h * 8);
        const s16x4 x0 = tr4(sX, 72, st * 32 + 4 * h, pt * 32, lane), x1 = tr4(sX, 72, st * 32 + 8 + 4 * h, pt * 32, lane);
        const s16x4 x2 = tr4(sX, 72, st * 32 + 16 + 4 * h, pt * 32, lane), x3 = tr4(sX, 72, st * 32 + 24 + 4 * h, pt * 32, lane);
        __builtin_amdgcn_sched_barrier(0);
        f32x16 sv = zero16();
#pragma unroll
        for (int ks = 0; ks < 8; ++ks) sv = MFMA(bf_[ks], creg[ks], sv);
#pragma unroll
        for (int g = 0; g < 4; ++g) {
          const float4 c4 = *(const float4*)(scs + st * 32 + 8 * g + 4 * h);
          const float4 d4 = *(const float4*)(sdt + st * 32 + 8 * g + 4 * h);
          const float cc[4] = {c4.x, c4.y, c4.z, c4.w};
          const float dd[4] = {d4.x, d4.y, d4.z, d4.w};
#pragma unroll
          for (int e = 0; e < 4; ++e) {
            const int sidx = st * 32 + 8 * g + 4 * h + e;
            const bool valid = dir == 0 ? (sidx <= lidx) : (sidx >= lidx);
            const float arg = valid ? (csl - cc[e]) : 0.f;
            const float dec = valid ? __expf(arg) * dd[e] : 0.f;
            sv[4 * g + e] *= dec;
          }
        }
        yacc = MFMA(cat8(x0, x1), pack8(sv, 0), yacc);
        yacc = MFMA(cat8(x2, x3), pack8(sv, 1), yacc);
      }
    }
    {
      bf16x8 hf_[8];
#pragma unroll
      for (int ks = 0; ks < 8; ++ks) hf_[ks] = *(const bf16x8*)(sH + (pt * 32 + r) * 136 + ks * 16 + h * 8);
      __builtin_amdgcn_sched_barrier(0);
      f32x16 yo = zero16();
#pragma unroll
      for (int ks = 0; ks < 8; ++ks) yo = MFMA(hf_[ks], creg[ks], yo);
      const float el = __expf(csl);
#pragma unroll
      for (int i = 0; i < 16; ++i) yacc[i] += el * yo[i];
    }
    {
      bf16_t* yout = p.yssd() + ((size_t)dir * MT + r0 + lidx) * 384 + head * 64 + pt * 32 + 4 * h;
#pragma unroll
      for (int g = 0; g < 4; ++g) {
        uint2 u;
        u.x = pack2(yacc[4 * g + 0], yacc[4 * g + 1]);
        u.y = pack2(yacc[4 * g + 2], yacc[4 * g + 3]);
        *(uint2*)(yout + 8 * g) = u;
      }
    }
    {
      const float et = __expf(fl[192]);
#pragma unroll
      for (int q = 0; q < 2; ++q)
#pragma unroll
        for (int i = 0; i < 16; ++i) hacc[q][i] *= et;
#pragma unroll
      for (int half = 0; half < 2; ++half) {
        bf16x8 av_[2], bv_[2][2];
#pragma unroll
        for (int k2 = 0; k2 < 2; ++k2) {
          const int ks = half * 2 + k2;
          av_[k2] = cat8(tr4(sXw, 72, ks * 16 + 8 * h, pt * 32, lane), tr4(sXw, 72, ks * 16 + 8 * h + 4, pt * 32, lane));
#pragma unroll
          for (int q = 0; q < 2; ++q) {
            const int nt = (wave & 1) * 2 + q;
            bv_[q][k2] = cat8(tr4(sB, 136, ks * 16 + 8 * h, nt * 32, lane), tr4(sB, 136, ks * 16 + 8 * h + 4, nt * 32, lane));
          }
        }
        __builtin_amdgcn_sched_barrier(0);
#pragma unroll
        for (int k2 = 0; k2 < 2; ++k2)
#pragma unroll
          for (int q = 0; q < 2; ++q) hacc[q] = MFMA(av_[k2], bv_[q][k2], hacc[q]);
        __builtin_amdgcn_sched_barrier(0);
      }
    }
    if (wave == 0 && it + 1 < 68) SSD_SCAN((it + 1) & 1);
    __syncthreads();
#pragma unroll
    for (int q = 0; q < 2; ++q) {
      const int nt = (wave & 1) * 2 + q;
#pragma unroll
      for (int reg = 0; reg < 16; ++reg) sH[(pt * 32 + crow(reg, h)) * 136 + nt * 32 + r] = f2bf(hacc[q][reg]);
    }
  }
#undef SSD_SCAN
#undef SSD_LOAD
  asm volatile("s_waitcnt vmcnt(0)" ::: "memory");
  __syncthreads();
  if (tid_full == 0) {
    __builtin_amdgcn_fence(__ATOMIC_RELEASE, "agent");
    asm volatile("s_waitcnt vmcnt(0)" ::: "memory");
    xb_add(p.bar() + 3700 + layer * 16 + b, 2u);
  }
  __syncthreads();
}

DI unsigned rope_word(unsigned mine, unsigned other, float4 cs, int h) {
  const float m0 = bflo(mine), m1 = bfhi(mine), o0 = bflo(other), o1 = bfhi(other);
  const float r0 = h ? (m0 * cs.x + o0 * cs.y) : (m0 * cs.x - o0 * cs.y);
  const float r1 = h ? (m1 * cs.z + o1 * cs.w) : (m1 * cs.z - o1 * cs.w);
  return pack2(r0, r1);
}
DI void attn_item(const Params& p, int b, int hh, int q0, int k_begin, int nkt, bf16_t* smem) {
  const int tid = otid(), lane = tid & 63, wave = tid >> 6, r = lane & 31, h = lane >> 5;
  const bf16_t* Kg = p.Kc() + ((size_t)(b * 6 + hh) * TT + k_begin) * 96;
  const bf16_t* Vg = p.Vt() + ((size_t)(b * 6 + hh) * TT + k_begin) * 64;
  const int qrow = q0 + wave * 32 + r;
  bf16x8 qreg[6];
  {
    const bf16_t* qp = p.Q() + ((size_t)(b * 6 + hh) * TT + qrow) * 96 + h * 8;
#pragma unroll
    for (int ks = 0; ks < 6; ++ks) qreg[ks] = *(const bf16x8*)(qp + ks * 16);
  }
  if (q0 < LSEQ) {
#pragma unroll
    for (int ax = 0; ax < 2; ++ax) {
      const int pos = ax ? (qrow & 63) : (qrow >> 6);
      const float* rp = p.rope() + pos * 16;
      const uint4 me = __builtin_bit_cast(uint4, qreg[4 + ax]);
      uint4 rr;
      rr.x = rope_word(me.x, __shfl_xor(me.x, 32), *(const float4*)(rp + 0), h);
      rr.y = rope_word(me.y, __shfl_xor(me.y, 32), *(const float4*)(rp + 4), h);
      rr.z = rope_word(me.z, __shfl_xor(me.z, 32), *(const float4*)(rp + 8), h);
      rr.w = rope_word(me.w, __shfl_xor(me.w, 32), *(const float4*)(rp + 12), h);
      qreg[4 + ax] = __builtin_bit_cast(bf16x8, rr);
    }
  }
  bf16_t* sK = smem;
  bf16_t* sV = smem + 2 * 64 * 104;
  uint4 rk0, rk1 = make_uint4(0u, 0u, 0u, 0u), rv;
  const int vrow = tid >> 3, vch = (tid & 7) * 8;
  const int kc1 = tid + 512;
  const int krow0 = tid / 12, kch0 = tid - krow0 * 12, krow1 = kc1 / 12, kch1 = kc1 - krow1 * 12;
#define K_LOAD(t_)                                                         \
  do {                                                                     \
    const bf16_t* kg_ = Kg + (size_t)(t_) * 64 * 96;                       \
    rk0 = *(const uint4*)(kg_ + (size_t)tid * 8);                          \
    if (tid < 256) rk1 = *(const uint4*)(kg_ + (size_t)kc1 * 8);           \
  } while (0)
#define K_STORE(buf_)                                                                      \
  do {                                                                                     \
    *(uint4*)(sK + ((buf_) * 64 + krow0) * 104 + kch0 * 8) = rk0;                          \
    if (tid < 256) *(uint4*)(sK + ((buf_) * 64 + krow1) * 104 + kch1 * 8) = rk1;           \
  } while (0)
#define V_LOAD(t_) rv = *(const uint4*)(Vg + (size_t)(t_) * 64 * 64 + (size_t)tid * 8)
#define V_STORE(buf_)                                                                      \
  do {                                                                                     \
    *(uint4*)(sV + ((buf_) * 64 + vrow) * 72 + vch) = rv;                                  \
  } while (0)
#define S_TILE(dst, buf_)                                                                                      \
  do {                                                                                                         \
    bf16x8 kf_[6];                                                                                             \
    const bf16_t* kb_ = sK + ((buf_) * 64 + r) * 104 + h * 8;                                                  \
    _Pragma("unroll") for (int ks = 0; ks < 6; ++ks) kf_[ks] = *(const bf16x8*)(kb_ + ks * 16);                \
    __builtin_amdgcn_sched_barrier(0);                                                                         \
    dst[0] = zero16();                                                                                         \
    _Pragma("unroll") for (int ks = 0; ks < 6; ++ks) dst[0] = MFMA(kf_[ks], qreg[ks], dst[0]);                 \
    __builtin_amdgcn_sched_barrier(0);                                                                         \
    _Pragma("unroll") for (int ks = 0; ks < 6; ++ks) kf_[ks] = *(const bf16x8*)(kb_ + 32 * 104 + ks * 16);     \
    __builtin_amdgcn_sched_barrier(0);                                                                         \
    dst[1] = zero16();                                                                                         \
    _Pragma("unroll") for (int ks = 0; ks < 6; ++ks) dst[1] = MFMA(kf_[ks], qreg[ks], dst[1]);                 \
    __builtin_amdgcn_sched_barrier(0);                                                                         \
  } while (0)
  K_LOAD(0); V_LOAD(0);
  K_STORE(0); V_STORE(0);
  if (nkt > 1) { K_LOAD(1); K_STORE(1); }
  __syncthreads();
  f32x16 o[2], o2, sc[2], negm;
  o[0] = zero16();
  o[1] = zero16();
  o2 = zero16();
  negm = zero16();
  bf16x8 ones;
  {
    const unsigned w = r == 0 ? 0x3F803F80u : 0u;
    uint4 u; u.x = w; u.y = w; u.z = w; u.w = w;
    ones = __builtin_bit_cast(bf16x8, u);
  }
#define S_CHAIN(dst, buf_)                                                                                 \
  do {                                                                                                     \
    bf16x8 kf_[6];                                                                                         \
    const bf16_t* kb_ = sK + ((buf_) * 64 + r) * 104 + h * 8;                                              \
    _Pragma("unroll") for (int ks = 0; ks < 6; ++ks) kf_[ks] = *(const bf16x8*)(kb_ + ks * 16);            \
    __builtin_amdgcn_sched_barrier(0);                                                                     \
    dst[0] = negm;                                                                                         \
    __builtin_amdgcn_s_setprio(1);                                                                         \
    _Pragma("unroll") for (int ks = 0; ks < 6; ++ks) dst[0] = MFMA(kf_[ks], qreg[ks], dst[0]);             \
    __builtin_amdgcn_s_setprio(0);                                                                         \
    __builtin_amdgcn_sched_barrier(0);                                                                     \
    _Pragma("unroll") for (int ks = 0; ks < 6; ++ks) kf_[ks] = *(const bf16x8*)(kb_ + 32 * 104 + ks * 16); \
    __builtin_amdgcn_sched_barrier(0);                                                                     \
    dst[1] = negm;                                                                                         \
    __builtin_amdgcn_s_setprio(1);                                                                         \
    _Pragma("unroll") for (int ks = 0; ks < 6; ++ks) dst[1] = MFMA(kf_[ks], qreg[ks], dst[1]);             \
    __builtin_amdgcn_s_setprio(0);                                                                         \
    __builtin_amdgcn_sched_barrier(0);                                                                     \
  } while (0)
#define ATT_STEP(sc_, sn_, kt_)                                                                            \
  do {                                                                                                     \
    const int buf = (kt_) & 1;                                                                             \
    if ((kt_) + 2 < nkt) K_LOAD((kt_) + 2);                                                                \
    if ((kt_) + 1 < nkt) { V_LOAD((kt_) + 1); S_CHAIN(sn_, buf ^ 1); }                                     \
    bf16x8 vf_[8];                                                                                         \
    _Pragma("unroll") for (int mt = 0; mt < 2; ++mt)                                                       \
    _Pragma("unroll") for (int s2 = 0; s2 < 2; ++s2)                                                       \
    _Pragma("unroll") for (int dt = 0; dt < 2; ++dt) {                                                     \
      const bf16_t* vt_ = sV + buf * 64 * 72;                                                              \
      vf_[(mt * 2 + s2) * 2 + dt] = cat8(tr4(vt_, 72, mt * 32 + 16 * s2 + 4 * h, dt * 32, lane),           \
                                         tr4(vt_, 72, mt * 32 + 16 * s2 + 8 + 4 * h, dt * 32, lane));      \
    }                                                                                                      \
    __builtin_amdgcn_sched_barrier(0);                                                                     \
    float mx = sc_[0][0];                                                                                  \
    _Pragma("unroll") for (int i = 1; i < 16; ++i) mx = fmaxf(mx, sc_[0][i]);                              \
    _Pragma("unroll") for (int i = 0; i < 16; ++i) mx = fmaxf(mx, sc_[1][i]);                              \
    mx = fmaxf(mx, __shfl_xor(mx, 32));                                                                    \
    if ((kt_) == 0 || __builtin_amdgcn_ballot_w64(mx > 8.f) != 0ull) {                                     \
      const float delta = ((kt_) == 0 || mx > 8.f) ? mx : 0.f;                                             \
      const float alpha = (kt_) == 0 ? 0.f : __builtin_amdgcn_exp2f(-delta);                               \
      _Pragma("unroll") for (int i = 0; i < 16; ++i) {                                                     \
        o[0][i] *= alpha; o[1][i] *= alpha; o2[i] *= alpha;                                                \
        sc_[0][i] -= delta; sc_[1][i] -= delta; sn_[0][i] -= delta; sn_[1][i] -= delta; negm[i] -= delta;  \
      }                                                                                                    \
    }                                                                                                      \
    _Pragma("unroll") for (int mt = 0; mt < 2; ++mt)                                                       \
    _Pragma("unroll") for (int i = 0; i < 16; ++i) sc_[mt][i] = __builtin_amdgcn_exp2f(sc_[mt][i]);        \
    __builtin_amdgcn_s_setprio(1);                                                                         \
    _Pragma("unroll") for (int mt = 0; mt < 2; ++mt)                                                       \
    _Pragma("unroll") for (int s2 = 0; s2 < 2; ++s2) {                                                     \
      const bf16x8 pf = pack8(sc_[mt], s2);                                                                \
      o[0] = MFMA(vf_[(mt * 2 + s2) * 2 + 0], pf, o[0]);                                                   \
      o[1] = MFMA(vf_[(mt * 2 + s2) * 2 + 1], pf, o[1]);                                                   \
      o2 = MFMA(ones, pf, o2);                                                                             \
    }                                                                                                      \
    __builtin_amdgcn_s_setprio(0);                                                                         \
    if ((kt_) + 2 < nkt) K_STORE(buf);                                                                     \
    if ((kt_) + 1 < nkt) V_STORE(buf ^ 1);                                                                 \
    __syncthreads();                                                                                       \
  } while (0)
  f32x16 sn[2];
  sn[0] = zero16();
  sn[1] = zero16();
  S_CHAIN(sc, 0);
  __syncthreads();
  for (int kt = 0; kt < nkt; kt += 2) {
    ATT_STEP(sc, sn, kt);
    ATT_STEP(sn, sc, kt + 1);
  }
#undef ATT_STEP
#undef S_CHAIN
  float l = __shfl(o2[0], r);
#undef K_LOAD
#undef K_STORE
#undef V_LOAD
#undef V_STORE
#undef S_TILE
  const float inv = 1.f / l;
  bf16_t* op = p.xn() + ((size_t)b * TT + qrow) * DM + 384 + hh * 64 + 4 * h;
#pragma unroll
  for (int dt = 0; dt < 2; ++dt)
#pragma unroll
    for (int g = 0; g < 4; ++g) {
      uint2 u;
      u.x = pack2(o[dt][4 * g + 0] * inv, o[dt][4 * g + 1] * inv);
      u.y = pack2(o[dt][4 * g + 2] * inv, o[dt][4 * g + 3] * inv);
      *(uint2*)(op + dt * 32 + 8 * g) = u;
    }
}

DI void ssd_out_rows(const Params& p, int layer, int r_begin, int nrows) {
  const int tid = otid(), lane = tid & 63, wave = tid >> 6;
  const int grp = lane >> 5, li = lane & 31;
  const int ch = grp * 192 + li * 6;
  float dsk[6], nw[6];
#pragma unroll
  for (int e = 0; e < 6; ++e) {
    dsk[e] = p.ssd_d[layer * 6 + (ch + e) / 64];
    nw[e] = p.ssd_norm_w[layer * 384 + ch + e];
  }
  for (int r = r_begin + wave; r < r_begin + nrows; r += 8) {
    const int b = r / TT, t = r - b * TT;
    if (t >= LSEQ && layer == 1) continue;
    const unsigned* yf = (const unsigned*)(p.yssd() + (size_t)r * 384 + ch);
    const unsigned* yb = (const unsigned*)(p.yssd() + ((size_t)MT + r) * 384 + ch);
    const unsigned* xs = (const unsigned*)(p.xbc() + (size_t)r * 896 + ch);
    const unsigned* zz = (const unsigned*)(p.proj() + (size_t)r * NP + C_Z + ch);
    float g[6];
    float ss = 0.f;
#pragma unroll
    for (int e2 = 0; e2 < 3; ++e2) {
      const unsigned a = yf[e2], bq = yb[e2], x = xs[e2], z = zz[e2];
      const float y0 = bflo(a) + bflo(bq) + bflo(x) * dsk[2 * e2];
      const float y1 = bfhi(a) + bfhi(bq) + bfhi(x) * dsk[2 * e2 + 1];
      g[2 * e2] = y0 * silu(bflo(z));
      g[2 * e2 + 1] = y1 * silu(bfhi(z));
      ss += g[2 * e2] * g[2 * e2] + g[2 * e2 + 1] * g[2 * e2 + 1];
    }
#pragma unroll
    for (int o = 16; o >= 1; o >>= 1) ss += __shfl_xor(ss, o);
    const float rstd = rsqrtf(ss * (1.f / 192.f) + 1e-6f);
    unsigned* dst = (unsigned*)(p.xn() + (size_t)r * DM + ch);
#pragma unroll
    for (int e2 = 0; e2 < 3; ++e2) dst[e2] = pack2(g[2 * e2] * rstd * nw[2 * e2], g[2 * e2 + 1] * rstd * nw[2 * e2 + 1]);
  }
}

DI void phase_mixers(const Params& p, int layer, bf16_t* smem, int rep) {
  if (EN(13) || ONLY == 3) for (int jp = obid(); jp < 96; jp += ogrid()) ssd_job(p, layer, jp, smem);
  if (ONLY == 13) return;
  if (layer == 0) {
    if (ogrid() > 96) { if (obid() >= 96) transpose_layer(p, 1, obid() - 96, ogrid() - 96, (float*)smem); }
    else transpose_layer(p, 1, obid(), ogrid(), (float*)smem);
  }
  volatile int* sitem = (volatile int*)((char*)smem + MISC_OFF + 1024);
  const int ipg = layer == 0 ? 17 : 16;
  const int nper = 12 * ipg;
  unsigned* qbase = p.bar() + 3616 + (layer + 2 * rep) * 8;
  const int xcc = (int)(xb_xcc_id() & 7u);
  for (int k = 0; k < 8; ++k) {
    const int xq = (xcc + k) & 7;
    while (true) {
      __syncthreads();
      if (threadIdx.x == 0) *sitem = (int)xb_add(qbase + xq, 1u);
      __syncthreads();
      const int idx = *sitem;
      if (idx >= nper) break;
      const int gi = idx / ipg, within = idx - gi * ipg;
      const int g = xq + 8 * gi;
      const int b = g / 6, hh = g - b * 6;
      if (within == 16) attn_item(p, b, hh, LSEQ, LSEQ, 4, smem);
      else attn_item(p, b, hh, within * 256, 0, 68, smem);
    }
  }
  {
    unsigned* done = p.bar() + 3700 + layer * 16;
    unsigned* rowq = p.bar() + 3740 + layer * 16;
    const int nchunk = layer == 0 ? 68 : 64;
    for (int bb = 0; bb < NB; ++bb) {
      __syncthreads();
      if (threadIdx.x == 0) {
        XB_SPIN(xb_ld(done + bb) < 12u, p.bar());
        __builtin_amdgcn_fence(__ATOMIC_ACQUIRE, "agent");
        asm volatile("s_waitcnt vmcnt(0)" ::: "memory");
      }
      __syncthreads();
      while (true) {
        if (threadIdx.x == 0) *sitem = (int)xb_add(rowq + bb, 1u);
        __syncthreads();
        const int c = *sitem;
        __syncthreads();
        if (c >= nchunk) break;
        ssd_out_rows(p, layer, bb * TT + c * 64, 64);
      }
    }
  }
}

struct XcdBarrier { unsigned* bar; unsigned x; volatile LAS unsigned* st; };
DI XcdBarrier xcd_barrier_post(unsigned* bar, volatile LAS unsigned* st) {
  XcdBarrier b; b.bar = bar; b.x = xb_xcc_id(); b.st = st;
  if (threadIdx.x == 0) (void)xb_add(&bar[XB_XCNT(b.x)], 1u);
  return b;
}
DI void xcd_barrier_complete(unsigned* bar, unsigned x, unsigned& nloc, unsigned& nx) {
  const unsigned G = gridDim.x * gridDim.y * gridDim.z;
  unsigned sum, cnt, mine, sp = 0u;
  for (;;) {
    sum = 0u; cnt = 0u; mine = 0u;
#pragma unroll
    for (unsigned j = 0; j < 16; ++j) { const unsigned c = xb_ld(&bar[XB_XCNT(j)]); sum += c; cnt += (c > 0u) ? 1u : 0u; mine = (j == x) ? c : mine; }
    if (sum == G) break;
    __builtin_amdgcn_s_sleep(1);
    if ((++sp & 255u) == 0u) { if (xb_ld(&bar[XB_TMO])) break; if (sp > XB_SPIN_CAP) { atomicAdd(&bar[XB_TMO], 1u); break; } }
  }
  nloc = mine > 0u ? mine : 1u; nx = cnt > 0u ? cnt : 1u;
}
DI void xcd_barrier(const XcdBarrier& b) {
  asm volatile("s_waitcnt vmcnt(0)" ::: "memory");
  __syncthreads();
  if (threadIdx.x == 0) {
    unsigned* bar = b.bar;
    __builtin_amdgcn_s_waitcnt(0);
    unsigned nloc = b.st[0], nx = b.st[1];
    if (nloc == 0u) { xcd_barrier_complete(bar, b.x, nloc, nx); b.st[0] = nloc; b.st[1] = nx; }
    const unsigned old = xb_add(&bar[XB_XSUB(b.x)], 1u);
    const unsigned gen = old / nloc;
    if (old + 1u == (gen + 1u) * nloc) {
      __builtin_amdgcn_fence(__ATOMIC_RELEASE, "agent");
      asm volatile("s_waitcnt vmcnt(0)" ::: "memory");
      const unsigned og = xb_add(&bar[XB_TOP], 1u);
      const unsigned tg = og / nx;
      if (og + 1u == (tg + 1u) * nx) xb_add(&bar[XB_TOPGEN], 1u);
      else XB_SPIN(xb_ld(&bar[XB_TOPGEN]) == tg, bar);
      __builtin_amdgcn_fence(__ATOMIC_ACQUIRE, "agent");
      xb_add(&bar[XB_XGEN(b.x)], 1u);
      asm volatile("s_waitcnt vmcnt(0)" ::: "memory");
    } else {
      XB_SPIN(xb_ld(&bar[XB_XGEN(b.x)]) == gen, bar);
      __builtin_amdgcn_fence(__ATOMIC_ACQUIRE, "agent");
      asm volatile("s_waitcnt vmcnt(0)" ::: "memory");
    }
  }
  __syncthreads();
}

DI void run_phase(const Params& p, int ph, bf16_t* smem, int rep) {
  if (ph == 0) { if (EN(10)) phase_prep(p, smem); return; }
  if (ph == NPHASE - 1) { if (EN(11)) phase_final(p); return; }
  const int layer = (ph - 1) / 9, s = (ph - 1) % 9;
  switch (s) {
    case 0: if (EN(0)) phase_norm(p, layer, 1); break;
    case 1: if (EN(1)) phase_gemm_in(p, layer, smem); break;
    case 2: if (EN(2)) phase_tokops(p, layer); if (EN(12)) phase_gemm_qkv(p, layer, smem); break;
    case 3: if (EN(3) || EN(13) || EN(14)) phase_mixers(p, layer, smem, rep); break;
    case 4: break;
    case 5: if (EN(5)) phase_gemm_out(p, layer, smem); break;
    case 6: if (EN(6)) phase_norm(p, layer, 2); break;
    case 7: if (EN(7)) phase_gemm_m1(p, layer, smem); break;
    default: if (EN(8)) phase_gemm_m2(p, layer, smem); break;
  }
}

__global__ void __launch_bounds__(512, 2) fwd_megakernel(Params p, int ph_begin, int ph_end) {
  __shared__ __attribute__((aligned(16))) unsigned char smem_raw[SMEM_BYTES];
  bf16_t* smem = (bf16_t*)smem_raw;
  cg::grid_group grid = cg::this_grid();
  volatile LAS unsigned* xst = (volatile LAS unsigned*)(LAS unsigned char*)(smem_raw + MISC_OFF + 1024 + 32);
  if (threadIdx.x == 0) { xst[0] = 0u; xst[1] = 0u; }
  __syncthreads();
  const XcdBarrier xb = xcd_barrier_post(p.bar(), xst);
  for (int ph = ph_begin; ph < ph_end; ++ph) {
    if (ph >= 1 && ph < NPHASE - 1 && (ph - 1) % 9 == 4) continue;
    run_phase(p, ph, smem, 0);
#if REPEAT_MASK
    if (ph >= 1 && ph < NPHASE - 1 && ((REPEAT_MASK >> ((ph - 1) % 9)) & 1)) {
      xcd_barrier(xb);
      run_phase(p, ph, smem, 1);
    }
#endif
    if (ph + 1 < ph_end) {
      if (ph_begin < 0) grid.sync();
      xcd_barrier(xb);
    }
  }
}

extern "C" void kernel_launch(void* const* d_in, const int* in_sizes, int n_in, void* d_out, int out_size, void* d_ws,
                              size_t ws_size, hipStream_t stream) {
  static int grid_blocks = 0;
  if (!grid_blocks) {
    int dev = 0, cus = 0, per_cu = 0;
    hipGetDevice(&dev);
    hipDeviceGetAttribute(&cus, hipDeviceAttributeMultiprocessorCount, dev);
    hipOccupancyMaxActiveBlocksPerMultiprocessor(&per_cu, fwd_megakernel, 512, 0);
    if (per_cu > 1) per_cu = 1;
    if (per_cu < 1) per_cu = 1;
    grid_blocks = cus * per_cu;
  }
  Params p{};
  const float** fp = (const float**)&p;
  for (int i = 0; i < 25; ++i) fp[i] = (const float*)d_in[i];
  p.out = (float*)d_out;
  p.ws = (char*)d_ws;
  if (WS_NEED > ws_size) fprintf(stderr, "workspace too small: need %zu have %zu\n", (size_t)WS_NEED, ws_size);
  hipMemsetAsync((char*)d_ws + O_BAR, 0, 16384, stream);
#if MULTI_LAUNCH
  for (int ph = 0; ph < NPHASE; ++ph)
    hipLaunchKernelGGL(fwd_megakernel, dim3(grid_blocks), dim3(512), 0, stream, p, ph, ph + 1);
#else
  int b0 = 0, b1 = NPHASE;
  void* args[] = {&p, &b0, &b1};
  hipError_t e = hipLaunchCooperativeKernel((void*)fwd_megakernel, dim3(grid_blocks), dim3(512), args, 0, stream);
  if (e != hipSuccess) fprintf(stderr, "cooperative launch failed: %s (grid %d)\n", hipGetErrorString(e), grid_blocks);
#endif
}
```
